# Optimizing an MI355X kernel written in HIP

```python
import math
import jax
import jax.numpy as jnp
from jax import lax
import numpy as np

D_MODEL = 1024
BATCH = 2
SEQ = 16384
DEPTH = 2

CHUNK = 64
Q_BLOCK = 128
SB_HEADS = 4
SB_HEAD_DIM = 64
SB_WIDTH = SB_HEADS * SB_HEAD_DIM
SSM_HEADS = 8
SSM_HEAD_DIM = 64
SSM_WIDTH = SSM_HEADS * SSM_HEAD_DIM
SSM_GROUPS = 2
SSM_STATE = 64
SSM_CONV = 4
SSM_CONV_DIM = SSM_WIDTH + 2 * SSM_GROUPS * SSM_STATE
SC_WIDTH = 256
SC_CONV = 3
MIX_WIDTH = SB_WIDTH + SSM_WIDTH + SC_WIDTH
IN_SEGMENTS = (SB_WIDTH, SB_WIDTH, SB_WIDTH,
               SSM_WIDTH, SSM_CONV_DIM, SSM_HEADS,
               SC_WIDTH, SC_WIDTH, SC_WIDTH)
IN_WIDTH = sum(IN_SEGMENTS)
PEER_HEADS = 4
PEER_KEY_DIM = 256
PEER_NKEYS = 128
PEER_TOPK = 16
PEER_EXPERTS = PEER_NKEYS * PEER_NKEYS
TOKEN_BLOCK = 128
EPS = 1e-6

kernel_name = 'hybrid_stickbreak_ssd_shortconv_peer'


def rmsnorm(x, w):
    x32 = x.astype(jnp.float32)
    y = x32 * lax.rsqrt(jnp.mean(x32 * x32, axis=-1, keepdims=True) + EPS)
    return (y * w.astype(jnp.float32)).astype(x.dtype)


def causal_depthwise_conv(x, w):
    k, c = w.shape
    return lax.conv_general_dilated(
        x, w[:, None, :].astype(x.dtype), window_strides=(1,), padding=[(k - 1, 0)],
        dimension_numbers=('NWC', 'WIO', 'NWC'), feature_group_count=c)


def stick_breaking_attention(q, k, v):
    b, s, h, dh = q.shape
    nblk = s // Q_BLOCK
    scale = dh ** -0.5

    def blocks(a):
        return a.astype(jnp.float32).reshape(b, nblk, Q_BLOCK, h, dh).transpose(1, 0, 3, 2, 4)

    qb, kb, vb = blocks(q), blocks(k), blocks(v)
    qi_np = np.concatenate([np.full(i + 1, i, np.int32) for i in range(nblk)])
    kj_np = np.concatenate([np.arange(i, -1, -1, dtype=np.int32) for i in range(nblk)])
    idx = jnp.arange(Q_BLOCK)
    diag_mask = idx[None, :] < idx[:, None]
    upper = (idx[:, None] > idx[None, :]).astype(jnp.float32)

    def step(carry, ij):
        acc, out_acc, buf = carry
        i, j = ij
        first = j == i
        z = jnp.einsum('bhqd,bhkd->bhqk', qb[i], kb[j]) * scale
        mask = diag_mask | (j < i)
        l = jax.nn.log_sigmoid(-z)
        lm = jnp.where(mask, l, 0.0)
        acc = jnp.where(first, 0.0, acc)
        out_acc = jnp.where(first, 0.0, out_acc)
        rev = jnp.einsum('bhqj,js->bhqs', lm, upper) + acc[..., None]
        w = jnp.where(mask, jnp.exp(l + z + rev), 0.0)
        out_acc = out_acc + jnp.einsum('bhqk,bhkd->bhqd', w, vb[j])
        acc = acc + jnp.sum(lm, axis=-1)
        buf = lax.dynamic_update_index_in_dim(buf, out_acc, i, 0)
        return (acc, out_acc, buf), None

    init = (jnp.zeros((b, h, Q_BLOCK), jnp.float32),
            jnp.zeros((b, h, Q_BLOCK, dh), jnp.float32),
            jnp.zeros((nblk, b, h, Q_BLOCK, dh), jnp.float32))
    (_, _, out), _ = lax.scan(step, init, (jnp.asarray(qi_np), jnp.asarray(kj_np)))
    return out.transpose(1, 0, 3, 2, 4).reshape(b, s, h, dh)


def segsum(x):
    L = x.shape[-1]
    idx = jnp.arange(L)
    xx = jnp.broadcast_to(x[..., :, None], x.shape + (L,))
    xx = jnp.where(idx[:, None] > idx[None, :], xx, 0.0)
    ss = jnp.cumsum(xx, axis=-2)
    return jnp.where(idx[:, None] >= idx[None, :], ss, -jnp.inf)


def ssd_scan(x, dt, A, Bm, Cm):
    b, s, h, p = x.shape
    n = Bm.shape[-1]
    nc = s // CHUNK
    xd = (x * dt[..., None]).reshape(b, nc, CHUNK, h, p)
    a = (dt * A).reshape(b, nc, CHUNK, h).transpose(0, 3, 1, 2)
    Bc = Bm.reshape(b, nc, CHUNK, h, n)
    Cc = Cm.reshape(b, nc, CHUNK, h, n)
    a_cs = jnp.cumsum(a, axis=-1)
    Lmat = jnp.exp(segsum(a))
    cb = jnp.einsum('bclhn,bcshn->bhcls', Cc, Bc)
    y_diag = jnp.einsum('bhcls,bcshp->bclhp', cb * Lmat, xd)
    decay = jnp.exp(a_cs[..., -1:] - a_cs)
    states = jnp.einsum('bclhn,bhcl,bclhp->bchpn', Bc, decay, xd)
    chunk_decay = jnp.exp(a_cs[..., -1])

    def step(carry, inp):
        st, dec = inp
        return carry * dec[..., None, None] + st, carry

    init = jnp.zeros((b, h, p, n), jnp.float32)
    _, prev = lax.scan(step, init, (states.transpose(1, 0, 2, 3, 4), chunk_decay.transpose(2, 0, 1)))
    prev = prev.transpose(1, 0, 2, 3, 4)
    y_off = jnp.einsum('bclhn,bchpn,bhcl->bclhp', Cc, prev, jnp.exp(a_cs))
    return (y_diag + y_off).reshape(b, s, h, p)


def hybrid_mixer(h, w_in, ssm_conv_w, ssm_conv_b, ssm_dt_bias, ssm_A_log, ssm_D, ssm_norm_w, sc_conv_w, w_out):
    b, s, _ = h.shape
    proj = jnp.einsum('bsd,de->bse', h, w_in)
    cuts = []
    acc = 0
    for width in IN_SEGMENTS[:-1]:
        acc += width
        cuts.append(acc)
    q, k, v, z, xbc, dt_raw, sc_b, sc_c, sc_v = jnp.split(proj, cuts, axis=-1)

    y_sb = stick_breaking_attention(q.reshape(b, s, SB_HEADS, SB_HEAD_DIM),
                                    k.reshape(b, s, SB_HEADS, SB_HEAD_DIM),
                                    v.reshape(b, s, SB_HEADS, SB_HEAD_DIM)).reshape(b, s, SB_WIDTH)

    xbc = jax.nn.silu(causal_depthwise_conv(xbc, ssm_conv_w) + ssm_conv_b.astype(xbc.dtype))
    xbc = xbc.astype(jnp.float32)
    xs = xbc[..., :SSM_WIDTH].reshape(b, s, SSM_HEADS, SSM_HEAD_DIM)
    rep = SSM_HEADS // SSM_GROUPS
    Bm = jnp.repeat(xbc[..., SSM_WIDTH:SSM_WIDTH + SSM_GROUPS * SSM_STATE].reshape(b, s, SSM_GROUPS, SSM_STATE), rep, axis=2)
    Cm = jnp.repeat(xbc[..., SSM_WIDTH + SSM_GROUPS * SSM_STATE:].reshape(b, s, SSM_GROUPS, SSM_STATE), rep, axis=2)
    dt = jax.nn.softplus(dt_raw.astype(jnp.float32) + ssm_dt_bias.astype(jnp.float32))
    A = -jnp.exp(ssm_A_log.astype(jnp.float32))
    y_ssm = ssd_scan(xs, dt, A, Bm, Cm) + ssm_D.astype(jnp.float32)[:, None] * xs
    y_ssm = y_ssm.reshape(b, s, SSM_WIDTH) * jax.nn.silu(z.astype(jnp.float32))
    y_ssm = rmsnorm(y_ssm, ssm_norm_w)

    y_sc = sc_b * causal_depthwise_conv(sc_c * sc_v, sc_conv_w)

    y = jnp.concatenate([y_sb.astype(h.dtype), y_ssm.astype(h.dtype), y_sc.astype(h.dtype)], axis=-1)
    return jnp.einsum('bse,ed->bsd', y, w_out)


def peer_ffn(h, w_q, sub_keys, u, v):
    b, s, d = h.shape
    half = PEER_KEY_DIM // 2
    q = jnp.einsum('bsd,de->bse', h, w_q).astype(jnp.float32).reshape(b, s, PEER_HEADS, 2, half)
    scores = jnp.einsum('bshtk,tnk->bshtn', q, sub_keys.astype(jnp.float32))
    s_top, i_top = lax.top_k(scores, PEER_TOPK)
    cand = s_top[..., 0, :, None] + s_top[..., 1, None, :]
    cand_idx = i_top[..., 0, :, None] * PEER_NKEYS + i_top[..., 1, None, :]
    kk = PEER_TOPK * PEER_TOPK
    best, pos = lax.top_k(cand.reshape(b, s, PEER_HEADS, kk), PEER_TOPK)
    expert = jnp.take_along_axis(cand_idx.reshape(b, s, PEER_HEADS, kk), pos, axis=-1)
    gate = jax.nn.softmax(best, axis=-1)

    nblk = s // TOKEN_BLOCK
    hb = h.reshape(b, nblk, TOKEN_BLOCK, d).transpose(1, 0, 2, 3)
    eb = expert.reshape(b, nblk, TOKEN_BLOCK, PEER_HEADS, PEER_TOPK).transpose(1, 0, 2, 3, 4)
    gb = gate.reshape(b, nblk, TOKEN_BLOCK, PEER_HEADS, PEER_TOPK).transpose(1, 0, 2, 3, 4)

    def block(args):
        hx, ex, gx = args
        ue = u[ex]
        act = jax.nn.gelu(jnp.einsum('btd,bthkd->bthk', hx, ue).astype(jnp.float32), approximate=False)
        ve = v[ex]
        return jnp.einsum('bthk,bthkd->btd', (gx * act).astype(ve.dtype), ve)

    out = lax.map(block, (hb, eb, gb))
    return out.transpose(1, 0, 2, 3).reshape(b, s, d).astype(h.dtype)


def setup_inputs(seed: int = 0) -> dict:
    key = jax.random.key(seed)
    ks = jax.random.split(key, 20)
    f32 = jnp.float32

    def nrm(k, shape, scale):
        return jax.random.normal(k, shape, f32) * scale

    dt = jnp.exp(jax.random.uniform(ks[6], (DEPTH, SSM_HEADS), f32, math.log(1e-3), math.log(1e-1)))
    return {
        'x': nrm(ks[0], (BATCH, SEQ, D_MODEL), 1.0),
        'norm1_w': 1.0 + nrm(ks[1], (DEPTH, D_MODEL), 0.05),
        'w_in': nrm(ks[2], (DEPTH, D_MODEL, IN_WIDTH), D_MODEL ** -0.5),
        'ssm_conv_w': nrm(ks[3], (DEPTH, SSM_CONV, SSM_CONV_DIM), SSM_CONV ** -0.5),
        'ssm_conv_b': nrm(ks[4], (DEPTH, SSM_CONV_DIM), 0.02),
        'ssm_dt_bias': dt + jnp.log(-jnp.expm1(-dt)),
        'ssm_A_log': jnp.log(jax.random.uniform(ks[7], (DEPTH, SSM_HEADS), f32, 1.0, 16.0)),
        'ssm_D': 1.0 + nrm(ks[8], (DEPTH, SSM_HEADS), 0.1),
        'ssm_norm_w': 1.0 + nrm(ks[9], (DEPTH, SSM_WIDTH), 0.05),
        'sc_conv_w': nrm(ks[10], (DEPTH, SC_CONV, SC_WIDTH), SC_CONV ** -0.5),
        'w_out': nrm(ks[11], (DEPTH, MIX_WIDTH, D_MODEL), MIX_WIDTH ** -0.5),
        'norm2_w': 1.0 + nrm(ks[12], (DEPTH, D_MODEL), 0.05),
        'peer_w_q': nrm(ks[13], (DEPTH, D_MODEL, PEER_HEADS * PEER_KEY_DIM), D_MODEL ** -0.5),
        'peer_sub_keys': nrm(ks[14], (DEPTH, 2, PEER_NKEYS, PEER_KEY_DIM // 2), (PEER_KEY_DIM // 2) ** -0.5),
        'peer_u': nrm(ks[15], (DEPTH, PEER_EXPERTS, D_MODEL), D_MODEL ** -0.5),
        'peer_v': nrm(ks[16], (DEPTH, PEER_EXPERTS, D_MODEL), 0.5),
        'final_norm_w': 1.0 + nrm(ks[17], (D_MODEL,), 0.05),
    }


def reference(x, norm1_w, w_in, ssm_conv_w, ssm_conv_b, ssm_dt_bias, ssm_A_log, ssm_D, ssm_norm_w,
              sc_conv_w, w_out, norm2_w, peer_w_q, peer_sub_keys, peer_u, peer_v, final_norm_w):
    for i in range(DEPTH):
        h = rmsnorm(x, norm1_w[i])
        x = x + hybrid_mixer(h, w_in[i], ssm_conv_w[i], ssm_conv_b[i], ssm_dt_bias[i], ssm_A_log[i],
                             ssm_D[i], ssm_norm_w[i], sc_conv_w[i], w_out[i])
        h = rmsnorm(x, norm2_w[i])
        x = x + peer_ffn(h, peer_w_q[i], peer_sub_keys[i], peer_u[i], peer_v[i])
    return rmsnorm(x, final_norm_w)
```

```cpp
#define MK_N_LAUNCHES 1
#include <hip/hip_runtime.h>
#include <cstdio>
#include <cstdint>
#include <cmath>
namespace pg8 {
#define PG8_LAS __attribute__((address_space(3)))
typedef unsigned short bf16_t;
typedef short bf16x8 __attribute__((ext_vector_type(8)));
typedef float f32x4 __attribute__((ext_vector_type(4)));
typedef unsigned u32x4 __attribute__((ext_vector_type(4)));
constexpr int BM = 256, BK = 64, HALF = 128, HTB = HALF * BK * 2  , STAGE_BYTES = 8 * HTB, NXCD = 8, WGM = 8;

__host__ __device__ __forceinline__ int lds_byte(int r, int c) { const int st = (r >> 4) * 2 + (c >> 5), rr = r & 15, cc = c & 31, ob = rr * 64 + cc * 2; return st * 1024 + (ob ^ (((ob >> 9) & 1) << 5)); }
__host__ __device__ __forceinline__ void stage_rc(int b, int& R, int& C) { const int st = b / 1024, sb = b % 1024, swz = sb ^ (((sb >> 9) & 1) << 5); R = (st >> 1) * 16 + swz / 64; C = (st & 1) * 32 + (swz % 64) / 2; }
__host__ __device__ __forceinline__ int perm32(int rho) { const int n = rho >> 4, i = rho & 15; return 8 * (i >> 2) + 4 * n + (i & 3); }

struct Unit { int pm, pn; };
struct Gemm { const bf16_t* A; const bf16_t* Bt; int M, N, K; };

struct StaticOrder {
    int nM, nN, nwg, G, c;
    __host__ __device__ void init(int M, int N, int G_, int c_) { nM = M / BM; nN = N / BM; nwg = nM * nN; G = G_; c = c_; }
    __host__ __device__ bool next(int i, Unit& u) const {
        const long L = (long)i * G + c; if (L >= nwg) return false;
        int wgid = (int)L; { const int q = nwg / NXCD, r = nwg % NXCD, xcd = wgid % NXCD, off = wgid / NXCD; wgid = (xcd < r ? xcd * (q + 1) : r * (q + 1) + (xcd - r) * q) + off; }
        const int nig = WGM * nN, gid = wgid / nig, fm = gid * WGM, gsz = (nM - fm) < WGM ? (nM - fm) : WGM;
        u.pm = fm + ((wgid % nig) % gsz); u.pn = (wgid % nig) / gsz; return true;
    }
    __device__ __forceinline__ void a_ready(const Unit&) const {}
    __device__ __forceinline__ void done(const Unit&) const {}
};

__device__ __forceinline__ unsigned cvt_pk_bf16(float lo, float hi) { unsigned r; asm volatile("v_cvt_pk_bf16_f32 %0, %1, %2" : "=v"(r) : "v"(lo), "v"(hi)); return r; }
typedef float f32x2 __attribute__((ext_vector_type(2)));
__device__ __forceinline__ f32x2 gelu_pk(f32x2 v) {
    const f32x2 av = __builtin_elementwise_abs(v), d = av * 0.2316418882f + 1.0f;
    f32x2 t; t.x = __builtin_amdgcn_rcpf(d.x); t.y = __builtin_amdgcn_rcpf(d.y);
    f32x2 q = t * 0.5307027145f + (-0.7265760135f); q = q * t + 0.7107068705f; q = q * t + (-0.142248368f); q = q * t + 0.127414796f; q = q * t;
    const f32x2 s = (v * v) * (-0.72134752044f);
    f32x2 e; e.x = __builtin_amdgcn_exp2f(s.x); e.y = __builtin_amdgcn_exp2f(s.y);
    const f32x2 m = v * (q * e), r = v - m;
    f32x2 o; o.x = v.x < 0.f ? m.x : r.x; o.y = v.y < 0.f ? m.y : r.y; return o;
}

template <int ACT  > struct EpiBf16 {
    static constexpr bool PERM = true, AFTER_DRAIN = false; static_assert(ACT == 0 || ACT == 1, "EpiBf16: ACT is 0 (none) or 1 (gelu_pk)");
    bf16_t* O; int ldc; const float* bias; int split_cols; size_t split_stride; float scale0;
    __device__ __forceinline__ void operator()(const f32x4 (&acc)[2][2][4][2], const Unit& u, int wr, int wc, int fr, int fq) const {
        const int row0 = u.pm * BM + wr * 64 + fr; int colt = u.pn * BM; bf16_t* base = O;
        float sc = 1.f; if (split_cols) { const int t = colt / split_cols; base += (size_t)t * split_stride; colt -= t * split_cols; if (t == 0) sc = scale0; }
        const int col0 = colt + wc * 32 + 8 * fq, bcol0 = u.pn * BM + wc * 32 + 8 * fq;
        f32x4 bv[2][2];
#pragma unroll
        for (int bj = 0; bj < 2; ++bj)
#pragma unroll
            for (int n = 0; n < 2; ++n) bv[bj][n] = bias ? *(const f32x4*)(bias + bcol0 + bj * HALF + 4 * n) : (f32x4){0.f, 0.f, 0.f, 0.f};
#pragma unroll
        for (int ai = 0; ai < 2; ++ai)
#pragma unroll
            for (int m = 0; m < 4; ++m) { bf16_t* rowp = base + (size_t)(row0 + ai * HALF + m * 16) * ldc + col0;
#pragma unroll
                for (int bj = 0; bj < 2; ++bj) { f32x4 v0 = acc[ai][bj][m][0] + bv[bj][0], v1 = acc[ai][bj][m][1] + bv[bj][1];
                    if (ACT == 1) { f32x2 a = gelu_pk((f32x2){v0[0], v0[1]}), b = gelu_pk((f32x2){v0[2], v0[3]}), c = gelu_pk((f32x2){v1[0], v1[1]}), d = gelu_pk((f32x2){v1[2], v1[3]});
                        v0 = (f32x4){a.x, a.y, b.x, b.y}; v1 = (f32x4){c.x, c.y, d.x, d.y}; }
                    v0 = v0 * sc; v1 = v1 * sc; u32x4 w; w.x = cvt_pk_bf16(v0[0], v0[1]); w.y = cvt_pk_bf16(v0[2], v0[3]); w.z = cvt_pk_bf16(v1[0], v1[1]); w.w = cvt_pk_bf16(v1[2], v1[3]);
                    *(u32x4*)(rowp + bj * HALF) = w; } }
    }
};
struct EpiResid {
    static constexpr bool PERM = true, AFTER_DRAIN = false;
    const float* resid; float* out; bf16_t* xb; float* ss;
    __device__ __forceinline__ void operator()(const f32x4 (&acc)[2][2][4][2], const Unit& u, int wr, int wc, int fr, int fq) const {
        const int row0 = u.pm * BM + wr * 64 + fr; const int col0 = u.pn * BM + wc * 32 + 8 * fq;
#pragma unroll
        for (int ai = 0; ai < 2; ++ai)
#pragma unroll
            for (int m = 0; m < 4; ++m) { const int row = row0 + ai * HALF + m * 16; const size_t off = (size_t)row * 1024 + col0; float s = 0.f;
#pragma unroll
                for (int bj = 0; bj < 2; ++bj) { const float* rp = resid + off + bj * HALF; const f32x4 r0 = *(const f32x4*)rp, r1 = *(const f32x4*)(rp + 4);
                    const f32x4 v0 = acc[ai][bj][m][0] + r0, v1 = acc[ai][bj][m][1] + r1;
                    *(f32x4*)(out + off + bj * HALF) = v0; *(f32x4*)(out + off + bj * HALF + 4) = v1;
                    u32x4 w; w.x = cvt_pk_bf16(v0[0], v0[1]); w.y = cvt_pk_bf16(v0[2], v0[3]); w.z = cvt_pk_bf16(v1[0], v1[1]); w.w = cvt_pk_bf16(v1[2], v1[3]);
                    *(u32x4*)(xb + off + bj * HALF) = w;
                    s += (v0[0] * v0[0] + v0[1] * v0[1]) + (v0[2] * v0[2] + v0[3] * v0[3]) + (v1[0] * v1[0] + v1[1] * v1[1]) + (v1[2] * v1[2] + v1[3] * v1[3]); }
                { const auto r16_ = __builtin_amdgcn_permlane16_swap(__float_as_uint(s), __float_as_uint(s), false, false); s = __uint_as_float(r16_[0]) + __uint_as_float(r16_[1]); const auto r32_ = __builtin_amdgcn_permlane32_swap(__float_as_uint(s), __float_as_uint(s), false, false); s = __uint_as_float(r32_[0]) + __uint_as_float(r32_[1]); }
                if (fq == 0) ss[(size_t)row * 16 + u.pn * 4 + wc] = s; }
    }
};
struct EpiScore {
    static constexpr bool PERM = true, AFTER_DRAIN = false;
    float* out; const float* ss; float eps;
    __device__ __forceinline__ void operator()(const f32x4 (&acc)[2][2][4][2], const Unit& u, int wr, int wc, int fr, int fq) const {
        const int row0 = u.pm * BM + wr * 64 + fr; const int col0 = u.pn * BM + wc * 32 + 8 * fq;
#pragma unroll
        for (int ai = 0; ai < 2; ++ai)
#pragma unroll
            for (int m = 0; m < 4; ++m) { const int row = row0 + ai * HALF + m * 16; const size_t off = (size_t)row * 1024 + col0;
                const f32x4* sp = (const f32x4*)(ss + (size_t)row * 16); const f32x4 a = sp[0], b = sp[1], c = sp[2], d = sp[3];
                const float t = ((a[0] + a[1]) + (a[2] + a[3])) + ((b[0] + b[1]) + (b[2] + b[3])) + ((c[0] + c[1]) + (c[2] + c[3])) + ((d[0] + d[1]) + (d[2] + d[3]));
                const float rstd = 1.0f / sqrtf(t * (1.0f / 1024.0f) + eps);
#pragma unroll
                for (int bj = 0; bj < 2; ++bj) { *(f32x4*)(out + off + bj * HALF) = acc[ai][bj][m][0] * rstd; *(f32x4*)(out + off + bj * HALF + 4) = acc[ai][bj][m][1] * rstd; } }
    }
};

struct EpiBf16Row {
    static constexpr bool PERM = true, AFTER_DRAIN = false;
    bf16_t* O; int ldc; const float* rs;
    __device__ __forceinline__ void operator()(const f32x4 (&acc)[2][2][4][2], const Unit& u, int wr, int wc, int fr, int fq) const {
        const int row0 = u.pm * BM + wr * 64 + fr; const int col0 = u.pn * BM + wc * 32 + 8 * fq;
#pragma unroll
        for (int ai = 0; ai < 2; ++ai)
#pragma unroll
            for (int m = 0; m < 4; ++m) { const int row = row0 + ai * HALF + m * 16; const float sc = rs[row]; bf16_t* rowp = O + (size_t)row * ldc + col0;
#pragma unroll
                for (int bj = 0; bj < 2; ++bj) { const f32x4 v0 = acc[ai][bj][m][0] * sc, v1 = acc[ai][bj][m][1] * sc;
                    u32x4 w; w.x = cvt_pk_bf16(v0[0], v0[1]); w.y = cvt_pk_bf16(v0[2], v0[3]); w.z = cvt_pk_bf16(v1[0], v1[1]); w.w = cvt_pk_bf16(v1[2], v1[3]);
                    *(u32x4*)(rowp + bj * HALF) = w; } }
    }
};
struct EpiResidB {
    static constexpr bool PERM = true, AFTER_DRAIN = false;
    const bf16_t* resid; bf16_t* xb; float* ss;
    __device__ __forceinline__ void operator()(const f32x4 (&acc)[2][2][4][2], const Unit& u, int wr, int wc, int fr, int fq) const {
        const int row0 = u.pm * BM + wr * 64 + fr; const int col0 = u.pn * BM + wc * 32 + 8 * fq;
#pragma unroll
        for (int ai = 0; ai < 2; ++ai)
#pragma unroll
            for (int m = 0; m < 4; ++m) { const int row = row0 + ai * HALF + m * 16; const size_t off = (size_t)row * 1024 + col0; float s = 0.f;
#pragma unroll
                for (int bj = 0; bj < 2; ++bj) { const u32x4 r = *(const u32x4*)(resid + off + bj * HALF);
                    const f32x4 r0 = (f32x4){__uint_as_float(r.x << 16), __uint_as_float(r.x & 0xffff0000u), __uint_as_float(r.y << 16), __uint_as_float(r.y & 0xffff0000u)};
                    const f32x4 r1 = (f32x4){__uint_as_float(r.z << 16), __uint_as_float(r.z & 0xffff0000u), __uint_as_float(r.w << 16), __uint_as_float(r.w & 0xffff0000u)};
                    const f32x4 v0 = acc[ai][bj][m][0] + r0, v1 = acc[ai][bj][m][1] + r1;
                    u32x4 w; w.x = cvt_pk_bf16(v0[0], v0[1]); w.y = cvt_pk_bf16(v0[2], v0[3]); w.z = cvt_pk_bf16(v1[0], v1[1]); w.w = cvt_pk_bf16(v1[2], v1[3]);
                    *(u32x4*)(xb + off + bj * HALF) = w;
                    s += (v0[0] * v0[0] + v0[1] * v0[1]) + (v0[2] * v0[2] + v0[3] * v0[3]) + (v1[0] * v1[0] + v1[1] * v1[1]) + (v1[2] * v1[2] + v1[3] * v1[3]); }
                { const auto r16_ = __builtin_amdgcn_permlane16_swap(__float_as_uint(s), __float_as_uint(s), false, false); s = __uint_as_float(r16_[0]) + __uint_as_float(r16_[1]); const auto r32_ = __builtin_amdgcn_permlane32_swap(__float_as_uint(s), __float_as_uint(s), false, false); s = __uint_as_float(r32_[0]) + __uint_as_float(r32_[1]); }
                if (fq == 0) ss[(size_t)row * 16 + u.pn * 4 + wc] = s; }
    }
};
template <class Epi, class Sched, bool ALIGN_EPI = false, bool SP2 = false>
__device__ __forceinline__ void gemm_phase(PG8_LAS unsigned char* lds, const Gemm g, const Sched& S, const Epi& E) {
    int tid_ = threadIdx.x; asm volatile("" : "+v"(tid_));
    const int tid = tid_, wid = __builtin_amdgcn_readfirstlane(tid >> 6), lane = tid & 63, wr = wid >> 2, wc = wid & 3, fr = lane & 15, fq = lane >> 4;
    const int K = g.K, nt = K / BK;
    unsigned voffA[2], voffB[2];
#pragma unroll
    for (int i = 0; i < 2; ++i) { int R, C; stage_rc(tid * 16 + i * 8192, R, C); const int Rb = Epi::PERM ? ((R & ~31) + perm32(R & 31)) : R;
        voffA[i] = (unsigned)(R * K + C) * 2u; voffB[i] = (unsigned)(Rb * K + C) * 2u; }
    const size_t kstep = (size_t)(BK * 2);
    const size_t hstep = (size_t)HALF * K * 2;
    const size_t tstep = 2 * hstep;
    const unsigned ldsw = (unsigned)wid * 1024u;
    const int aoff = lds_byte(wr * 64 + fr, fq * 8), boff = lds_byte(wc * 32 + fr, fq * 8);
#define PG8_SA(b, h) (((b) * 2 + (h)) * HTB)
#define PG8_SB(b, h) ((4 + (b) * 2 + (h)) * HTB)
#define PG8_STAGE(bufoff, gbase, voff) do { _Pragma("unroll") for (int _i = 0; _i < 2; ++_i) \
        __builtin_amdgcn_global_load_lds((const unsigned*)((const char*)(gbase) + (voff)[_i]), (PG8_LAS unsigned*)(lds + (bufoff) + ldsw + _i * 8192), 16, 0, 0); } while (0)
#define PG8_LDA(dst, b, h) do { _Pragma("unroll") for (int m = 0; m < 4; ++m) _Pragma("unroll") for (int k = 0; k < 2; ++k) dst[m][k] = *(const PG8_LAS bf16x8*)(lds + PG8_SA(b, h) + aoff + m * 2048 + k * 1024); } while (0)
#define PG8_LDB(dst, b, h) do { _Pragma("unroll") for (int n = 0; n < 2; ++n) _Pragma("unroll") for (int k = 0; k < 2; ++k) dst[n][k] = *(const PG8_LAS bf16x8*)(lds + PG8_SB(b, h) + boff + n * 2048 + k * 1024); } while (0)
#define PG8_MMA(ai, bj, At, Bt) do { __builtin_amdgcn_s_setprio(1); _Pragma("unroll") for (int m = 0; m < 4; ++m) _Pragma("unroll") for (int n = 0; n < 2; ++n) _Pragma("unroll") for (int k = 0; k < 2; ++k) \
        acc[ai][bj][m][n] = __builtin_amdgcn_mfma_f32_16x16x32_bf16(Bt[n][k], At[m][k], acc[ai][bj][m][n], 0, 0, 0); __builtin_amdgcn_s_setprio(0); } while (0)
#define PG8_WAIT_V(n) asm volatile("s_waitcnt vmcnt(" #n ")" ::: "memory")
#define PG8_WAIT_L(n) asm volatile("s_waitcnt lgkmcnt(" #n ")" ::: "memory")
#define PG8_BAR __builtin_amdgcn_s_barrier()
#define PG8_SCHED __builtin_amdgcn_sched_barrier(0)
    Unit cur, nxt; int ui = 0;
    if (!S.next(0, cur)) return;
    f32x4 acc[2][2][4][2];
#pragma unroll
    for (int a = 0; a < 2; ++a)
#pragma unroll
        for (int b = 0; b < 2; ++b)
#pragma unroll
            for (int m = 0; m < 4; ++m)
#pragma unroll
                for (int n = 0; n < 2; ++n) acc[a][b][m][n] = (f32x4){0.f, 0.f, 0.f, 0.f};
    bf16x8 At[4][2], B0[2][2], B1[2][2];
    const char* cA = (const char*)g.A + (size_t)cur.pm * tstep; const char* cB = (const char*)g.Bt + (size_t)cur.pn * tstep;
    S.a_ready(cur);
    if constexpr (SP2) {
        PG8_STAGE(PG8_SB(0, 0), cB, voffB); PG8_STAGE(PG8_SB(0, 1), cB + hstep, voffB); PG8_STAGE(PG8_SA(0, 0), cA, voffA); PG8_STAGE(PG8_SA(0, 1), cA + hstep, voffA);
        if (wr == 1) PG8_BAR;
        PG8_WAIT_V(2); PG8_BAR;
        PG8_STAGE(PG8_SB(1, 0), cB + kstep, voffB); PG8_STAGE(PG8_SA(1, 0), cA + kstep, voffA); PG8_STAGE(PG8_SB(1, 1), cB + hstep + kstep, voffB);
        PG8_WAIT_V(6); PG8_BAR;
    } else {
        PG8_STAGE(PG8_SB(0, 0), cB, voffB); PG8_STAGE(PG8_SA(0, 0), cA, voffA); PG8_STAGE(PG8_SB(0, 1), cB + hstep, voffB); PG8_STAGE(PG8_SA(0, 1), cA + hstep, voffA);
        if (wr == 1) PG8_BAR;
        PG8_WAIT_V(4); PG8_BAR;
        PG8_STAGE(PG8_SB(1, 0), cB + kstep, voffB); PG8_STAGE(PG8_SA(1, 0), cA + kstep, voffA); PG8_STAGE(PG8_SB(1, 1), cB + hstep + kstep, voffB);
        PG8_WAIT_V(6); PG8_BAR;
    }
    for (;;) {
        const bool has_next = S.next(ui + 1, nxt);
        const char* nA = has_next ? (const char*)g.A + (size_t)nxt.pm * tstep : cA; const char* nB = has_next ? (const char*)g.Bt + (size_t)nxt.pn * tstep : cB;
        for (int t = 0; t < nt; t += 2) {
            const bool last = (t == nt - 2);
            const char* a1 = cA + (size_t)(t + 1) * kstep;
            const char* a2 = last ? nA : cA + (size_t)(t + 2) * kstep; const char* b2 = last ? nB : cB + (size_t)(t + 2) * kstep;
            const char* a3 = a2 + kstep; const char* b3 = b2 + kstep;
            if (last && has_next) S.a_ready(nxt);
            if constexpr (SP2) {
            PG8_LDB(B0, 0, 0); PG8_LDB(B1, 0, 1); PG8_SCHED; PG8_LDA(At, 0, 0); PG8_STAGE(PG8_SA(1, 1), a1 + hstep, voffA);
            PG8_WAIT_V(8); PG8_WAIT_L(0); PG8_BAR; PG8_MMA(0, 0, At, B0); PG8_MMA(0, 1, At, B1); PG8_BAR; PG8_SCHED;
            PG8_LDA(At, 0, 1); PG8_STAGE(PG8_SB(0, 0), b2, voffB); PG8_STAGE(PG8_SB(0, 1), b2 + hstep, voffB); PG8_STAGE(PG8_SA(0, 0), a2, voffA);
            PG8_WAIT_V(8); PG8_WAIT_L(0); PG8_BAR; PG8_MMA(1, 0, At, B0); PG8_MMA(1, 1, At, B1); PG8_BAR; PG8_SCHED;
            PG8_LDB(B0, 1, 0); PG8_LDB(B1, 1, 1); PG8_SCHED; PG8_LDA(At, 1, 0); PG8_STAGE(PG8_SA(0, 1), a2 + hstep, voffA);
            PG8_WAIT_V(8); PG8_WAIT_L(0); PG8_BAR; PG8_MMA(0, 0, At, B0); PG8_MMA(0, 1, At, B1); PG8_BAR; PG8_SCHED;
            PG8_LDA(At, 1, 1); PG8_STAGE(PG8_SB(1, 0), b3, voffB); PG8_STAGE(PG8_SB(1, 1), b3 + hstep, voffB); PG8_STAGE(PG8_SA(1, 0), a3, voffA);
            PG8_WAIT_V(8); PG8_WAIT_L(0); PG8_BAR; PG8_MMA(1, 0, At, B0); PG8_MMA(1, 1, At, B1); PG8_BAR; PG8_SCHED;
            } else {
            PG8_LDB(B0, 0, 0); PG8_SCHED; PG8_LDA(At, 0, 0); PG8_STAGE(PG8_SA(1, 1), a1 + hstep, voffA);
            PG8_WAIT_L(8); PG8_BAR; PG8_WAIT_L(0); PG8_MMA(0, 0, At, B0); PG8_BAR; PG8_SCHED;
            PG8_LDB(B1, 0, 1); PG8_STAGE(PG8_SB(0, 0), b2, voffB);
            PG8_BAR; PG8_WAIT_L(0); PG8_MMA(0, 1, At, B1); PG8_BAR;
            PG8_LDA(At, 0, 1); PG8_STAGE(PG8_SA(0, 0), a2, voffA);
            PG8_BAR; PG8_WAIT_L(0); PG8_MMA(1, 0, At, B0); PG8_BAR; PG8_SCHED;
            PG8_STAGE(PG8_SB(0, 1), b2 + hstep, voffB);
            PG8_WAIT_V(6); PG8_BAR; PG8_MMA(1, 1, At, B1); PG8_BAR;
            PG8_LDB(B0, 1, 0); PG8_SCHED; PG8_LDA(At, 1, 0); PG8_STAGE(PG8_SA(0, 1), a2 + hstep, voffA);
            PG8_WAIT_L(8); PG8_BAR; PG8_WAIT_L(0); PG8_MMA(0, 0, At, B0); PG8_BAR; PG8_SCHED;
            PG8_LDB(B1, 1, 1); PG8_STAGE(PG8_SB(1, 0), b3, voffB);
            PG8_BAR; PG8_WAIT_L(0); PG8_MMA(0, 1, At, B1); PG8_BAR;
            PG8_LDA(At, 1, 1); PG8_STAGE(PG8_SA(1, 0), a3, voffA);
            PG8_BAR; PG8_WAIT_L(0); PG8_MMA(1, 0, At, B0); PG8_BAR; PG8_SCHED;
            PG8_STAGE(PG8_SB(1, 1), b3 + hstep, voffB);
            PG8_WAIT_V(6); PG8_BAR; PG8_MMA(1, 1, At, B1); PG8_BAR;
            }
        }
        if constexpr (ALIGN_EPI) { if (wr == 0) PG8_BAR; }
        if constexpr (!Epi::AFTER_DRAIN) { E(acc, cur, wr, wc, fr, fq); S.done(cur); }
        if (!has_next) break;
#pragma unroll
        for (int a = 0; a < 2; ++a)
#pragma unroll
            for (int b = 0; b < 2; ++b)
#pragma unroll
                for (int m = 0; m < 4; ++m)
#pragma unroll
                    for (int n = 0; n < 2; ++n) acc[a][b][m][n] = (f32x4){0.f, 0.f, 0.f, 0.f};
        cur = nxt; cA = nA; cB = nB; ++ui;
        if constexpr (ALIGN_EPI) { if (wr == 1) PG8_BAR; }
    }
    PG8_WAIT_V(0);
    if constexpr (!ALIGN_EPI) { if (wr == 0) PG8_BAR; }
    PG8_BAR;
    if constexpr (Epi::AFTER_DRAIN) { E.fused(acc, cur, wr, wc, fr, fq, lds, wid, lane); S.done(cur); }
#undef PG8_SA
#undef PG8_SB
#undef PG8_STAGE
#undef PG8_LDA
#undef PG8_LDB
#undef PG8_MMA
#undef PG8_WAIT_V
#undef PG8_WAIT_L
#undef PG8_BAR
#undef PG8_SCHED
}
}

#ifndef PG8_SP2
#define PG8_SP2 true
#endif
#ifndef PG8_ALIGN
#define PG8_ALIGN true
#endif
constexpr int NWAVES = 8;
constexpr int NPH = 15;
#ifndef MK_N_LAUNCHES
#define MK_N_LAUNCHES 1
#endif
constexpr int N_LAUNCHES = MK_N_LAUNCHES;

constexpr int BATCH = 2, SEQ = 16384, DM = 1024, DEPTH = 2;
constexpr int M = BATCH * SEQ;
constexpr int INW = 2824;
constexpr int NP = 3072;
constexpr int QOFF = 0, KOFF = 256, VOFF = 512, ZOFF = 768, XOFF = 1280, SBOFF = 2048, SCOFF = 2304, SVOFF = 2560, DTOFF = 2816;
constexpr int NCHUNK = SEQ / 64;
constexpr float EPS = 1e-6f;
constexpr float SB_EXIT = -104.0f;

constexpr size_t MiB = 1u << 20;
constexpr size_t WS_CTL = 0, CTL_ZERO_BYTES = 1 * MiB;
constexpr size_t WS_WIN = 2 * MiB;
constexpr size_t WS_WOUT = 14 * MiB;
constexpr size_t WS_WS = 18 * MiB;
constexpr size_t WS_SS2 = 22 * MiB;
constexpr size_t WS_EA = 24 * MiB;
constexpr size_t WS_CD = 25 * MiB;
constexpr size_t WS_CC = 26 * MiB;
constexpr size_t WS_U8 = 34 * MiB;
constexpr size_t WS_V8 = 66 * MiB;
constexpr size_t WS_US = 25 * MiB + 128 * 1024;
constexpr size_t WS_VS = 25 * MiB + 256 * 1024;
constexpr size_t WS_RS1 = 25 * MiB + 512 * 1024;
constexpr size_t WS_XB = 98 * MiB;
constexpr size_t WS_XNY = 162 * MiB;
constexpr size_t WS_P = 226 * MiB;
constexpr size_t WS_SC = WS_P, WS_X1B = WS_P + 128 * MiB;
constexpr size_t WS_ST = 418 * MiB;
constexpr size_t WS_END = 482 * MiB;
constexpr int CW_BAR = 4096;

constexpr int LDS_BYTES = 163840;
constexpr int LDSCTL_OFF = 161792, MISC_OFF = LDSCTL_OFF + 320;
static_assert(MISC_OFF + 128 <= LDS_BYTES, "LDS map");

#define GAS __attribute__((address_space(1)))
#define LAS __attribute__((address_space(3)))
typedef unsigned short bf16;
typedef unsigned v4u __attribute__((ext_vector_type(4)));
typedef unsigned v2u __attribute__((ext_vector_type(2)));
typedef float f32x4 __attribute__((ext_vector_type(4)));
typedef GAS unsigned gu32;
#define RLX_AGENT __ATOMIC_RELAXED, __HIP_MEMORY_SCOPE_AGENT
#define LDS_WAIT() asm volatile("s_waitcnt lgkmcnt(0)" ::: "memory")
#define VM_WAIT() asm volatile("s_waitcnt vmcnt(0)" ::: "memory")
__device__ __forceinline__ unsigned f2bf(float f) { unsigned u = __builtin_bit_cast(unsigned, f); return (u + 0x7fffu + ((u >> 16) & 1u)) >> 16; }
__device__ __forceinline__ unsigned pk2(float lo, float hi) { return f2bf(lo) | (f2bf(hi) << 16); }
__device__ __forceinline__ float bflo(unsigned u) { return __uint_as_float(u << 16); }
__device__ __forceinline__ float bfhi(unsigned u) { return __uint_as_float(u & 0xffff0000u); }
__device__ __forceinline__ float bf2f(bf16 h) { return __uint_as_float(((unsigned)h) << 16); }
__device__ __forceinline__ void unpack8(const v4u v, float (&f)[8]) { f[0] = bflo(v.x); f[1] = bfhi(v.x); f[2] = bflo(v.y); f[3] = bfhi(v.y); f[4] = bflo(v.z); f[5] = bfhi(v.z); f[6] = bflo(v.w); f[7] = bfhi(v.w); }
__device__ __forceinline__ v4u pack8(const float (&f)[8]) { v4u o; o.x = pk2(f[0], f[1]); o.y = pk2(f[2], f[3]); o.z = pk2(f[4], f[5]); o.w = pk2(f[6], f[7]); return o; }
__device__ __forceinline__ float wave_sum(float v) {
#pragma unroll
    for (int o = 1; o < 64; o <<= 1) v += __shfl_xor(v, o);
    return v;
}
template <int CTRL> __device__ __forceinline__ float dppf(float x) { return __int_as_float(__builtin_amdgcn_update_dpp(0, __float_as_int(x), CTRL, 0xf, 0xf, false)); }
__device__ __forceinline__ float sum_x16(float x) { const auto r = __builtin_amdgcn_permlane16_swap(__float_as_uint(x), __float_as_uint(x), false, false); return __uint_as_float(r[0]) + __uint_as_float(r[1]); }
__device__ __forceinline__ float sum_x32(float x) { const auto r = __builtin_amdgcn_permlane32_swap(__float_as_uint(x), __float_as_uint(x), false, false); return __uint_as_float(r[0]) + __uint_as_float(r[1]); }
__device__ __forceinline__ float wave_sum_v(float x) { x += dppf<0xB1>(x); x += dppf<0x4E>(x); x += dppf<0x141>(x); x += dppf<0x128>(x); x = sum_x16(x); return sum_x32(x); }
__device__ __forceinline__ float silu_f(float x) { return x / (1.0f + __expf(-x)); }

#define XB_TMO      128
#define XB_XCNT(j)  (256  + 64 * (j))
#define XB_XSUB(j)  (1280 + 64 * (j))
#define XB_XGEN(j)  (2304 + 64 * (j))
#define XB_TOP      3328
#define XB_TOPGEN   3392
#define XCD_BAR_WORDS 3456
#define XB_SPIN_CAP (1u << 18)

__device__ __forceinline__ unsigned xb_ld(unsigned* p)              { return __hip_atomic_load(p, __ATOMIC_RELAXED, __HIP_MEMORY_SCOPE_AGENT); }
__device__ __forceinline__ unsigned xb_add(unsigned* p, unsigned v) { return __hip_atomic_fetch_add(p, v, __ATOMIC_RELAXED, __HIP_MEMORY_SCOPE_AGENT); }
__device__ __forceinline__ unsigned xb_xcc_id() { return (unsigned)__builtin_amdgcn_s_getreg((3 << 11) | 20) & 0xFu; }
#define XB_SPIN(cond, bar) do { unsigned _sp = 0; while (cond) { __builtin_amdgcn_s_sleep(1); \
    if ((++_sp & 255u) == 0u) { if (xb_ld(&(bar)[XB_TMO])) break; if (_sp > XB_SPIN_CAP) { atomicAdd(&(bar)[XB_TMO], 1u); break; } } } } while (0)

struct XcdBarrier {
    unsigned* bar; unsigned x;
    volatile LAS unsigned* st;
};

__device__ __forceinline__ XcdBarrier xcd_barrier_post(unsigned* bar, volatile LAS unsigned* st) {
    XcdBarrier b; b.bar = bar; b.x = xb_xcc_id(); b.st = st;
    if (threadIdx.x == 0) (void)xb_add(&bar[XB_XCNT(b.x)], 1u);
    return b;
}
__device__ __forceinline__ void xcd_barrier_complete(unsigned* bar, unsigned x, unsigned& nloc, unsigned& nx) {
    const unsigned G = gridDim.x * gridDim.y * gridDim.z;
    unsigned sum, cnt, mine, sp = 0u;
    for (;;) {
        sum = 0u; cnt = 0u; mine = 0u;
#pragma unroll
        for (unsigned j = 0; j < 16; ++j) { const unsigned c = xb_ld(&bar[XB_XCNT(j)]); sum += c; cnt += (c > 0u) ? 1u : 0u; mine = (j == x) ? c : mine; }
        if (sum == G) break;
        __builtin_amdgcn_s_sleep(1);
        if ((++sp & 255u) == 0u) { if (xb_ld(&bar[XB_TMO])) break; if (sp > XB_SPIN_CAP) { atomicAdd(&bar[XB_TMO], 1u); break; } }
    }
    nloc = mine > 0u ? mine : 1u; nx = cnt > 0u ? cnt : 1u;
}

__device__ __forceinline__ void xcd_barrier(const XcdBarrier& b) {
    asm volatile("s_waitcnt vmcnt(0)" ::: "memory");
    __syncthreads();
    if (threadIdx.x == 0) {
        unsigned* bar = b.bar;
        __builtin_amdgcn_s_waitcnt(0);
        unsigned nloc = b.st[0], nx = b.st[1];
        if (nloc == 0u) { xcd_barrier_complete(bar, b.x, nloc, nx); b.st[0] = nloc; b.st[1] = nx; }
        const unsigned old = xb_add(&bar[XB_XSUB(b.x)], 1u);
        const unsigned gen = old / nloc;
        if (old + 1u == (gen + 1u) * nloc) {
            __builtin_amdgcn_fence(__ATOMIC_RELEASE, "agent");
            asm volatile("s_waitcnt vmcnt(0)" ::: "memory");
            const unsigned og = xb_add(&bar[XB_TOP], 1u);
            const unsigned tg = og / nx;
            if (og + 1u == (tg + 1u) * nx) xb_add(&bar[XB_TOPGEN], 1u);
            else XB_SPIN(xb_ld(&bar[XB_TOPGEN]) == tg, bar);
            __builtin_amdgcn_fence(__ATOMIC_ACQUIRE, "agent");
            xb_add(&bar[XB_XGEN(b.x)], 1u);
            asm volatile("s_waitcnt vmcnt(0)" ::: "memory");
        } else {
            XB_SPIN(xb_ld(&bar[XB_XGEN(b.x)]) == gen, bar);
            __builtin_amdgcn_fence(__ATOMIC_ACQUIRE, "agent");
            asm volatile("s_waitcnt vmcnt(0)" ::: "memory");
        }
    }
    __syncthreads();
}

struct Ctx { LAS unsigned char* lds; int tid, lane, wave, vcu, G; };

__device__ __forceinline__ int win_colmap(int n) { return n < 2048 ? n : (n < 2816 ? n + 8 : (n < INW ? n - 2816 + 2048 : -1)); }
__device__ __forceinline__ void tr_item(const float* W, int Nsrc, int K, bf16* WT, const float* rowscale, LAS float* scr, int kb, int nb, int lane, bool mapped) {
    const int k0 = 64 * kb, n0 = 32 * nb; const int n = n0 + (lane & 31); const int sc = mapped ? win_colmap(n) : n;
#pragma unroll 8
    for (int i = 0; i < 32; ++i) { const int kk = 2 * i + (lane >> 5); float v = 0.f; if (sc >= 0) { v = W[(size_t)(k0 + kk) * Nsrc + sc]; if (rowscale) v *= rowscale[k0 + kk]; } scr[kk * 33 + (lane & 31)] = v; }
    LDS_WAIT(); asm volatile("" ::: "memory");
    const int c = lane & 7;
#pragma unroll
    for (int j = 0; j < 4; ++j) { const int nn = (lane >> 3) + 8 * j; const LAS float* s = scr + (8 * c) * 33 + nn;
        v4u o; o.x = pk2(s[0 * 33], s[1 * 33]); o.y = pk2(s[2 * 33], s[3 * 33]); o.z = pk2(s[4 * 33], s[5 * 33]); o.w = pk2(s[6 * 33], s[7 * 33]);
        *(GAS v4u*)(WT + (size_t)(n0 + nn) * K + k0 + 8 * c) = o; }
    LDS_WAIT(); asm volatile("" ::: "memory");
}
__device__ __forceinline__ void p0_prologue(const Ctx F, const float* x, const float* norm1_w, const float* w_in, const float* w_out, const float* norm2_w, const float* w_q, const float* sub_keys, unsigned char* ws) {
    bf16* WIN = (bf16*)(ws + WS_WIN); bf16* WOUT = (bf16*)(ws + WS_WOUT); bf16* WST = (bf16*)(ws + WS_WS);
    LAS float* scr = (LAS float*)(F.lds + F.wave * 16384);
    const int gw = F.vcu * NWAVES + F.wave, NGW = F.G * NWAVES;
    constexpr int I_IN = (DM / 64) * (NP / 32), I_OUT = (DM / 64) * (DM / 32);
    for (int it = gw; it < DEPTH * (I_IN + I_OUT); it += NGW) {
        int r = it;
        if (r < DEPTH * I_IN) { const int L = r / I_IN; r -= L * I_IN; tr_item(w_in + (size_t)L * DM * INW, INW, DM, WIN + (size_t)L * NP * DM, norm1_w + L * DM, scr, r / (NP / 32), r % (NP / 32), F.lane, true); }
        else { r -= DEPTH * I_IN; const int L = r / I_OUT; r -= L * I_OUT; tr_item(w_out + (size_t)L * DM * DM, DM, DM, WOUT + (size_t)L * DM * DM, nullptr, scr, r / (DM / 32), r % (DM / 32), F.lane, false); }
    }
    {
        typedef float f32x4w __attribute__((ext_vector_type(4)));
        const int fr = F.lane & 15, fq = F.lane >> 4;
        for (int u = gw; u < DEPTH * 8 * 64 * 2; u += NGW) {
            const int jh = u & 1, dt = (u >> 1) & 63, sl = (u >> 7) & 7, L = u >> 10, half = sl & 1;
            const float* Aq = w_q + (size_t)L * DM * DM + (size_t)(16 * dt + fr) * DM + sl * 128 + fq;
            const float* Bk = sub_keys + ((size_t)L * 2 + half) * 128 * 128 + (size_t)(64 * jh + fr) * 128 + fq;
            f32x4w acc[4];
#pragma unroll
            for (int j = 0; j < 4; ++j) acc[j] = (f32x4w){0.f, 0.f, 0.f, 0.f};
#pragma unroll 4
            for (int kk = 0; kk < 32; ++kk) { const float a = Aq[4 * kk];
#pragma unroll
                for (int j = 0; j < 4; ++j) acc[j] = __builtin_amdgcn_mfma_f32_16x16x4f32(a, Bk[(size_t)(16 * j) * 128 + 4 * kk], acc[j], 0, 0, 0); }
            const f32x4 w4 = *(const f32x4*)(norm2_w + L * DM + 16 * dt + 4 * fq);
#pragma unroll
            for (int j = 0; j < 4; ++j) *(v2u*)(WST + (size_t)L * DM * DM + (size_t)(sl * 128 + 64 * jh + 16 * j + fr) * DM + 16 * dt + 4 * fq) = (v2u){pk2(acc[j][0] * w4[0], acc[j][1] * w4[1]), pk2(acc[j][2] * w4[2], acc[j][3] * w4[3])};
        }
    }
    { bf16* XB = (bf16*)(ws + WS_XB); float* RS1 = (float*)(ws + WS_RS1);
    for (int m = gw; m < M; m += NGW) {
        const f32x4* xr = (const f32x4*)(x + (size_t)m * DM) + F.lane; f32x4 v[4]; float s = 0.f;
#pragma unroll
        for (int j = 0; j < 4; ++j) { v[j] = xr[64 * j]; s += (v[j][0] * v[j][0] + v[j][1] * v[j][1]) + (v[j][2] * v[j][2] + v[j][3] * v[j][3]); }
        const float rstd = 1.0f / sqrtf(wave_sum_v(s) * (1.0f / DM) + EPS);
        v2u* o8 = (v2u*)(XB + (size_t)m * DM) + F.lane;
#pragma unroll
        for (int j = 0; j < 4; ++j) { v2u o; o.x = pk2(v[j][0], v[j][1]); o.y = pk2(v[j][2], v[j][3]); o8[64 * j] = o; }
        if (F.lane == 0) RS1[m] = rstd;
    } }
}

typedef float f32x16 __attribute__((ext_vector_type(16)));
typedef short bf16x8 __attribute__((ext_vector_type(8)));
typedef short v4i16_t __attribute__((ext_vector_type(4)));
constexpr int AT_VS = 72;
__device__ __forceinline__ int crow(int r, int hi) { return (r & 3) + 8 * (r >> 2) + 4 * hi; }
__device__ __forceinline__ void attn_mfma(const Ctx F, const bf16* P, bf16* Y) {
    LAS bf16* vt = (LAS bf16*)(F.lds + F.wave * 8192);
    const int lane = F.lane, r32 = lane & 31, hi = lane >> 5;
    const int gw = F.vcu * NWAVES + F.wave, NGW = F.G * NWAVES;
    const LAS bf16* vrd = vt + (4 * hi + ((lane & 15) >> 2)) * AT_VS + 16 * ((lane >> 4) & 1) + 4 * (lane & 3);
#pragma unroll 1
    for (int u = gw; u < BATCH * 4 * (SEQ / 32); u += NGW) {
        const int qb = u & (SEQ / 32 - 1), bh = u / (SEQ / 32), h = bh & 3, b = bh >> 2;
        const int q0 = qb * 32; const size_t rowbase = (size_t)b * SEQ; const int t = q0 + r32;
        bf16x8 qf[4];
#pragma unroll
        for (int d0 = 0; d0 < 4; ++d0) { float f[8]; unpack8(*(const v4u*)(P + (rowbase + q0 + r32) * NP + QOFF + h * 64 + d0 * 16 + hi * 8), f);
#pragma unroll
            for (int i = 0; i < 8; ++i) f[i] *= 0.125f;
            qf[d0] = __builtin_bit_cast(bf16x8, pack8(f)); }
        f32x16 o0, o1;
#pragma unroll
        for (int r = 0; r < 16; ++r) { o0[r] = 0.f; o1[r] = 0.f; }
        float R = 0.f;
        int k0 = q0; bool diag = true;
        v4u kf[4], vr[4];
        { const bf16* kp = P + (rowbase + k0 + r32) * NP + KOFF + h * 64 + hi * 8; const bf16* vp = P + (rowbase + k0 + (lane >> 1)) * NP + VOFF + h * 64 + (lane & 1) * 32;
#pragma unroll
          for (int c = 0; c < 4; ++c) { kf[c] = *(const v4u*)(kp + c * 16); vr[c] = *(const v4u*)(vp + c * 8); } }
#pragma unroll 1
        for (;;) {
#pragma unroll
            for (int c = 0; c < 4; ++c) *(LAS v4u*)(vt + (lane >> 1) * AT_VS + (lane & 1) * 32 + c * 8) = vr[c];
            bf16x8 ka[4];
#pragma unroll
            for (int c = 0; c < 4; ++c) ka[c] = __builtin_bit_cast(bf16x8, kf[c]);
            const int kn = k0 - 32;
            if (kn >= 0) { const bf16* kp = P + (rowbase + kn + r32) * NP + KOFF + h * 64 + hi * 8; const bf16* vp = P + (rowbase + kn + (lane >> 1)) * NP + VOFF + h * 64 + (lane & 1) * 32;
#pragma unroll
                for (int c = 0; c < 4; ++c) { kf[c] = *(const v4u*)(kp + c * 16); vr[c] = *(const v4u*)(vp + c * 8); } }
            f32x16 p;
#pragma unroll
            for (int r = 0; r < 16; ++r) p[r] = 0.f;
#pragma unroll
            for (int d0 = 0; d0 < 4; ++d0) p = __builtin_amdgcn_mfma_f32_32x32x16_bf16(ka[d0], qf[d0], p, 0, 0, 0);
            float l[16], ee[16];
#pragma unroll
            for (int r = 0; r < 16; ++r) { const float z = p[r]; const float sp = fmaxf(z, 0.f) + __logf(1.0f + __expf(-fabsf(z)));
                const bool valid = !diag || (k0 + crow(r, hi) < t);
                l[r] = valid ? -sp : 0.f; ee[r] = valid ? (z - sp) : -INFINITY; }
            float gs[4], pg[4], tot[4], later[4];
#pragma unroll
            for (int g = 0; g < 4; ++g) { gs[g] = (l[4 * g] + l[4 * g + 1]) + (l[4 * g + 2] + l[4 * g + 3]); tot[g] = sum_x32(gs[g]); pg[g] = tot[g] - gs[g]; }
            later[3] = 0.f; later[2] = tot[3]; later[1] = tot[3] + tot[2]; later[0] = later[1] + tot[1];
            if (hi == 0) {
#pragma unroll
                for (int g = 0; g < 4; ++g) later[g] += pg[g]; }
#pragma unroll
            for (int g = 0; g < 4; ++g) { const float base = R + later[g];
                const float s3 = base, s2 = s3 + l[4 * g + 3], s1 = s2 + l[4 * g + 2], s0 = s1 + l[4 * g + 1];
                p[4 * g + 3] = __expf(ee[4 * g + 3] + s3); p[4 * g + 2] = __expf(ee[4 * g + 2] + s2); p[4 * g + 1] = __expf(ee[4 * g + 1] + s1); p[4 * g] = __expf(ee[4 * g] + s0); }
            R += (tot[0] + tot[1]) + (tot[2] + tot[3]);
            bf16x8 pb[2];
#pragma unroll
            for (int ks = 0; ks < 2; ++ks) { float f[8];
#pragma unroll
                for (int j = 0; j < 8; ++j) f[j] = p[8 * ks + j];
                pb[ks] = __builtin_bit_cast(bf16x8, pack8(f)); }
#pragma unroll
            for (int ks = 0; ks < 2; ++ks)
#pragma unroll
                for (int dt = 0; dt < 2; ++dt) {
                    const v4i16_t lo = __builtin_amdgcn_ds_read_tr16_b64_v4i16((LAS v4i16_t*)(vrd + (16 * ks) * AT_VS + 32 * dt));
                    const v4i16_t hi4 = __builtin_amdgcn_ds_read_tr16_b64_v4i16((LAS v4i16_t*)(vrd + (16 * ks + 8) * AT_VS + 32 * dt));
                    const bf16x8 va = (bf16x8){lo[0], lo[1], lo[2], lo[3], hi4[0], hi4[1], hi4[2], hi4[3]};
                    if (dt == 0) o0 = __builtin_amdgcn_mfma_f32_32x32x16_bf16(va, pb[ks], o0, 0, 0, 0); else o1 = __builtin_amdgcn_mfma_f32_32x32x16_bf16(va, pb[ks], o1, 0, 0, 0);
                }
            if (kn < 0 || __all(R < SB_EXIT)) break;
            k0 = kn; diag = false;
        }
        bf16* yp = Y + (rowbase + q0 + r32) * DM + h * 64;
#pragma unroll
        for (int g = 0; g < 4; ++g) { v2u a, c; a.x = pk2(o0[4 * g], o0[4 * g + 1]); a.y = pk2(o0[4 * g + 2], o0[4 * g + 3]); c.x = pk2(o1[4 * g], o1[4 * g + 1]); c.y = pk2(o1[4 * g + 2], o1[4 * g + 3]);
            *(v2u*)(yp + 8 * g + 4 * hi) = a; *(v2u*)(yp + 32 + 8 * g + 4 * hi) = c; }
    }
}
__device__ __forceinline__ void shortconv(const Ctx F, const bf16* P, bf16* Y, const float* cw  ) {
    for (long it = (long)F.vcu * 512 + F.tid; it < (long)(M / 8) * 32; it += (long)F.G * 512) {
        const size_t row0 = (size_t)(it >> 5) * 8; const int c0 = (int)(it & 31) * 8; const int t0 = (int)(row0 & (SEQ - 1));
        v4u cr[10], vr[10], br[8];
#pragma unroll
        for (int j = 0; j < 10; ++j) { const bool ok = (j >= 2) || (t0 > 0);
            cr[j] = ok ? *(const v4u*)(P + (row0 + j - 2) * NP + SCOFF + c0) : (v4u){0u, 0u, 0u, 0u}; vr[j] = ok ? *(const v4u*)(P + (row0 + j - 2) * NP + SVOFF + c0) : (v4u){0u, 0u, 0u, 0u}; }
#pragma unroll
        for (int j = 0; j < 8; ++j) br[j] = *(const v4u*)(P + (row0 + j) * NP + SBOFF + c0);
        float w[3][8];
#pragma unroll
        for (int k = 0; k < 3; ++k) { const f32x4 w0 = *(const f32x4*)(cw + k * 256 + c0), w1 = *(const f32x4*)(cw + k * 256 + c0 + 4);
#pragma unroll
            for (int i = 0; i < 4; ++i) { w[k][i] = w0[i]; w[k][4 + i] = w1[i]; } }
        float cv[10][8];
#pragma unroll
        for (int j = 0; j < 10; ++j) { float c8[8], v8[8]; unpack8(cr[j], c8); unpack8(vr[j], v8);
#pragma unroll
            for (int i = 0; i < 8; ++i) cv[j][i] = c8[i] * v8[i]; }
#pragma unroll
        for (int j = 0; j < 8; ++j) { float b8[8], o[8]; unpack8(br[j], b8);
#pragma unroll
            for (int i = 0; i < 8; ++i) o[i] = b8[i] * (w[0][i] * cv[j][i] + w[1][i] * cv[j + 1][i] + w[2][i] * cv[j + 2][i]);
            *(v4u*)(Y + (row0 + j) * DM + 768 + c0) = pack8(o); }
    }
}
constexpr int XTS = 72, BNS = 136;
constexpr int L_XT = 0, L_BN = L_XT + 512 * XTS * 2, L_BT = L_BN + 64 * BNS * 2, L_CN = L_BT + 128 * XTS * 2, L_GG = L_CN + 64 * BNS * 2, L_DT = L_GG + 128 * XTS * 2, L_ACS = L_DT + 2048, L_WL = L_ACS + 2048, L_SSD_END = L_WL + 2048;
static_assert(L_SSD_END <= LDSCTL_OFF, "SSD part 1 LDS");
typedef float f32x4v __attribute__((ext_vector_type(4)));
__device__ __forceinline__ void ssd_part1(const Ctx F, const bf16* P, bf16* Y, const float* cw  , const float* cb  , const float* dt_bias, const float* A_log, const float* Dp,
                                          bf16* CC, float* EA, float* CD, bf16* ST) {
    LAS bf16* XT = (LAS bf16*)(F.lds + L_XT); LAS bf16* BN = (LAS bf16*)(F.lds + L_BN); LAS bf16* BT = (LAS bf16*)(F.lds + L_BT); LAS bf16* CN = (LAS bf16*)(F.lds + L_CN); LAS bf16* GG = (LAS bf16*)(F.lds + L_GG);
    LAS float* DTH = (LAS float*)(F.lds + L_DT); LAS float* ACH = (LAS float*)(F.lds + L_ACS); LAS float* WLH = (LAS float*)(F.lds + L_WL);
    const int lane = F.lane, fr = lane & 15, fq = lane >> 4;
#pragma unroll 1
    for (int u = F.vcu; u < BATCH * NCHUNK; u += F.G) {
        const int b = u / NCHUNK, c = u % NCHUNK, t0 = c * 64; const size_t r0 = (size_t)b * SEQ + t0;
        __syncthreads();
        if (F.tid < 384) { const int ch = 2 * F.tid;
            float w0[4], w1[4];
#pragma unroll
            for (int k = 0; k < 4; ++k) { w0[k] = cw[k * 768 + ch]; w1[k] = cw[k * 768 + ch + 1]; }
            const float b0 = cb[ch], b1 = cb[ch + 1];
            const bf16* pin = P + ((size_t)b * SEQ + t0) * NP + XOFF + ch;
            unsigned h0 = 0u, h1 = 0u, h2 = 0u;
            if (t0 > 0) { h0 = *(const unsigned*)(pin - 3 * (ptrdiff_t)NP); h1 = *(const unsigned*)(pin - 2 * (ptrdiff_t)NP); h2 = *(const unsigned*)(pin - (ptrdiff_t)NP); }
#pragma unroll 1
            for (int tq = 0; tq < 4; ++tq) {
                unsigned r[16];
#pragma unroll
                for (int j = 0; j < 16; ++j) r[j] = *(const unsigned*)(pin + (size_t)(16 * tq + j) * NP);
#pragma unroll
                for (int tg4 = 0; tg4 < 4; ++tg4) { const int tg = 4 * tq + tg4;
                    const unsigned in[7] = {tg4 == 0 ? h0 : r[4 * tg4 - 3], tg4 == 0 ? h1 : r[4 * tg4 - 2], tg4 == 0 ? h2 : r[4 * tg4 - 1], r[4 * tg4], r[4 * tg4 + 1], r[4 * tg4 + 2], r[4 * tg4 + 3]};
                    float y0[4], y1[4];
#pragma unroll
                    for (int j = 0; j < 4; ++j) { float a0 = b0, a1 = b1;
#pragma unroll
                        for (int k = 0; k < 4; ++k) { a0 += w0[k] * bflo(in[j + k]); a1 += w1[k] * bfhi(in[j + k]); }
                        y0[j] = silu_f(a0); y1[j] = silu_f(a1); }
                    const v2u t0v = (v2u){pk2(y0[0], y0[1]), pk2(y0[2], y0[3])}, t1v = (v2u){pk2(y1[0], y1[1]), pk2(y1[2], y1[3])};
                    if (ch < 512) { *(LAS v2u*)(XT + ch * XTS + 4 * tg) = t0v; *(LAS v2u*)(XT + (ch + 1) * XTS + 4 * tg) = t1v; }
                    else if (ch < 640) { const int nb = ch - 512; *(LAS v2u*)(BT + nb * XTS + 4 * tg) = t0v; *(LAS v2u*)(BT + (nb + 1) * XTS + 4 * tg) = t1v;
#pragma unroll
                        for (int j = 0; j < 4; ++j) *(LAS unsigned*)(BN + (4 * tg + j) * BNS + nb) = pk2(y0[j], y1[j]); }
                    else { const int nc = ch - 640;
#pragma unroll
                        for (int j = 0; j < 4; ++j) { const unsigned pk = pk2(y0[j], y1[j]); *(LAS unsigned*)(CN + (4 * tg + j) * BNS + nc) = pk; *(unsigned*)(CC + (r0 + 4 * tg + j) * 128 + nc) = pk; } }
                }
                h0 = r[13]; h1 = r[14]; h2 = r[15];
            }
        }
        { const int h = F.wave, l = lane; const float xx = bf2f(P[(r0 + l) * NP + DTOFF + h]) + dt_bias[h]; const float dt = xx > 20.f ? xx : log1pf(__expf(xx));
          const float A = -__expf(A_log[h]); float cs = dt * A;
#pragma unroll
          for (int o = 1; o < 64; o <<= 1) { const float tmp = __shfl_up(cs, o); if (l >= o) cs += tmp; }
          const float last = __shfl(cs, 63);
          DTH[h * 64 + l] = dt; ACH[h * 64 + l] = cs; WLH[h * 64 + l] = __expf(last - cs) * dt;
          EA[(r0 + l) * 8 + h] = __expf(cs); if (l == 63) CD[(size_t)u * 8 + h] = __expf(cs); }
        __syncthreads();
        { const int g = F.wave >> 2, mt = F.wave & 3;
          const bf16x8 c0 = *(const LAS bf16x8*)(CN + (16 * mt + fr) * BNS + g * 64 + 8 * fq), c1 = *(const LAS bf16x8*)(CN + (16 * mt + fr) * BNS + g * 64 + 32 + 8 * fq);
#pragma unroll 1
          for (int nt = 0; nt <= mt; ++nt) {
              const bf16x8 b0 = *(const LAS bf16x8*)(BN + (16 * nt + fr) * BNS + g * 64 + 8 * fq), b1 = *(const LAS bf16x8*)(BN + (16 * nt + fr) * BNS + g * 64 + 32 + 8 * fq);
              f32x4v acc = (f32x4v){0.f, 0.f, 0.f, 0.f};
              acc = __builtin_amdgcn_mfma_f32_16x16x32_bf16(b0, c0, acc, 0, 0, 0); acc = __builtin_amdgcn_mfma_f32_16x16x32_bf16(b1, c1, acc, 0, 0, 0);
              *(LAS v2u*)(GG + (g * 64 + 16 * mt + fr) * XTS + 16 * nt + 4 * fq) = (v2u){pk2(acc[0], acc[1]), pk2(acc[2], acc[3])}; } }
        __syncthreads();
        { const int h = F.wave, g = h >> 2;
          bf16x8 xa[4][2];
#pragma unroll
          for (int nt = 0; nt < 4; ++nt)
#pragma unroll
              for (int ks = 0; ks < 2; ++ks) xa[nt][ks] = *(const LAS bf16x8*)(XT + (h * 64 + 16 * nt + fr) * XTS + 32 * ks + 8 * fq);
          {
            f32x4v acc[4][4];
#pragma unroll
            for (int nt = 0; nt < 4; ++nt)
#pragma unroll
                for (int mt = 0; mt < 4; ++mt) acc[nt][mt] = (f32x4v){0.f, 0.f, 0.f, 0.f};
#pragma unroll
            for (int mt = 0; mt < 4; ++mt)
#pragma unroll
                for (int ks = 0; ks < 2; ++ks) if (32 * ks <= 16 * mt + 15) {
                    const int l = 16 * mt + fr, s0 = 32 * ks + 8 * fq;
                    float gf[8]; unpack8(*(const LAS v4u*)(GG + (g * 64 + l) * XTS + s0), gf);
                    const float al = ACH[h * 64 + l]; const f32x4 a0 = *(const LAS f32x4*)(ACH + h * 64 + s0), a1 = *(const LAS f32x4*)(ACH + h * 64 + s0 + 4), d0 = *(const LAS f32x4*)(DTH + h * 64 + s0), d1 = *(const LAS f32x4*)(DTH + h * 64 + s0 + 4);
                    float mf[8];
#pragma unroll
                    for (int j = 0; j < 4; ++j) { mf[j] = (s0 + j <= l) ? gf[j] * __expf(al - a0[j]) * d0[j] : 0.f; mf[4 + j] = (s0 + 4 + j <= l) ? gf[4 + j] * __expf(al - a1[j]) * d1[j] : 0.f; }
                    const bf16x8 mfr = __builtin_bit_cast(bf16x8, pack8(mf));
#pragma unroll
                    for (int nt = 0; nt < 4; ++nt) acc[nt][mt] = __builtin_amdgcn_mfma_f32_16x16x32_bf16(xa[nt][ks], mfr, acc[nt][mt], 0, 0, 0);
                }
            const float Dh = Dp[h];
#pragma unroll
            for (int mt = 0; mt < 4; ++mt)
#pragma unroll
                for (int nt = 0; nt < 4; ++nt) { const int l = 16 * mt + fr, p0 = 16 * nt + 4 * fq; float o[4];
#pragma unroll
                    for (int r = 0; r < 4; ++r) o[r] = acc[nt][mt][r] + Dh * bf2f(XT[(h * 64 + p0 + r) * XTS + l]);
                    *(v2u*)(Y + (r0 + l) * DM + 256 + h * 64 + p0) = (v2u){pk2(o[0], o[1]), pk2(o[2], o[3])}; }
          }
          {
#pragma unroll
            for (int ks = 0; ks < 2; ++ks) { const f32x4 w0 = *(const LAS f32x4*)(WLH + h * 64 + 32 * ks + 8 * fq), w1 = *(const LAS f32x4*)(WLH + h * 64 + 32 * ks + 8 * fq + 4);
#pragma unroll
                for (int nt = 0; nt < 4; ++nt) { float f[8]; unpack8(__builtin_bit_cast(v4u, xa[nt][ks]), f);
#pragma unroll
                    for (int j = 0; j < 4; ++j) { f[j] *= w0[j]; f[4 + j] *= w1[j]; }
                    xa[nt][ks] = __builtin_bit_cast(bf16x8, pack8(f)); } }
            f32x4v acc[4][4];
#pragma unroll
            for (int n4 = 0; n4 < 4; ++n4)
#pragma unroll
                for (int pt = 0; pt < 4; ++pt) acc[n4][pt] = (f32x4v){0.f, 0.f, 0.f, 0.f};
#pragma unroll
            for (int n4 = 0; n4 < 4; ++n4)
#pragma unroll
                for (int ks = 0; ks < 2; ++ks) { const bf16x8 bt = *(const LAS bf16x8*)(BT + (g * 64 + 16 * n4 + fr) * XTS + 32 * ks + 8 * fq);
#pragma unroll
                    for (int pt = 0; pt < 4; ++pt) acc[n4][pt] = __builtin_amdgcn_mfma_f32_16x16x32_bf16(bt, xa[pt][ks], acc[n4][pt], 0, 0, 0); }
#pragma unroll
            for (int n4 = 0; n4 < 4; ++n4)
#pragma unroll
                for (int pt = 0; pt < 4; ++pt) *(v2u*)(ST + (((size_t)u * 8 + h) * 64 + 16 * pt + fr) * 64 + 16 * n4 + 4 * fq) = (v2u){pk2(acc[n4][pt][0], acc[n4][pt][1]), pk2(acc[n4][pt][2], acc[n4][pt][3])};
          }
        }
    }
    __syncthreads();
}
__device__ __forceinline__ void convert_tables(const int lane, const float* pu, const float* pv, unsigned char* ws, int L, int wid, int nw) {
    unsigned char* U8 = ws + WS_U8; unsigned char* V8 = ws + WS_V8; float* USc = (float*)(ws + WS_US); float* VSc = (float*)(ws + WS_VS);
#pragma unroll 1
    for (int r = wid; r < 2 * 16384; r += nw) {
        const bool isv = r >= 16384; const int rr = L * 16384 + (isv ? r - 16384 : r); const float* src = (isv ? pv : pu) + (size_t)rr * DM + lane * 16;
        f32x4 v[4]; float am = 0.f;
#pragma unroll
        for (int j = 0; j < 4; ++j) { v[j] = *(const f32x4*)(src + 4 * j); am = fmaxf(am, fmaxf(fmaxf(fabsf(v[j][0]), fabsf(v[j][1])), fmaxf(fabsf(v[j][2]), fabsf(v[j][3])))); }
        am = fmaxf(am, dppf<0xB1>(am)); am = fmaxf(am, dppf<0x4E>(am)); am = fmaxf(am, dppf<0x141>(am)); am = fmaxf(am, dppf<0x128>(am));
        { const auto r16 = __builtin_amdgcn_permlane16_swap(__float_as_uint(am), __float_as_uint(am), false, false); am = fmaxf(__uint_as_float(r16[0]), __uint_as_float(r16[1]));
          const auto r32 = __builtin_amdgcn_permlane32_swap(__float_as_uint(am), __float_as_uint(am), false, false); am = fmaxf(__uint_as_float(r32[0]), __uint_as_float(r32[1])); }
        int ex = 0; if (am > 0.f) (void)frexpf(am, &ex); else ex = 8;
        const float sc = ldexpf(1.0f, 8 - ex), isc = ldexpf(1.0f, ex - 8);
        v4u o;
#pragma unroll
        for (int j = 0; j < 4; ++j) { int w = 0; w = __builtin_amdgcn_cvt_pk_fp8_f32(v[j][0] * sc, v[j][1] * sc, w, false); w = __builtin_amdgcn_cvt_pk_fp8_f32(v[j][2] * sc, v[j][3] * sc, w, true); o[j] = (unsigned)w; }
        *(v4u*)((isv ? V8 : U8) + (size_t)rr * DM + lane * 16) = o;
        if (lane == 0) (isv ? VSc : USc)[rr] = isc;
    }
}
__device__ __forceinline__ void ssd_scan(const Ctx F, bf16* ST, const float* CD, bool dry) {
    if (F.tid < 128) for (int e = F.vcu * 128 + F.tid; e < BATCH * 16384; e += F.G * 128) {
        const int b = e >> 14, hpn2 = e & 16383, h = hpn2 >> 11; float r0 = 0.f, r1 = 0.f;
        unsigned* sp = (unsigned*)ST + ((size_t)b * NCHUNK << 14) + hpn2; const float* dp = CD + (size_t)b * NCHUNK * 8 + h;
#pragma unroll 1
        for (int c = 0; c < NCHUNK; c += 32) { unsigned s[32]; float d[32];
#pragma unroll
            for (int i = 0; i < 32; ++i) { s[i] = sp[(size_t)(c + i) << 14]; d[i] = dp[(c + i) * 8]; }
#pragma unroll
            for (int i = 0; i < 32; ++i) { if (!dry) sp[(size_t)(c + i) << 14] = pk2(r0, r1); r0 = r0 * d[i] + bflo(s[i]); r1 = r1 * d[i] + bfhi(s[i]); } }
        asm volatile("" :: "v"(r0), "v"(r1));
    }
}
__device__ __forceinline__ void ssd_part2(const Ctx F, const bf16* P, bf16* Y, const bf16* CC, const float* EA, const bf16* ST, const float* nw  , bool dry) {
    LAS float* SSH = (LAS float*)F.lds;
    const int lane = F.lane, fr = lane & 15, fq = lane >> 4, h = F.wave, g = h >> 2;
#pragma unroll 1
    for (int u = F.vcu; u < BATCH * NCHUNK; u += F.G) {
        const int b = u / NCHUNK, c = u % NCHUNK; const size_t r0 = (size_t)b * SEQ + c * 64;
        bf16x8 pa[4][2], cbf[4][2];
#pragma unroll
        for (int pt = 0; pt < 4; ++pt)
#pragma unroll
            for (int ks = 0; ks < 2; ++ks) { pa[pt][ks] = __builtin_bit_cast(bf16x8, *(const v4u*)(ST + (((size_t)u * 8 + h) * 64 + 16 * pt + fr) * 64 + 32 * ks + 8 * fq));
                cbf[pt][ks] = __builtin_bit_cast(bf16x8, *(const v4u*)(CC + (r0 + 16 * pt + fr) * 128 + g * 64 + 32 * ks + 8 * fq)); }
        v2u yv4[4][4], zv4[4][4]; float ea4[4];
#pragma unroll
        for (int lt = 0; lt < 4; ++lt) { const int l = 16 * lt + fr; ea4[lt] = EA[(r0 + l) * 8 + h];
#pragma unroll
            for (int pt = 0; pt < 4; ++pt) { const int p0 = 16 * pt + 4 * fq; yv4[lt][pt] = *(const v2u*)(Y + (r0 + l) * DM + 256 + h * 64 + p0); zv4[lt][pt] = *(const v2u*)(P + (r0 + l) * NP + ZOFF + h * 64 + p0); } }
        f32x4v acc[4][4];
#pragma unroll
        for (int pt = 0; pt < 4; ++pt)
#pragma unroll
            for (int lt = 0; lt < 4; ++lt) { acc[pt][lt] = (f32x4v){0.f, 0.f, 0.f, 0.f};
#pragma unroll
                for (int ks = 0; ks < 2; ++ks) acc[pt][lt] = __builtin_amdgcn_mfma_f32_16x16x32_bf16(pa[pt][ks], cbf[lt][ks], acc[pt][lt], 0, 0, 0); }
        float ssl[4];
#pragma unroll
        for (int lt = 0; lt < 4; ++lt) { const float ea = ea4[lt]; ssl[lt] = 0.f;
#pragma unroll
            for (int pt = 0; pt < 4; ++pt) { const v2u yv = yv4[lt][pt], zv = zv4[lt][pt];
                const float yd[4] = {bflo(yv.x), bfhi(yv.x), bflo(yv.y), bfhi(yv.y)}, zz[4] = {bflo(zv.x), bfhi(zv.x), bflo(zv.y), bfhi(zv.y)};
#pragma unroll
                for (int r = 0; r < 4; ++r) { const float v = (yd[r] + ea * acc[pt][lt][r]) * silu_f(zz[r]); acc[pt][lt][r] = v; ssl[lt] += v * v; } } }
        __syncthreads();
#pragma unroll
        for (int lt = 0; lt < 4; ++lt) { const float s = sum_x32(sum_x16(ssl[lt])); if (fq == 0) SSH[h * 64 + 16 * lt + fr] = s; }
        __syncthreads();
#pragma unroll
        for (int lt = 0; lt < 4; ++lt) { const int l = 16 * lt + fr; float t = 0.f;
#pragma unroll
            for (int hh = 0; hh < 8; ++hh) t += SSH[hh * 64 + l];
            const float rstd = 1.0f / sqrtf(t * (1.0f / 512.0f) + EPS);
#pragma unroll
            for (int pt = 0; pt < 4; ++pt) { const int p0 = 16 * pt + 4 * fq; const f32x4 w4 = *(const f32x4*)(nw + h * 64 + p0);
                const v2u o = (v2u){pk2(acc[pt][lt][0] * rstd * w4[0], acc[pt][lt][1] * rstd * w4[1]), pk2(acc[pt][lt][2] * rstd * w4[2], acc[pt][lt][3] * rstd * w4[3])};
                if (!dry) *(v2u*)(Y + (r0 + l) * DM + 256 + h * 64 + p0) = o; } }
    }
}
constexpr int L7_EI = 0, L7_CF = 16384, L7_PT = L7_CF + 32768, L7_RS = L7_PT + 32768, L7_SSQ = L7_RS + 512, L7_W2 = L7_SSQ + 512, L7_SCL = L7_W2 + 4096, L7_END = L7_SCL + 8 * 9216;
static_assert(L7_END <= LDSCTL_OFF, "PEER LDS");
__device__ __forceinline__ unsigned mk_key(float f, unsigned idx) { const unsigned u = __float_as_uint(f); unsigned k = (u & 0x80000000u) ? ~u : (u | 0x80000000u); return (k & ~127u) | (127u - idx); }
__device__ __forceinline__ float key_val(unsigned k) { const unsigned kk = k & ~127u; return __uint_as_float((kk & 0x80000000u) ? (kk & 0x7fffffffu) : ~kk); }
__device__ __forceinline__ void ce_desc(unsigned& a, unsigned& b) { const unsigned hi = a > b ? a : b; const unsigned lo = a > b ? b : a; a = hi; b = lo; }
__device__ __forceinline__ void bitonic_sort16_desc(unsigned (&v)[16]) {
#pragma unroll
    for (int k = 2; k <= 16; k <<= 1)
#pragma unroll
        for (int j = k >> 1; j > 0; j >>= 1)
#pragma unroll
            for (int i = 0; i < 16; ++i) { const int l = i ^ j; if (l > i) { if ((i & k) == 0) ce_desc(v[i], v[l]); else ce_desc(v[l], v[i]); } }
}
__device__ __forceinline__ void bitonic_merge16_desc(unsigned (&v)[16]) {
#pragma unroll
    for (int j = 8; j > 0; j >>= 1)
#pragma unroll
        for (int i = 0; i < 16; ++i) { const int l = i ^ j; if (l > i) ce_desc(v[i], v[l]); }
}
__device__ __forceinline__ void topk16_slice(const float* sp, unsigned (&lst)[16]) {
    { const f32x4 a = *(const f32x4*)sp, b = *(const f32x4*)(sp + 4), c = *(const f32x4*)(sp + 8), d = *(const f32x4*)(sp + 12);
#pragma unroll
      for (int e = 0; e < 4; ++e) { lst[e] = mk_key(a[e], (unsigned)e); lst[4 + e] = mk_key(b[e], (unsigned)(4 + e)); lst[8 + e] = mk_key(c[e], (unsigned)(8 + e)); lst[12 + e] = mk_key(d[e], (unsigned)(12 + e)); } }
    bitonic_sort16_desc(lst);
#pragma unroll 1
    for (int ch = 1; ch < 8; ++ch) { unsigned cv[16];
        const f32x4 a = *(const f32x4*)(sp + 16 * ch), b = *(const f32x4*)(sp + 16 * ch + 4), c = *(const f32x4*)(sp + 16 * ch + 8), d = *(const f32x4*)(sp + 16 * ch + 12);
#pragma unroll
        for (int e = 0; e < 4; ++e) { cv[e] = mk_key(a[e], (unsigned)(16 * ch + e)); cv[4 + e] = mk_key(b[e], (unsigned)(16 * ch + 4 + e)); cv[8 + e] = mk_key(c[e], (unsigned)(16 * ch + 8 + e)); cv[12 + e] = mk_key(d[e], (unsigned)(16 * ch + 12 + e)); }
        bitonic_sort16_desc(cv);
#pragma unroll
        for (int q = 0; q < 16; ++q) lst[q] = lst[q] > cv[15 - q] ? lst[q] : cv[15 - q];
        bitonic_merge16_desc(lst); }
}
typedef float f32x2 __attribute__((ext_vector_type(2)));
__device__ __forceinline__ void dec16(const v4u q, float (&f)[16]) {
#pragma unroll
    for (int w = 0; w < 4; ++w) { const f32x2 lo = __builtin_amdgcn_cvt_pk_f32_fp8((int)q[w], false), hi = __builtin_amdgcn_cvt_pk_f32_fp8((int)q[w], true);
        f[4 * w] = lo.x; f[4 * w + 1] = lo.y; f[4 * w + 2] = hi.x; f[4 * w + 3] = hi.y; }
}
__device__ __forceinline__ void peer_phase(const Ctx F, const float* SC, const float* SS2, const unsigned char* U8, const unsigned char* V8, const float* US, const float* VS, const float* w2  ,
                                           const bf16* X1B  , bf16* XB  , float* RS1  , float* OUT  , const float* fw  , bool last, bool dry, int dry2, const void* ST_CODE = nullptr) {
    LAS unsigned short* EI = (LAS unsigned short*)(F.lds + L7_EI); LAS float* CF = (LAS float*)(F.lds + L7_CF); LAS float* PT = (LAS float*)(F.lds + L7_PT);
    LAS float* RS = (LAS float*)(F.lds + L7_RS); LAS float* SSQ = (LAS float*)(F.lds + L7_SSQ); LAS float* W2L = (LAS float*)(F.lds + L7_W2);
#pragma unroll 1
    for (int tile = F.vcu; tile < M / 128; tile += F.G) {
        int lane_o = F.lane; asm volatile("" : "+v"(lane_o));
        const int g = lane_o >> 3, i = lane_o & 7;
        __syncthreads();
        {
            const int tokl = F.tid >> 2, hh = F.tid & 3; const size_t row = (size_t)tile * 128 + tokl;
            unsigned l0[16], l1[16];
            topk16_slice(SC + row * 1024 + hh * 256, l0); topk16_slice(SC + row * 1024 + hh * 256 + 128, l1);
            float s0[16], s1[16];
#pragma unroll
            for (int j = 0; j < 16; ++j) { s0[j] = key_val(l0[j]); s1[j] = key_val(l1[j]); }
            {
                LAS unsigned* slot = (LAS unsigned*)(PT + tokl * 64 + hh * 16);
#pragma unroll
                for (int j = 0; j < 8; ++j) { slot[j] = (127u - (l0[2 * j] & 127u)) | ((127u - (l0[2 * j + 1] & 127u)) << 16); slot[8 + j] = (127u - (l1[2 * j] & 127u)) | ((127u - (l1[2 * j + 1] & 127u)) << 16); } }
            unsigned best[16];
#define CKEY(i_, j_) ((({ const unsigned u_ = __float_as_uint(s0[i_] + s1[j_]); (u_ & 0x80000000u) ? ~u_ : (u_ | 0x80000000u); }) & ~255u) | (255u - (unsigned)(16 * (i_) + (j_))))
#pragma unroll
            for (int j = 0; j < 16; ++j) best[j] = CKEY(0, j);
#pragma unroll
            for (int ii = 1; ii < 8; ++ii) { constexpr int NR[8] = {16, 8, 5, 4, 3, 2, 2, 2};
#pragma unroll
                for (int j = 0; j < 16; ++j) if (j < NR[ii]) { const unsigned c = CKEY(ii, j); best[15 - j] = best[15 - j] > c ? best[15 - j] : c; }
                bitonic_merge16_desc(best); }
#pragma unroll
            for (int ii = 8; ii < 16; ++ii) { unsigned k = CKEY(ii, 0);
#pragma unroll
                for (int q = 0; q < 16; ++q) { const unsigned hi = best[q] > k ? best[q] : k; k = best[q] > k ? k : best[q]; best[q] = hi; } }
#undef CKEY
            float e[16], bv[16], sum = 0.f;
#pragma unroll
            for (int j = 0; j < 16; ++j) { const unsigned kk = best[j] & ~255u; bv[j] = __uint_as_float((kk & 0x80000000u) ? (kk & 0x7fffffffu) : ~kk); }
#pragma unroll
            for (int j = 0; j < 16; ++j) { e[j] = __expf(bv[j] - bv[0]); sum += e[j]; }
            const float inv = 1.0f / sum;
            { const LAS unsigned short* slot = (const LAS unsigned short*)(PT + tokl * 64 + hh * 16);
#pragma unroll
              for (int j = 0; j < 16; ++j) { const unsigned pos = 255u - (best[j] & 255u); const unsigned ex = (unsigned)slot[pos >> 4] * 128u + (unsigned)slot[16 + (pos & 15u)];
                  EI[tokl * 64 + hh * 16 + j] = (unsigned short)ex; CF[tokl * 64 + hh * 16 + j] = e[j] * inv; } }
        }
        if (F.tid < 256) *(LAS f32x4*)(W2L + 4 * F.tid) = *(const f32x4*)(w2 + 4 * F.tid);
        if (F.lane < 16) { const int tok = F.wave * 16 + F.lane; const f32x4* sp = (const f32x4*)(SS2 + ((size_t)tile * 128 + tok) * 16); const f32x4 a = sp[0], b = sp[1], c = sp[2], d = sp[3];
            const float t = ((a[0] + a[1]) + (a[2] + a[3])) + ((b[0] + b[1]) + (b[2] + b[3])) + ((c[0] + c[1]) + (c[2] + c[3])) + ((d[0] + d[1]) + (d[2] + d[3]));
            RS[tok] = 1.0f / sqrtf(t * (1.0f / DM) + EPS); SSQ[tok] = 0.f; }
        __syncthreads();
#define U_LOAD(it_, Q, X) do { const int s_ = (it_) >> 4, tok_ = F.wave * 16 + ((it_) & 15); \
            _Pragma("unroll") for (int j = 0; j < 8; ++j) { const unsigned e_ = EI[tok_ * 64 + 8 * j + g]; Q[j] = *(const v4u*)(U8 + (size_t)e_ * 1024 + 128 * s_ + 16 * i); } \
            const bf16* xp_ = X1B + ((size_t)tile * 128 + tok_) * DM + 128 * s_ + 16 * i; \
            X[0] = *(const v4u*)xp_; X[1] = *(const v4u*)(xp_ + 8); } while (0)
#define U_COMP(it_, Q, X) do { const int s_ = (it_) >> 4, tok_ = F.wave * 16 + ((it_) & 15); float hw[16]; \
            { float xf_[16]; { float t8_[8]; unpack8(X[0], t8_); _Pragma("unroll") for (int q = 0; q < 8; ++q) xf_[q] = t8_[q]; unpack8(X[1], t8_); _Pragma("unroll") for (int q = 0; q < 8; ++q) xf_[8 + q] = t8_[q]; } \
            _Pragma("unroll") for (int q = 0; q < 16; ++q) hw[q] = xf_[q] * w2r[q]; } \
            float d[8]; \
            _Pragma("unroll") for (int j = 0; j < 8; ++j) { float f[16]; dec16(Q[j], f); float a0 = 0.f, a1 = 0.f; \
                _Pragma("unroll") for (int m = 0; m < 8; ++m) { a0 += hw[2 * m] * f[2 * m]; a1 += hw[2 * m + 1] * f[2 * m + 1]; } \
                d[j] = a0 + a1; } \
            float d2[4], d3[2]; \
            _Pragma("unroll") for (int m = 0; m < 4; ++m) { const float snd = (i & 4) ? d[m] : d[4 + m]; const float kp = (i & 4) ? d[4 + m] : d[m]; d2[m] = kp + dppf<0x141>(snd); }     \
            _Pragma("unroll") for (int m = 0; m < 2; ++m) { const float snd = (i & 2) ? d2[m] : d2[2 + m]; const float kp = (i & 2) ? d2[2 + m] : d2[m]; d3[m] = kp + dppf<0x4E>(snd); } \
            const float snd = (i & 1) ? d3[0] : d3[1]; const float kp = (i & 1) ? d3[1] : d3[0]; const float tot = kp + dppf<0xB1>(snd); \
            const int pi = tok_ * 64 + 8 * i + g; PT[pi] = (s_ == 0) ? tot : PT[pi] + tot; } while (0)
#pragma unroll 1
        for (int repu = 0; repu < ((dry2 >> 1) & 1) + 1; ++repu)
        {
            v4u qa[8], qb[8]; v4u xa[2], xb[2]; float w2r[16];
            U_LOAD(0, qa, xa);
#pragma unroll 1
            for (int it = 0; it < 128; it += 2) {
                if ((it & 15) == 0) {
#pragma unroll
                    for (int q = 0; q < 4; ++q) { const f32x4 w_ = *(const LAS f32x4*)(W2L + 8 * it + 16 * i + 4 * q); w2r[4 * q] = w_[0]; w2r[4 * q + 1] = w_[1]; w2r[4 * q + 2] = w_[2]; w2r[4 * q + 3] = w_[3]; } }
                U_LOAD(it + 1, qb, xb);
                if ((dry2 & 8) && repu == 0) { unsigned acc_ = 0; _Pragma("unroll") for (int j = 0; j < 8; ++j) acc_ ^= qa[j][0] ^ qa[j][1] ^ qa[j][2] ^ qa[j][3]; acc_ ^= xa[0][0] ^ xa[1][3]; asm volatile("" :: "v"(acc_)); } else
                U_COMP(it, qa, xa);
                { const int itn = (it + 2 < 128) ? it + 2 : 127; U_LOAD(itn, qa, xa); }
                if ((dry2 & 8) && repu == 0) { unsigned acc_ = 0; _Pragma("unroll") for (int j = 0; j < 8; ++j) acc_ ^= qb[j][0] ^ qb[j][1] ^ qb[j][2] ^ qb[j][3]; acc_ ^= xb[0][0] ^ xb[1][3]; asm volatile("" :: "v"(acc_)); } else
                U_COMP(it + 1, qb, xb);
            }
        }
#undef U_LOAD
#undef U_COMP
#pragma unroll 1
        for (int n = 0; n < 16; ++n) { const int idx = (F.wave * 16 + n) * 64 + F.lane; const unsigned e = EI[idx]; const float dd = PT[idx] * US[e] * RS[F.wave * 16 + n];
            CF[idx] = CF[idx] * (0.5f * dd * (1.0f + erff(dd * 0.70710678118654752f))) * VS[e]; }
#define V_LOAD(it_, Q, X) do { const int s_ = (it_) >> 4, tok_ = F.wave * 16 + ((it_) & 15); \
            _Pragma("unroll") for (int j = 0; j < 8; ++j) { const unsigned e_ = EI[tok_ * 64 + 8 * j + g]; Q[j] = *(const v4u*)(V8 + (size_t)e_ * 1024 + 128 * s_ + 16 * i); } \
            X = *(const unsigned*)(X1B + ((size_t)tile * 128 + tok_) * DM + 128 * s_ + vd); } while (0)
#define V_COMP(it_, Q, X) do { const int s_ = (it_) >> 4, tok_ = F.wave * 16 + ((it_) & 15); float o[16]; \
            _Pragma("unroll") for (int m = 0; m < 16; ++m) o[m] = 0.f; \
            _Pragma("unroll") for (int j = 0; j < 8; ++j) { const float cf_ = CF[tok_ * 64 + 8 * j + g]; float f[16]; dec16(Q[j], f); \
                _Pragma("unroll") for (int m = 0; m < 16; ++m) o[m] += cf_ * f[m]; } \
            float o2[8], o3[4], o4[2]; \
            _Pragma("unroll") for (int m = 0; m < 8; ++m) { const auto rr_ = __builtin_amdgcn_permlane32_swap(__float_as_uint(o[8 + m]), __float_as_uint(o[m]), false, false); o2[m] = __uint_as_float(rr_[0]) + __uint_as_float(rr_[1]); }     \
            _Pragma("unroll") for (int m = 0; m < 4; ++m) { const auto rr_ = __builtin_amdgcn_permlane16_swap(__float_as_uint(o2[4 + m]), __float_as_uint(o2[m]), false, false); o3[m] = __uint_as_float(rr_[0]) + __uint_as_float(rr_[1]); }     \
            _Pragma("unroll") for (int m = 0; m < 2; ++m) { const float snd = (g & 1) ? o3[m] : o3[2 + m]; const float kp = (g & 1) ? o3[2 + m] : o3[m]; o4[m] = kp + dppf<0x128>(snd); } \
            const float y0 = bflo(X) + o4[0], y1 = bfhi(X) + o4[1]; \
            if (!dry) *(unsigned*)(XB + ((size_t)tile * 128 + tok_) * DM + 128 * s_ + vd) = pk2(y0, y1); \
            } while (0)
#pragma unroll 1
        for (int repv = 0; repv < ((dry2 >> 2) & 1) + 1; ++repv)
        {
            const int vd = 16 * i + 8 * (1 - ((g >> 2) & 1)) + 4 * (1 - ((g >> 1) & 1)) + 2 * (g & 1);
            v4u qa[8], qb[8]; unsigned xa, xb;
            V_LOAD(0, qa, xa);
#pragma unroll 1
            for (int it = 0; it < 128; it += 2) {
                V_LOAD(it + 1, qb, xb);
                V_COMP(it, qa, xa);
                { const int itn = (it + 2 < 128) ? it + 2 : 127; V_LOAD(itn, qa, xa); }
                V_COMP(it + 1, qb, xb);
            }
        }
#undef V_LOAD
#undef V_COMP
        asm volatile("s_waitcnt vmcnt(0)" ::: "memory");
        __builtin_amdgcn_fence(__ATOMIC_ACQUIRE, "agent");
        asm volatile("s_waitcnt vmcnt(0)" ::: "memory");
#pragma unroll 1
        for (int ti = 0; ti < 16; ++ti) {
            const int tok = F.wave * 16 + ti; const size_t row = (size_t)tile * 128 + tok;
            float f0[8], f1[8]; unpack8(*(const v4u*)(XB + row * DM + F.lane * 8), f0); unpack8(*(const v4u*)(XB + row * DM + 512 + F.lane * 8), f1);
            float sq = 0.f;
#pragma unroll
            for (int q = 0; q < 8; ++q) sq += f0[q] * f0[q] + f1[q] * f1[q];
            float rstd = 1.0f / sqrtf(wave_sum_v(sq) * (1.0f / DM) + EPS);
#if defined(SELFTEST)
            rstd *= 1.0f + 0.2f * (float)__hip_atomic_load((const unsigned*)ST_CODE, __ATOMIC_RELAXED, __HIP_MEMORY_SCOPE_AGENT);
#endif
            if (!last) { if (F.lane == 0 && !dry) RS1[row] = rstd; }
            else if (!dry) {
                const f32x4 c0 = *(const f32x4*)(fw + F.lane * 8), d0 = *(const f32x4*)(fw + F.lane * 8 + 4), c1 = *(const f32x4*)(fw + 512 + F.lane * 8), d1 = *(const f32x4*)(fw + 512 + F.lane * 8 + 4);
                *(f32x4*)(OUT + row * DM + F.lane * 8) = (f32x4){f0[0] * rstd * c0[0], f0[1] * rstd * c0[1], f0[2] * rstd * c0[2], f0[3] * rstd * c0[3]};
                *(f32x4*)(OUT + row * DM + F.lane * 8 + 4) = (f32x4){f0[4] * rstd * d0[0], f0[5] * rstd * d0[1], f0[6] * rstd * d0[2], f0[7] * rstd * d0[3]};
                *(f32x4*)(OUT + row * DM + 512 + F.lane * 8) = (f32x4){f1[0] * rstd * c1[0], f1[1] * rstd * c1[1], f1[2] * rstd * c1[2], f1[3] * rstd * c1[3]};
                *(f32x4*)(OUT + row * DM + 512 + F.lane * 8 + 4) = (f32x4){f1[4] * rstd * d1[0], f1[5] * rstd * d1[1], f1[6] * rstd * d1[2], f1[7] * rstd * d1[3]};
            }
        }
    }
}


#if defined(SELFTEST)
__device__ __forceinline__ float st_a(int r, int k) { return (float)(((r * 3 + k) % 5) - 2); }
__device__ __forceinline__ float st_b(int k, int c) { return (float)(((k + 2 * c) % 7) - 3); }
__device__ __forceinline__ void selftest(const Ctx F, gu32* ctl) {
    if (blockIdx.x != 0 || F.wave != 0) return;
    const int lane = F.lane, fr = lane & 15, fq = lane >> 4;
    int aw[2] = {0, 0}, bw[2] = {0, 0};
#pragma unroll
    for (int w = 0; w < 2; ++w) { aw[w] = __builtin_amdgcn_cvt_pk_fp8_f32(st_a(fr, 8 * fq + 4 * w), st_a(fr, 8 * fq + 4 * w + 1), aw[w], false); aw[w] = __builtin_amdgcn_cvt_pk_fp8_f32(st_a(fr, 8 * fq + 4 * w + 2), st_a(fr, 8 * fq + 4 * w + 3), aw[w], true);
                                  bw[w] = __builtin_amdgcn_cvt_pk_fp8_f32(st_b(8 * fq + 4 * w, fr), st_b(8 * fq + 4 * w + 1, fr), bw[w], false); bw[w] = __builtin_amdgcn_cvt_pk_fp8_f32(st_b(8 * fq + 4 * w + 2, fr), st_b(8 * fq + 4 * w + 3, fr), bw[w], true); }
    const long A = (long)(((unsigned long long)(unsigned)aw[1] << 32) | (unsigned)aw[0]), B = (long)(((unsigned long long)(unsigned)bw[1] << 32) | (unsigned)bw[0]);
    f32x4 d = (f32x4){0.f, 0.f, 0.f, 0.f};
    d = __builtin_amdgcn_mfma_f32_16x16x32_fp8_fp8(A, B, d, 0, 0, 0);
    bool ok1 = true;
#pragma unroll
    for (int r = 0; r < 4; ++r) { float e = 0.f; for (int kk = 0; kk < 32; ++kk) e += st_a(4 * fq + r, kk) * st_b(kk, fr); ok1 = ok1 && (d[r] == e); }
    const int t1 = __all(ok1) ? 1 : 0;
    LAS unsigned char* T = F.lds;
    for (int c4 = 0; c4 < 32; ++c4) { unsigned w = 0; for (int b = 0; b < 4; ++b) w |= (unsigned)((37 * lane + 11 * (4 * c4 + b)) & 127) << (8 * b); *(LAS unsigned*)(T + lane * 128 + 4 * c4) = w; }
    asm volatile("s_waitcnt lgkmcnt(0)" ::: "memory");
    int t2 = 0;
#pragma unroll
    for (int hyp = 1; hyp <= 2; ++hyp) {
        const int l16 = lane & 15; const int row = (hyp == 1) ? (l16 >> 1) : (l16 & 7), cc = (hyp == 1) ? 8 * (l16 & 1) : 8 * (l16 >> 3);
        const v2i_t v = __builtin_amdgcn_ds_read_tr8_b64_v2i32((LAS v2i_t*)(T + (8 * fq + row) * 128 + 16 + cc));
        bool ok = true;
#pragma unroll
        for (int j = 0; j < 8; ++j) { const unsigned got = ((unsigned)(j < 4 ? v.x : v.y) >> (8 * (j & 3))) & 255u; ok = ok && (got == (unsigned)((37 * (8 * fq + j) + 11 * (16 + l16)) & 127)); }
        if (__all(ok)) t2 = hyp;
    }
    if (lane == 0) __hip_atomic_store(ctl + 20, (unsigned)(t1 + 2 * t2 + 1), RLX_AGENT);
    asm volatile("s_waitcnt vmcnt(0) lgkmcnt(0)" ::: "memory");
}
#endif
__device__ __forceinline__ Ctx fresh(const Ctx F) { Ctx R = F; int t = F.tid, v = F.vcu, g = F.G; asm volatile("" : "+v"(t)); asm volatile("" : "+s"(v), "+s"(g)); R.tid = t; R.lane = t & 63; R.wave = __builtin_amdgcn_readfirstlane(t >> 6); R.vcu = v; R.G = g; return R; }
struct Args { const float* in[17]; float* out; unsigned char* ws; int ph_lo, ph_hi, li, pad; };
__global__ void __launch_bounds__(NWAVES * 64, 2) mega_fwd(Args args) {
    extern __shared__ __attribute__((aligned(16))) unsigned char lds[];
    Ctx F;
    F.lds = (LAS unsigned char*)lds;
    F.tid = threadIdx.x; F.lane = F.tid & 63; F.wave = __builtin_amdgcn_readfirstlane(F.tid >> 6);
    F.G = gridDim.x; { const int bx = blockIdx.x; F.vcu = (F.G % 8 == 0) ? (bx % 8) * (F.G / 8) + bx / 8 : bx; }
    unsigned char* ws = args.ws;
    gu32* ctl = (gu32*)(ws + WS_CTL);
    volatile LAS unsigned* MISC = (volatile LAS unsigned*)(F.lds + MISC_OFF);
    for (int u = F.tid; u < (LDS_BYTES - LDSCTL_OFF) / 4; u += NWAVES * 64) ((LAS unsigned*)(F.lds + LDSCTL_OFF))[u] = 0u;
    __syncthreads();
    XcdBarrier bar; bar.bar = (unsigned*)(ctl + CW_BAR); bar.x = 0; bar.st = nullptr;
    if (N_LAUNCHES != NPH) bar = xcd_barrier_post((unsigned*)(ctl + CW_BAR), MISC + 8);
    const int lo = args.ph_lo, hi = args.ph_hi;
#define IN(k) (lo <= (k) && (k) < hi)
#ifndef PH_MASK
#define PH_MASK 0x3ff
#endif
#define PHK(i) ((PH_MASK >> (i)) & 1)
#ifndef DUP_KIND
#define DUP_KIND (-1)
#endif
#define DUPK(i) (DUP_KIND == (i))
    const bool dry = (args.pad == 0);
#define SEAM(k) do { if (N_LAUNCHES != NPH) { if (IN(k) && IN((k) + 1)) xcd_barrier(bar); } } while (0)
    const float* x_in = args.in[0]; float* OUT = args.out;
    bf16* XNY = (bf16*)(ws + WS_XNY); bf16* XB = (bf16*)(ws + WS_XB); float* RS1 = (float*)(ws + WS_RS1); bf16* PB = (bf16*)(ws + WS_P); float* SC = (float*)(ws + WS_SC); bf16* X1B = (bf16*)(ws + WS_X1B);
    float* SS2 = (float*)(ws + WS_SS2); float* EA = (float*)(ws + WS_EA); float* CD = (float*)(ws + WS_CD); bf16* CC = (bf16*)(ws + WS_CC); bf16* ST = (bf16*)(ws + WS_ST);
#if defined(SELFTEST)
    if (IN(0)) { selftest(fresh(F), ctl); __syncthreads(); }
#endif
    if (DUPK(0) && IN(0)) p0_prologue(fresh(F), x_in, args.in[1], args.in[2], args.in[10], args.in[11], args.in[12], args.in[13], ws);
    if (PHK(0) && IN(0)) p0_prologue(fresh(F), x_in, args.in[1], args.in[2], args.in[10], args.in[11], args.in[12], args.in[13], ws);
    SEAM(0);
    if (DUPK(15) && N_LAUNCHES != NPH) { for (int r = 0; r < 10; ++r) xcd_barrier(bar); }
#pragma unroll
    for (int L = 0; L < DEPTH; ++L) {
        const int pb = 1 + 7 * L;
#pragma unroll 1
        for (int rep = 0; rep < ((DUPK(1) && L == 0) ? 2 : 1); ++rep)
        if (PHK(1) && IN(pb)) {
            pg8::Gemm g{XB, (const bf16*)(ws + WS_WIN) + (size_t)L * NP * DM, M, NP, DM}; pg8::StaticOrder S; S.init(M, NP, F.G, (int)blockIdx.x);
            pg8::EpiBf16Row E{PB, NP, RS1};
            pg8::gemm_phase<pg8::EpiBf16Row, pg8::StaticOrder, PG8_ALIGN, PG8_SP2>(F.lds, g, S, E);
        }
        SEAM(pb);
        if (IN(pb + 1)) {
            if (DUPK(2) && L == 0) ssd_part1(fresh(F), PB, XNY, args.in[3] + (size_t)L * 4 * 768, args.in[4] + L * 768, args.in[5] + L * 8, args.in[6] + L * 8, args.in[7] + L * 8, CC, EA, CD, ST);
            if (PHK(2)) ssd_part1(fresh(F), PB, XNY, args.in[3] + (size_t)L * 4 * 768, args.in[4] + L * 768, args.in[5] + L * 8, args.in[6] + L * 8, args.in[7] + L * 8, CC, EA, CD, ST);
            if (DUPK(3) && L == 0) attn_mfma(fresh(F), PB, XNY);
            if (PHK(3)) attn_mfma(fresh(F), PB, XNY);
            if (DUPK(4) && L == 0) shortconv(fresh(F), PB, XNY, args.in[9] + (size_t)L * 3 * 256);
            if (PHK(4)) shortconv(fresh(F), PB, XNY, args.in[9] + (size_t)L * 3 * 256);
        }
        SEAM(pb + 1);
        if (DUPK(5) && L == 0 && IN(pb + 2)) ssd_scan(fresh(F), ST, CD, dry);
        if (PHK(5) && IN(pb + 2)) { const Ctx Fs = fresh(F); ssd_scan(Fs, ST, CD, false); if (Fs.wave >= 2) convert_tables(Fs.lane, args.in[14], args.in[15], ws, L, Fs.vcu * 6 + (Fs.wave - 2), Fs.G * 6); }
        SEAM(pb + 2);
        if (DUPK(6) && L == 0 && IN(pb + 3)) ssd_part2(fresh(F), PB, XNY, CC, EA, ST, args.in[8] + L * 512, dry);
        if (PHK(6) && IN(pb + 3)) ssd_part2(fresh(F), PB, XNY, CC, EA, ST, args.in[8] + L * 512, false);
        SEAM(pb + 3);
#pragma unroll 1
        for (int rep = 0; rep < ((DUPK(7) && L == 0) ? 2 : 1); ++rep)
        if (PHK(7) && IN(pb + 4)) {
            pg8::Gemm g{XNY, (const bf16*)(ws + WS_WOUT) + (size_t)L * DM * DM, M, DM, DM}; pg8::StaticOrder S; S.init(M, DM, F.G, (int)blockIdx.x);
            pg8::EpiResidB E{XB, X1B, SS2};
            pg8::gemm_phase<pg8::EpiResidB, pg8::StaticOrder, PG8_ALIGN, PG8_SP2>(F.lds, g, S, E);
        }
        SEAM(pb + 4);
#pragma unroll 1
        for (int rep = 0; rep < ((DUPK(8) && L == 0) ? 2 : 1); ++rep)
        if (PHK(8) && IN(pb + 5)) {
            pg8::Gemm g{X1B, (const bf16*)(ws + WS_WS) + (size_t)L * DM * DM, M, DM, DM}; pg8::StaticOrder S; S.init(M, DM, F.G, (int)blockIdx.x);
            pg8::EpiScore E{SC, SS2, EPS};
            pg8::gemm_phase<pg8::EpiScore, pg8::StaticOrder, PG8_ALIGN, PG8_SP2>(F.lds, g, S, E);
        }
        SEAM(pb + 5);
        if (DUPK(9) && L == 0 && IN(pb + 6)) peer_phase(fresh(F), SC, SS2, ws + WS_U8 + (size_t)L * 16384 * DM, ws + WS_V8 + (size_t)L * 16384 * DM, (const float*)(ws + WS_US) + L * 16384, (const float*)(ws + WS_VS) + L * 16384, args.in[11] + L * DM, X1B, XB, RS1, OUT, args.in[16], L == DEPTH - 1, dry, 0);
        if (PHK(9) && IN(pb + 6)) peer_phase(fresh(F), SC, SS2, ws + WS_U8 + (size_t)L * 16384 * DM, ws + WS_V8 + (size_t)L * 16384 * DM, (const float*)(ws + WS_US) + L * 16384, (const float*)(ws + WS_VS) + L * 16384, args.in[11] + L * DM, X1B, XB, RS1, OUT, args.in[16], L == DEPTH - 1, false, (L == 0 && dry) ? (DUPK(10) ? 1 : DUPK(11) ? 2 : DUPK(12) ? 4 : DUPK(13) ? 10 : DUPK(14) ? 17 : 0) : 0, (const void*)(ctl + 20));
        SEAM(pb + 6);
    }
#undef IN
#undef SEAM
}

extern "C" void kernel_launch(void* const* d_in, const int* in_sizes, int n_in, void* d_out, int out_size, void* d_ws, size_t ws_size, hipStream_t stream) {
    static int grid = 0;
    if (grid == 0) {
        if (n_in != 17 || in_sizes[0] != M * DM || out_size != M * DM || ws_size < WS_END) { fprintf(stderr, "kernel_launch: unexpected shapes (n_in %d, in0 %d, out %d, ws %zu); nothing launched\n", n_in, n_in > 0 ? in_sizes[0] : -1, out_size, ws_size); grid = -1; return; }
        int dev = 0, cus = 0, per_cu = 0;
        if (hipGetDevice(&dev) != hipSuccess || hipDeviceGetAttribute(&cus, hipDeviceAttributeMultiprocessorCount, dev) != hipSuccess) { fprintf(stderr, "kernel_launch: device query failed\n"); grid = -1; return; }
        if (hipFuncSetAttribute((const void*)mega_fwd, hipFuncAttributeMaxDynamicSharedMemorySize, LDS_BYTES) != hipSuccess) { fprintf(stderr, "kernel_launch: hipFuncSetAttribute failed\n"); grid = -1; return; }
        if (hipOccupancyMaxActiveBlocksPerMultiprocessor(&per_cu, (const void*)mega_fwd, NWAVES * 64, LDS_BYTES) != hipSuccess || per_cu < 1) { fprintf(stderr, "kernel_launch: occupancy query reports %d workgroups per CU\n", per_cu); per_cu = 1; }
        (void)hipGetLastError();
        grid = cus;
    }
    if (grid < 0) return;
    if (hipMemsetAsync((char*)d_ws + WS_CTL, 0, CTL_ZERO_BYTES, stream) != hipSuccess) { fprintf(stderr, "kernel_launch: memset failed\n"); return; }
    Args a{};
    for (int i = 0; i < 17; ++i) a.in[i] = (const float*)d_in[i];
    a.out = (float*)d_out; a.ws = (unsigned char*)d_ws;
    for (int li = 0; li < N_LAUNCHES; ++li) {
        a.ph_lo = (N_LAUNCHES == NPH) ? li : 0; a.ph_hi = (N_LAUNCHES == NPH) ? li + 1 : NPH; a.li = li;
        hipLaunchKernelGGL(mega_fwd, dim3(grid), dim3(NWAVES * 64), LDS_BYTES, stream, a);
        const hipError_t le = hipPeekAtLastError();
        if (le != hipSuccess) { fprintf(stderr, "kernel_launch: launch %d failed: %s\n", li, hipGetErrorName(le)); break; }
    }
}
```

```cpp
#define MK_N_LAUNCHES 1
#include <hip/hip_runtime.h>
#include <cstdio>
#include <cstdint>
#include <cmath>
namespace pg8 {
#define PG8_LAS __attribute__((address_space(3)))
typedef unsigned short bf16_t;
typedef short bf16x8 __attribute__((ext_vector_type(8)));
typedef float f32x4 __attribute__((ext_vector_type(4)));
typedef unsigned u32x4 __attribute__((ext_vector_type(4)));
constexpr int BM = 256, BK = 64, HALF = 128, HTB = HALF * BK * 2  , STAGE_BYTES = 8 * HTB, NXCD = 8, WGM = 8;

__host__ __device__ __forceinline__ int lds_byte(int r, int c) { const int st = (r >> 4) * 2 + (c >> 5), rr = r & 15, cc = c & 31, ob = rr * 64 + cc * 2; return st * 1024 + (ob ^ (((ob >> 9) & 1) << 5)); }
__host__ __device__ __forceinline__ void stage_rc(int b, int& R, int& C) { const int st = b / 1024, sb = b % 1024, swz = sb ^ (((sb >> 9) & 1) << 5); R = (st >> 1) * 16 + swz / 64; C = (st & 1) * 32 + (swz % 64) / 2; }
__host__ __device__ __forceinline__ int perm32(int rho) { const int n = rho >> 4, i = rho & 15; return 8 * (i >> 2) + 4 * n + (i & 3); }

struct Unit { int pm, pn; };
struct Gemm { const bf16_t* A; const bf16_t* Bt; int M, N, K; };

struct StaticOrder {
    int nM, nN, nwg, G, c;
    __host__ __device__ void init(int M, int N, int G_, int c_) { nM = M / BM; nN = N / BM; nwg = nM * nN; G = G_; c = c_; }
    __host__ __device__ bool next(int i, Unit& u) const {
        const long L = (long)i * G + c; if (L >= nwg) return false;
        int wgid = (int)L; { const int q = nwg / NXCD, r = nwg % NXCD, xcd = wgid % NXCD, off = wgid / NXCD; wgid = (xcd < r ? xcd * (q + 1) : r * (q + 1) + (xcd - r) * q) + off; }
        const int nig = WGM * nN, gid = wgid / nig, fm = gid * WGM, gsz = (nM - fm) < WGM ? (nM - fm) : WGM;
        u.pm = fm + ((wgid % nig) % gsz); u.pn = (wgid % nig) / gsz; return true;
    }
    __device__ __forceinline__ void a_ready(const Unit&) const {}
    __device__ __forceinline__ void done(const Unit&) const {}
};

__device__ __forceinline__ unsigned cvt_pk_bf16(float lo, float hi) { unsigned r; asm volatile("v_cvt_pk_bf16_f32 %0, %1, %2" : "=v"(r) : "v"(lo), "v"(hi)); return r; }
typedef float f32x2 __attribute__((ext_vector_type(2)));
__device__ __forceinline__ f32x2 gelu_pk(f32x2 v) {
    const f32x2 av = __builtin_elementwise_abs(v), d = av * 0.2316418882f + 1.0f;
    f32x2 t; t.x = __builtin_amdgcn_rcpf(d.x); t.y = __builtin_amdgcn_rcpf(d.y);
    f32x2 q = t * 0.5307027145f + (-0.7265760135f); q = q * t + 0.7107068705f; q = q * t + (-0.142248368f); q = q * t + 0.127414796f; q = q * t;
    const f32x2 s = (v * v) * (-0.72134752044f);
    f32x2 e; e.x = __builtin_amdgcn_exp2f(s.x); e.y = __builtin_amdgcn_exp2f(s.y);
    const f32x2 m = v * (q * e), r = v - m;
    f32x2 o; o.x = v.x < 0.f ? m.x : r.x; o.y = v.y < 0.f ? m.y : r.y; return o;
}

template <int ACT  > struct EpiBf16 {
    static constexpr bool PERM = true, AFTER_DRAIN = false; static_assert(ACT == 0 || ACT == 1, "EpiBf16: ACT is 0 (none) or 1 (gelu_pk)");
    bf16_t* O; int ldc; const float* bias; int split_cols; size_t split_stride; float scale0;
    __device__ __forceinline__ void operator()(const f32x4 (&acc)[2][2][4][2], const Unit& u, int wr, int wc, int fr, int fq) const {
        const int row0 = u.pm * BM + wr * 64 + fr; int colt = u.pn * BM; bf16_t* base = O;
        float sc = 1.f; if (split_cols) { const int t = colt / split_cols; base += (size_t)t * split_stride; colt -= t * split_cols; if (t == 0) sc = scale0; }
        const int col0 = colt + wc * 32 + 8 * fq, bcol0 = u.pn * BM + wc * 32 + 8 * fq;
        f32x4 bv[2][2];
#pragma unroll
        for (int bj = 0; bj < 2; ++bj)
#pragma unroll
            for (int n = 0; n < 2; ++n) bv[bj][n] = bias ? *(const f32x4*)(bias + bcol0 + bj * HALF + 4 * n) : (f32x4){0.f, 0.f, 0.f, 0.f};
#pragma unroll
        for (int ai = 0; ai < 2; ++ai)
#pragma unroll
            for (int m = 0; m < 4; ++m) { bf16_t* rowp = base + (size_t)(row0 + ai * HALF + m * 16) * ldc + col0;
#pragma unroll
                for (int bj = 0; bj < 2; ++bj) { f32x4 v0 = acc[ai][bj][m][0] + bv[bj][0], v1 = acc[ai][bj][m][1] + bv[bj][1];
                    if (ACT == 1) { f32x2 a = gelu_pk((f32x2){v0[0], v0[1]}), b = gelu_pk((f32x2){v0[2], v0[3]}), c = gelu_pk((f32x2){v1[0], v1[1]}), d = gelu_pk((f32x2){v1[2], v1[3]});
                        v0 = (f32x4){a.x, a.y, b.x, b.y}; v1 = (f32x4){c.x, c.y, d.x, d.y}; }
                    v0 = v0 * sc; v1 = v1 * sc; u32x4 w; w.x = cvt_pk_bf16(v0[0], v0[1]); w.y = cvt_pk_bf16(v0[2], v0[3]); w.z = cvt_pk_bf16(v1[0], v1[1]); w.w = cvt_pk_bf16(v1[2], v1[3]);
                    *(u32x4*)(rowp + bj * HALF) = w; } }
    }
};
struct EpiResid {
    static constexpr bool PERM = true, AFTER_DRAIN = false;
    const float* resid; float* out; bf16_t* xb; float* ss;
    __device__ __forceinline__ void operator()(const f32x4 (&acc)[2][2][4][2], const Unit& u, int wr, int wc, int fr, int fq) const {
        const int row0 = u.pm * BM + wr * 64 + fr; const int col0 = u.pn * BM + wc * 32 + 8 * fq;
#pragma unroll
        for (int ai = 0; ai < 2; ++ai)
#pragma unroll
            for (int m = 0; m < 4; ++m) { const int row = row0 + ai * HALF + m * 16; const size_t off = (size_t)row * 1024 + col0; float s = 0.f;
#pragma unroll
                for (int bj = 0; bj < 2; ++bj) { const float* rp = resid + off + bj * HALF; const f32x4 r0 = *(const f32x4*)rp, r1 = *(const f32x4*)(rp + 4);
                    const f32x4 v0 = acc[ai][bj][m][0] + r0, v1 = acc[ai][bj][m][1] + r1;
                    *(f32x4*)(out + off + bj * HALF) = v0; *(f32x4*)(out + off + bj * HALF + 4) = v1;
                    u32x4 w; w.x = cvt_pk_bf16(v0[0], v0[1]); w.y = cvt_pk_bf16(v0[2], v0[3]); w.z = cvt_pk_bf16(v1[0], v1[1]); w.w = cvt_pk_bf16(v1[2], v1[3]);
                    *(u32x4*)(xb + off + bj * HALF) = w;
                    s += (v0[0] * v0[0] + v0[1] * v0[1]) + (v0[2] * v0[2] + v0[3] * v0[3]) + (v1[0] * v1[0] + v1[1] * v1[1]) + (v1[2] * v1[2] + v1[3] * v1[3]); }
                { const auto r16_ = __builtin_amdgcn_permlane16_swap(__float_as_uint(s), __float_as_uint(s), false, false); s = __uint_as_float(r16_[0]) + __uint_as_float(r16_[1]); const auto r32_ = __builtin_amdgcn_permlane32_swap(__float_as_uint(s), __float_as_uint(s), false, false); s = __uint_as_float(r32_[0]) + __uint_as_float(r32_[1]); }
                if (fq == 0) ss[(size_t)row * 16 + u.pn * 4 + wc] = s; }
    }
};
struct EpiScore {
    static constexpr bool PERM = true, AFTER_DRAIN = false;
    float* out; const float* ss; float eps;
    __device__ __forceinline__ void operator()(const f32x4 (&acc)[2][2][4][2], const Unit& u, int wr, int wc, int fr, int fq) const {
        const int row0 = u.pm * BM + wr * 64 + fr; const int col0 = u.pn * BM + wc * 32 + 8 * fq;
#pragma unroll
        for (int ai = 0; ai < 2; ++ai)
#pragma unroll
            for (int m = 0; m < 4; ++m) { const int row = row0 + ai * HALF + m * 16; const size_t off = (size_t)row * 1024 + col0;
                const f32x4* sp = (const f32x4*)(ss + (size_t)row * 16); const f32x4 a = sp[0], b = sp[1], c = sp[2], d = sp[3];
                const float t = ((a[0] + a[1]) + (a[2] + a[3])) + ((b[0] + b[1]) + (b[2] + b[3])) + ((c[0] + c[1]) + (c[2] + c[3])) + ((d[0] + d[1]) + (d[2] + d[3]));
                const float rstd = 1.0f / sqrtf(t * (1.0f / 1024.0f) + eps);
#pragma unroll
                for (int bj = 0; bj < 2; ++bj) { *(f32x4*)(out + off + bj * HALF) = acc[ai][bj][m][0] * rstd; *(f32x4*)(out + off + bj * HALF + 4) = acc[ai][bj][m][1] * rstd; } }
    }
};

struct EpiBf16Row {
    static constexpr bool PERM = true, AFTER_DRAIN = false;
    bf16_t* O; int ldc; const float* rs;
    __device__ __forceinline__ void operator()(const f32x4 (&acc)[2][2][4][2], const Unit& u, int wr, int wc, int fr, int fq) const {
        const int row0 = u.pm * BM + wr * 64 + fr; const int col0 = u.pn * BM + wc * 32 + 8 * fq;
#pragma unroll
        for (int ai = 0; ai < 2; ++ai)
#pragma unroll
            for (int m = 0; m < 4; ++m) { const int row = row0 + ai * HALF + m * 16; const float sc = rs[row]; bf16_t* rowp = O + (size_t)row * ldc + col0;
#pragma unroll
                for (int bj = 0; bj < 2; ++bj) { const f32x4 v0 = acc[ai][bj][m][0] * sc, v1 = acc[ai][bj][m][1] * sc;
                    u32x4 w; w.x = cvt_pk_bf16(v0[0], v0[1]); w.y = cvt_pk_bf16(v0[2], v0[3]); w.z = cvt_pk_bf16(v1[0], v1[1]); w.w = cvt_pk_bf16(v1[2], v1[3]);
                    *(u32x4*)(rowp + bj * HALF) = w; } }
    }
};
struct EpiResidB {
    static constexpr bool PERM = true, AFTER_DRAIN = false;
    const bf16_t* resid; bf16_t* xb; float* ss;
    __device__ __forceinline__ void operator()(const f32x4 (&acc)[2][2][4][2], const Unit& u, int wr, int wc, int fr, int fq) const {
        const int row0 = u.pm * BM + wr * 64 + fr; const int col0 = u.pn * BM + wc * 32 + 8 * fq;
#pragma unroll
        for (int ai = 0; ai < 2; ++ai)
#pragma unroll
            for (int m = 0; m < 4; ++m) { const int row = row0 + ai * HALF + m * 16; const size_t off = (size_t)row * 1024 + col0; float s = 0.f;
#pragma unroll
                for (int bj = 0; bj < 2; ++bj) { const u32x4 r = *(const u32x4*)(resid + off + bj * HALF);
                    const f32x4 r0 = (f32x4){__uint_as_float(r.x << 16), __uint_as_float(r.x & 0xffff0000u), __uint_as_float(r.y << 16), __uint_as_float(r.y & 0xffff0000u)};
                    const f32x4 r1 = (f32x4){__uint_as_float(r.z << 16), __uint_as_float(r.z & 0xffff0000u), __uint_as_float(r.w << 16), __uint_as_float(r.w & 0xffff0000u)};
                    const f32x4 v0 = acc[ai][bj][m][0] + r0, v1 = acc[ai][bj][m][1] + r1;
                    u32x4 w; w.x = cvt_pk_bf16(v0[0], v0[1]); w.y = cvt_pk_bf16(v0[2], v0[3]); w.z = cvt_pk_bf16(v1[0], v1[1]); w.w = cvt_pk_bf16(v1[2], v1[3]);
                    *(u32x4*)(xb + off + bj * HALF) = w;
                    s += (v0[0] * v0[0] + v0[1] * v0[1]) + (v0[2] * v0[2] + v0[3] * v0[3]) + (v1[0] * v1[0] + v1[1] * v1[1]) + (v1[2] * v1[2] + v1[3] * v1[3]); }
                { const auto r16_ = __builtin_amdgcn_permlane16_swap(__float_as_uint(s), __float_as_uint(s), false, false); s = __uint_as_float(r16_[0]) + __uint_as_float(r16_[1]); const auto r32_ = __builtin_amdgcn_permlane32_swap(__float_as_uint(s), __float_as_uint(s), false, false); s = __uint_as_float(r32_[0]) + __uint_as_float(r32_[1]); }
                if (fq == 0) ss[(size_t)row * 16 + u.pn * 4 + wc] = s; }
    }
};
template <class Epi, class Sched, bool ALIGN_EPI = false, bool SP2 = false>
__device__ __forceinline__ void gemm_phase(PG8_LAS unsigned char* lds, const Gemm g, const Sched& S, const Epi& E) {
    int tid_ = threadIdx.x; asm volatile("" : "+v"(tid_));
    const int tid = tid_, wid = __builtin_amdgcn_readfirstlane(tid >> 6), lane = tid & 63, wr = wid >> 2, wc = wid & 3, fr = lane & 15, fq = lane >> 4;
    const int K = g.K, nt = K / BK;
    unsigned voffA[2], voffB[2];
#pragma unroll
    for (int i = 0; i < 2; ++i) { int R, C; stage_rc(tid * 16 + i * 8192, R, C); const int Rb = Epi::PERM ? ((R & ~31) + perm32(R & 31)) : R;
        voffA[i] = (unsigned)(R * K + C) * 2u; voffB[i] = (unsigned)(Rb * K + C) * 2u; }
    const size_t kstep = (size_t)(BK * 2);
    const size_t hstep = (size_t)HALF * K * 2;
    const size_t tstep = 2 * hstep;
    const unsigned ldsw = (unsigned)wid * 1024u;
    const int aoff = lds_byte(wr * 64 + fr, fq * 8), boff = lds_byte(wc * 32 + fr, fq * 8);
#define PG8_SA(b, h) (((b) * 2 + (h)) * HTB)
#define PG8_SB(b, h) ((4 + (b) * 2 + (h)) * HTB)
#define PG8_STAGE(bufoff, gbase, voff) do { _Pragma("unroll") for (int _i = 0; _i < 2; ++_i) \
        __builtin_amdgcn_global_load_lds((const unsigned*)((const char*)(gbase) + (voff)[_i]), (PG8_LAS unsigned*)(lds + (bufoff) + ldsw + _i * 8192), 16, 0, 0); } while (0)
#define PG8_LDA(dst, b, h) do { _Pragma("unroll") for (int m = 0; m < 4; ++m) _Pragma("unroll") for (int k = 0; k < 2; ++k) dst[m][k] = *(const PG8_LAS bf16x8*)(lds + PG8_SA(b, h) + aoff + m * 2048 + k * 1024); } while (0)
#define PG8_LDB(dst, b, h) do { _Pragma("unroll") for (int n = 0; n < 2; ++n) _Pragma("unroll") for (int k = 0; k < 2; ++k) dst[n][k] = *(const PG8_LAS bf16x8*)(lds + PG8_SB(b, h) + boff + n * 2048 + k * 1024); } while (0)
#define PG8_MMA(ai, bj, At, Bt) do { __builtin_amdgcn_s_setprio(1); _Pragma("unroll") for (int m = 0; m < 4; ++m) _Pragma("unroll") for (int n = 0; n < 2; ++n) _Pragma("unroll") for (int k = 0; k < 2; ++k) \
        acc[ai][bj][m][n] = __builtin_amdgcn_mfma_f32_16x16x32_bf16(Bt[n][k], At[m][k], acc[ai][bj][m][n], 0, 0, 0); __builtin_amdgcn_s_setprio(0); } while (0)
#define PG8_WAIT_V(n) asm volatile("s_waitcnt vmcnt(" #n ")" ::: "memory")
#define PG8_WAIT_L(n) asm volatile("s_waitcnt lgkmcnt(" #n ")" ::: "memory")
#define PG8_BAR __builtin_amdgcn_s_barrier()
#define PG8_SCHED __builtin_amdgcn_sched_barrier(0)
    Unit cur, nxt; int ui = 0;
    if (!S.next(0, cur)) return;
    f32x4 acc[2][2][4][2];
#pragma unroll
    for (int a = 0; a < 2; ++a)
#pragma unroll
        for (int b = 0; b < 2; ++b)
#pragma unroll
            for (int m = 0; m < 4; ++m)
#pragma unroll
                for (int n = 0; n < 2; ++n) acc[a][b][m][n] = (f32x4){0.f, 0.f, 0.f, 0.f};
    bf16x8 At[4][2], B0[2][2], B1[2][2];
    const char* cA = (const char*)g.A + (size_t)cur.pm * tstep; const char* cB = (const char*)g.Bt + (size_t)cur.pn * tstep;
    S.a_ready(cur);
    if constexpr (SP2) {
        PG8_STAGE(PG8_SB(0, 0), cB, voffB); PG8_STAGE(PG8_SB(0, 1), cB + hstep, voffB); PG8_STAGE(PG8_SA(0, 0), cA, voffA); PG8_STAGE(PG8_SA(0, 1), cA + hstep, voffA);
        if (wr == 1) PG8_BAR;
        PG8_WAIT_V(2); PG8_BAR;
        PG8_STAGE(PG8_SB(1, 0), cB + kstep, voffB); PG8_STAGE(PG8_SA(1, 0), cA + kstep, voffA); PG8_STAGE(PG8_SB(1, 1), cB + hstep + kstep, voffB);
        PG8_WAIT_V(6); PG8_BAR;
    } else {
        PG8_STAGE(PG8_SB(0, 0), cB, voffB); PG8_STAGE(PG8_SA(0, 0), cA, voffA); PG8_STAGE(PG8_SB(0, 1), cB + hstep, voffB); PG8_STAGE(PG8_SA(0, 1), cA + hstep, voffA);
        if (wr == 1) PG8_BAR;
        PG8_WAIT_V(4); PG8_BAR;
        PG8_STAGE(PG8_SB(1, 0), cB + kstep, voffB); PG8_STAGE(PG8_SA(1, 0), cA + kstep, voffA); PG8_STAGE(PG8_SB(1, 1), cB + hstep + kstep, voffB);
        PG8_WAIT_V(6); PG8_BAR;
    }
    for (;;) {
        const bool has_next = S.next(ui + 1, nxt);
        const char* nA = has_next ? (const char*)g.A + (size_t)nxt.pm * tstep : cA; const char* nB = has_next ? (const char*)g.Bt + (size_t)nxt.pn * tstep : cB;
        for (int t = 0; t < nt; t += 2) {
            const bool last = (t == nt - 2);
            const char* a1 = cA + (size_t)(t + 1) * kstep;
            const char* a2 = last ? nA : cA + (size_t)(t + 2) * kstep; const char* b2 = last ? nB : cB + (size_t)(t + 2) * kstep;
            const char* a3 = a2 + kstep; const char* b3 = b2 + kstep;
            if (last && has_next) S.a_ready(nxt);
            if constexpr (SP2) {
            PG8_LDB(B0, 0, 0); PG8_LDB(B1, 0, 1); PG8_SCHED; PG8_LDA(At, 0, 0); PG8_STAGE(PG8_SA(1, 1), a1 + hstep, voffA);
            PG8_WAIT_V(8); PG8_WAIT_L(0); PG8_BAR; PG8_MMA(0, 0, At, B0); PG8_MMA(0, 1, At, B1); PG8_BAR; PG8_SCHED;
            PG8_LDA(At, 0, 1); PG8_STAGE(PG8_SB(0, 0), b2, voffB); PG8_STAGE(PG8_SB(0, 1), b2 + hstep, voffB); PG8_STAGE(PG8_SA(0, 0), a2, voffA);
            PG8_WAIT_V(8); PG8_WAIT_L(0); PG8_BAR; PG8_MMA(1, 0, At, B0); PG8_MMA(1, 1, At, B1); PG8_BAR; PG8_SCHED;
            PG8_LDB(B0, 1, 0); PG8_LDB(B1, 1, 1); PG8_SCHED; PG8_LDA(At, 1, 0); PG8_STAGE(PG8_SA(0, 1), a2 + hstep, voffA);
            PG8_WAIT_V(8); PG8_WAIT_L(0); PG8_BAR; PG8_MMA(0, 0, At, B0); PG8_MMA(0, 1, At, B1); PG8_BAR; PG8_SCHED;
            PG8_LDA(At, 1, 1); PG8_STAGE(PG8_SB(1, 0), b3, voffB); PG8_STAGE(PG8_SB(1, 1), b3 + hstep, voffB); PG8_STAGE(PG8_SA(1, 0), a3, voffA);
            PG8_WAIT_V(8); PG8_WAIT_L(0); PG8_BAR; PG8_MMA(1, 0, At, B0); PG8_MMA(1, 1, At, B1); PG8_BAR; PG8_SCHED;
            } else {
            PG8_LDB(B0, 0, 0); PG8_SCHED; PG8_LDA(At, 0, 0); PG8_STAGE(PG8_SA(1, 1), a1 + hstep, voffA);
            PG8_WAIT_L(8); PG8_BAR; PG8_WAIT_L(0); PG8_MMA(0, 0, At, B0); PG8_BAR; PG8_SCHED;
            PG8_LDB(B1, 0, 1); PG8_STAGE(PG8_SB(0, 0), b2, voffB);
            PG8_BAR; PG8_WAIT_L(0); PG8_MMA(0, 1, At, B1); PG8_BAR;
            PG8_LDA(At, 0, 1); PG8_STAGE(PG8_SA(0, 0), a2, voffA);
            PG8_BAR; PG8_WAIT_L(0); PG8_MMA(1, 0, At, B0); PG8_BAR; PG8_SCHED;
            PG8_STAGE(PG8_SB(0, 1), b2 + hstep, voffB);
            PG8_WAIT_V(6); PG8_BAR; PG8_MMA(1, 1, At, B1); PG8_BAR;
            PG8_LDB(B0, 1, 0); PG8_SCHED; PG8_LDA(At, 1, 0); PG8_STAGE(PG8_SA(0, 1), a2 + hstep, voffA);
            PG8_WAIT_L(8); PG8_BAR; PG8_WAIT_L(0); PG8_MMA(0, 0, At, B0); PG8_BAR; PG8_SCHED;
            PG8_LDB(B1, 1, 1); PG8_STAGE(PG8_SB(1, 0), b3, voffB);
            PG8_BAR; PG8_WAIT_L(0); PG8_MMA(0, 1, At, B1); PG8_BAR;
            PG8_LDA(At, 1, 1); PG8_STAGE(PG8_SA(1, 0), a3, voffA);
            PG8_BAR; PG8_WAIT_L(0); PG8_MMA(1, 0, At, B0); PG8_BAR; PG8_SCHED;
            PG8_STAGE(PG8_SB(1, 1), b3 + hstep, voffB);
            PG8_WAIT_V(6); PG8_BAR; PG8_MMA(1, 1, At, B1); PG8_BAR;
            }
        }
        if constexpr (ALIGN_EPI) { if (wr == 0) PG8_BAR; }
        if constexpr (!Epi::AFTER_DRAIN) { E(acc, cur, wr, wc, fr, fq); S.done(cur); }
        if (!has_next) break;
#pragma unroll
        for (int a = 0; a < 2; ++a)
#pragma unroll
            for (int b = 0; b < 2; ++b)
#pragma unroll
                for (int m = 0; m < 4; ++m)
#pragma unroll
                    for (int n = 0; n < 2; ++n) acc[a][b][m][n] = (f32x4){0.f, 0.f, 0.f, 0.f};
        cur = nxt; cA = nA; cB = nB; ++ui;
        if constexpr (ALIGN_EPI) { if (wr == 1) PG8_BAR; }
    }
    PG8_WAIT_V(0);
    if constexpr (!ALIGN_EPI) { if (wr == 0) PG8_BAR; }
    PG8_BAR;
    if constexpr (Epi::AFTER_DRAIN) { E.fused(acc, cur, wr, wc, fr, fq, lds, wid, lane); S.done(cur); }
#undef PG8_SA
#undef PG8_SB
#undef PG8_STAGE
#undef PG8_LDA
#undef PG8_LDB
#undef PG8_MMA
#undef PG8_WAIT_V
#undef PG8_WAIT_L
#undef PG8_BAR
#undef PG8_SCHED
}
}

#ifndef PG8_SP2
#define PG8_SP2 true
#endif
#ifndef PG8_ALIGN
#define PG8_ALIGN true
#endif
constexpr int NWAVES = 8;
constexpr int NPH = 15;
#ifndef MK_N_LAUNCHES
#define MK_N_LAUNCHES 1
#endif
constexpr int N_LAUNCHES = MK_N_LAUNCHES;

constexpr int BATCH = 2, SEQ = 16384, DM = 1024, DEPTH = 2;
constexpr int M = BATCH * SEQ;
constexpr int INW = 2824;
constexpr int NP = 3072;
constexpr int QOFF = 0, KOFF = 256, VOFF = 512, ZOFF = 768, XOFF = 1280, SBOFF = 2048, SCOFF = 2304, SVOFF = 2560, DTOFF = 2816;
constexpr int NCHUNK = SEQ / 64;
constexpr float EPS = 1e-6f;
constexpr float SB_EXIT = -104.0f;

constexpr size_t MiB = 1u << 20;
constexpr size_t WS_CTL = 0, CTL_ZERO_BYTES = 1 * MiB;
constexpr size_t WS_WIN = 2 * MiB;
constexpr size_t WS_WOUT = 14 * MiB;
constexpr size_t WS_WS = 18 * MiB;
constexpr size_t WS_SS2 = 22 * MiB;
constexpr size_t WS_EA = 24 * MiB;
constexpr size_t WS_CD = 25 * MiB;
constexpr size_t WS_CC = 26 * MiB;
constexpr size_t WS_U8 = 34 * MiB;
constexpr size_t WS_V8 = 66 * MiB;
constexpr size_t WS_US = 25 * MiB + 128 * 1024;
constexpr size_t WS_VS = 25 * MiB + 256 * 1024;
constexpr size_t WS_RS1 = 25 * MiB + 512 * 1024;
constexpr size_t WS_XB = 98 * MiB;
constexpr size_t WS_XNY = 162 * MiB;
constexpr size_t WS_P = 226 * MiB;
constexpr size_t WS_SC = WS_P, WS_X1B = WS_P + 128 * MiB;
constexpr size_t WS_ST = 418 * MiB;
constexpr size_t WS_END = 482 * MiB;
constexpr int CW_BAR = 4096;

constexpr int LDS_BYTES = 163840;
constexpr int LDSCTL_OFF = 161792, MISC_OFF = LDSCTL_OFF + 320;
static_assert(MISC_OFF + 128 <= LDS_BYTES, "LDS map");

#define GAS __attribute__((address_space(1)))
#define LAS __attribute__((address_space(3)))
typedef unsigned short bf16;
typedef unsigned v4u __attribute__((ext_vector_type(4)));
typedef unsigned v2u __attribute__((ext_vector_type(2)));
typedef float f32x4 __attribute__((ext_vector_type(4)));
typedef GAS unsigned gu32;
#define RLX_AGENT __ATOMIC_RELAXED, __HIP_MEMORY_SCOPE_AGENT
#define LDS_WAIT() asm volatile("s_waitcnt lgkmcnt(0)" ::: "memory")
#define VM_WAIT() asm volatile("s_waitcnt vmcnt(0)" ::: "memory")
__device__ __forceinline__ unsigned f2bf(float f) { unsigned u = __builtin_bit_cast(unsigned, f); return (u + 0x7fffu + ((u >> 16) & 1u)) >> 16; }
__device__ __forceinline__ unsigned pk2(float lo, float hi) { return f2bf(lo) | (f2bf(hi) << 16); }
__device__ __forceinline__ float bflo(unsigned u) { return __uint_as_float(u << 16); }
__device__ __forceinline__ float bfhi(unsigned u) { return __uint_as_float(u & 0xffff0000u); }
__device__ __forceinline__ float bf2f(bf16 h) { return __uint_as_float(((unsigned)h) << 16); }
__device__ __forceinline__ void unpack8(const v4u v, float (&f)[8]) { f[0] = bflo(v.x); f[1] = bfhi(v.x); f[2] = bflo(v.y); f[3] = bfhi(v.y); f[4] = bflo(v.z); f[5] = bfhi(v.z); f[6] = bflo(v.w); f[7] = bfhi(v.w); }
__device__ __forceinline__ v4u pack8(const float (&f)[8]) { v4u o; o.x = pk2(f[0], f[1]); o.y = pk2(f[2], f[3]); o.z = pk2(f[4], f[5]); o.w = pk2(f[6], f[7]); return o; }
__device__ __forceinline__ float wave_sum(float v) {
#pragma unroll
    for (int o = 1; o < 64; o <<= 1) v += __shfl_xor(v, o);
    return v;
}
template <int CTRL> __device__ __forceinline__ float dppf(float x) { return __int_as_float(__builtin_amdgcn_update_dpp(0, __float_as_int(x), CTRL, 0xf, 0xf, false)); }
__device__ __forceinline__ float sum_x16(float x) { const auto r = __builtin_amdgcn_permlane16_swap(__float_as_uint(x), __float_as_uint(x), false, false); return __uint_as_float(r[0]) + __uint_as_float(r[1]); }
__device__ __forceinline__ float sum_x32(float x) { const auto r = __builtin_amdgcn_permlane32_swap(__float_as_uint(x), __float_as_uint(x), false, false); return __uint_as_float(r[0]) + __uint_as_float(r[1]); }
__device__ __forceinline__ float wave_sum_v(float x) { x += dppf<0xB1>(x); x += dppf<0x4E>(x); x += dppf<0x141>(x); x += dppf<0x128>(x); x = sum_x16(x); return sum_x32(x); }
__device__ __forceinline__ float silu_f(float x) { return x / (1.0f + __expf(-x)); }

#define XB_TMO      128
#define XB_XCNT(j)  (256  + 64 * (j))
#define XB_XSUB(j)  (1280 + 64 * (j))
#define XB_XGEN(j)  (2304 + 64 * (j))
#define XB_TOP      3328
#define XB_TOPGEN   3392
#define XCD_BAR_WORDS 3456
#define XB_SPIN_CAP (1u << 18)

__device__ __forceinline__ unsigned xb_ld(unsigned* p)              { return __hip_atomic_load(p, __ATOMIC_RELAXED, __HIP_MEMORY_SCOPE_AGENT); }
__device__ __forceinline__ unsigned xb_add(unsigned* p, unsigned v) { return __hip_atomic_fetch_add(p, v, __ATOMIC_RELAXED, __HIP_MEMORY_SCOPE_AGENT); }
__device__ __forceinline__ unsigned xb_xcc_id() { return (unsigned)__builtin_amdgcn_s_getreg((3 << 11) | 20) & 0xFu; }
#define XB_SPIN(cond, bar) do { unsigned _sp = 0; while (cond) { __builtin_amdgcn_s_sleep(1); \
    if ((++_sp & 255u) == 0u) { if (xb_ld(&(bar)[XB_TMO])) break; if (_sp > XB_SPIN_CAP) { atomicAdd(&(bar)[XB_TMO], 1u); break; } } } } while (0)

struct XcdBarrier {
    unsigned* bar; unsigned x;
    volatile LAS unsigned* st;
};

__device__ __forceinline__ XcdBarrier xcd_barrier_post(unsigned* bar, volatile LAS unsigned* st) {
    XcdBarrier b; b.bar = bar; b.x = xb_xcc_id(); b.st = st;
    if (threadIdx.x == 0) (void)xb_add(&bar[XB_XCNT(b.x)], 1u);
    return b;
}
__device__ __forceinline__ void xcd_barrier_complete(unsigned* bar, unsigned x, unsigned& nloc, unsigned& nx) {
    const unsigned G = gridDim.x * gridDim.y * gridDim.z;
    unsigned sum, cnt, mine, sp = 0u;
    for (;;) {
        sum = 0u; cnt = 0u; mine = 0u;
#pragma unroll
        for (unsigned j = 0; j < 16; ++j) { const unsigned c = xb_ld(&bar[XB_XCNT(j)]); sum += c; cnt += (c > 0u) ? 1u : 0u; mine = (j == x) ? c : mine; }
        if (sum == G) break;
        __builtin_amdgcn_s_sleep(1);
        if ((++sp & 255u) == 0u) { if (xb_ld(&bar[XB_TMO])) break; if (sp > XB_SPIN_CAP) { atomicAdd(&bar[XB_TMO], 1u); break; } }
    }
    nloc = mine > 0u ? mine : 1u; nx = cnt > 0u ? cnt : 1u;
}

__device__ __forceinline__ void xcd_barrier(const XcdBarrier& b) {
    asm volatile("s_waitcnt vmcnt(0)" ::: "memory");
    __syncthreads();
    if (threadIdx.x == 0) {
        unsigned* bar = b.bar;
        __builtin_amdgcn_s_waitcnt(0);
        unsigned nloc = b.st[0], nx = b.st[1];
        if (nloc == 0u) { xcd_barrier_complete(bar, b.x, nloc, nx); b.st[0] = nloc; b.st[1] = nx; }
        const unsigned old = xb_add(&bar[XB_XSUB(b.x)], 1u);
        const unsigned gen = old / nloc;
        if (old + 1u == (gen + 1u) * nloc) {
            __builtin_amdgcn_fence(__ATOMIC_RELEASE, "agent");
            asm volatile("s_waitcnt vmcnt(0)" ::: "memory");
            const unsigned og = xb_add(&bar[XB_TOP], 1u);
            const unsigned tg = og / nx;
            if (og + 1u == (tg + 1u) * nx) xb_add(&bar[XB_TOPGEN], 1u);
            else XB_SPIN(xb_ld(&bar[XB_TOPGEN]) == tg, bar);
            __builtin_amdgcn_fence(__ATOMIC_ACQUIRE, "agent");
            xb_add(&bar[XB_XGEN(b.x)], 1u);
            asm volatile("s_waitcnt vmcnt(0)" ::: "memory");
        } else {
            XB_SPIN(xb_ld(&bar[XB_XGEN(b.x)]) == gen, bar);
            __builtin_amdgcn_fence(__ATOMIC_ACQUIRE, "agent");
            asm volatile("s_waitcnt vmcnt(0)" ::: "memory");
        }
    }
    __syncthreads();
}

struct Ctx { LAS unsigned char* lds; int tid, lane, wave, vcu, G; };

__device__ __forceinline__ int win_colmap(int n) { return n < 2048 ? n : (n < 2816 ? n + 8 : (n < INW ? n - 2816 + 2048 : -1)); }
__device__ __forceinline__ void tr_item(const float* W, int Nsrc, int K, bf16* WT, const float* rowscale, LAS float* scr, int kb, int nb, int lane, bool mapped) {
    const int k0 = 64 * kb, n0 = 32 * nb; const int n = n0 + (lane & 31); const int sc = mapped ? win_colmap(n) : n;
#pragma unroll 8
    for (int i = 0; i < 32; ++i) { const int kk = 2 * i + (lane >> 5); float v = 0.f; if (sc >= 0) { v = W[(size_t)(k0 + kk) * Nsrc + sc]; if (rowscale) v *= rowscale[k0 + kk]; } scr[kk * 33 + (lane & 31)] = v; }
    LDS_WAIT(); asm volatile("" ::: "memory");
    const int c = lane & 7;
#pragma unroll
    for (int j = 0; j < 4; ++j) { const int nn = (lane >> 3) + 8 * j; const LAS float* s = scr + (8 * c) * 33 + nn;
        v4u o; o.x = pk2(s[0 * 33], s[1 * 33]); o.y = pk2(s[2 * 33], s[3 * 33]); o.z = pk2(s[4 * 33], s[5 * 33]); o.w = pk2(s[6 * 33], s[7 * 33]);
        *(GAS v4u*)(WT + (size_t)(n0 + nn) * K + k0 + 8 * c) = o; }
    LDS_WAIT(); asm volatile("" ::: "memory");
}
__device__ __forceinline__ void p0_prologue(const Ctx F, const float* x, const float* norm1_w, const float* w_in, const float* w_out, const float* norm2_w, const float* w_q, const float* sub_keys, unsigned char* ws) {
    bf16* WIN = (bf16*)(ws + WS_WIN); bf16* WOUT = (bf16*)(ws + WS_WOUT); bf16* WST = (bf16*)(ws + WS_WS);
    LAS float* scr = (LAS float*)(F.lds + F.wave * 16384);
    const int gw = F.vcu * NWAVES + F.wave, NGW = F.G * NWAVES;
    constexpr int I_IN = (DM / 64) * (NP / 32), I_OUT = (DM / 64) * (DM / 32);
    for (int it = gw; it < DEPTH * (I_IN + I_OUT); it += NGW) {
        int r = it;
        if (r < DEPTH * I_IN) { const int L = r / I_IN; r -= L * I_IN; tr_item(w_in + (size_t)L * DM * INW, INW, DM, WIN + (size_t)L * NP * DM, norm1_w + L * DM, scr, r / (NP / 32), r % (NP / 32), F.lane, true); }
        else { r -= DEPTH * I_IN; const int L = r / I_OUT; r -= L * I_OUT; tr_item(w_out + (size_t)L * DM * DM, DM, DM, WOUT + (size_t)L * DM * DM, nullptr, scr, r / (DM / 32), r % (DM / 32), F.lane, false); }
    }
    {
        typedef float f32x4w __attribute__((ext_vector_type(4)));
        const int fr = F.lane & 15, fq = F.lane >> 4;
        for (int u = gw; u < DEPTH * 8 * 64 * 2; u += NGW) {
            const int jh = u & 1, dt = (u >> 1) & 63, sl = (u >> 7) & 7, L = u >> 10, half = sl & 1;
            const float* Aq = w_q + (size_t)L * DM * DM + (size_t)(16 * dt + fr) * DM + sl * 128 + fq;
            const float* Bk = sub_keys + ((size_t)L * 2 + half) * 128 * 128 + (size_t)(64 * jh + fr) * 128 + fq;
            f32x4w acc[4];
#pragma unroll
            for (int j = 0; j < 4; ++j) acc[j] = (f32x4w){0.f, 0.f, 0.f, 0.f};
#pragma unroll 4
            for (int kk = 0; kk < 32; ++kk) { const float a = Aq[4 * kk];
#pragma unroll
                for (int j = 0; j < 4; ++j) acc[j] = __builtin_amdgcn_mfma_f32_16x16x4f32(a, Bk[(size_t)(16 * j) * 128 + 4 * kk], acc[j], 0, 0, 0); }
            const f32x4 w4 = *(const f32x4*)(norm2_w + L * DM + 16 * dt + 4 * fq);
#pragma unroll
            for (int j = 0; j < 4; ++j) *(v2u*)(WST + (size_t)L * DM * DM + (size_t)(sl * 128 + 64 * jh + 16 * j + fr) * DM + 16 * dt + 4 * fq) = (v2u){pk2(acc[j][0] * w4[0], acc[j][1] * w4[1]), pk2(acc[j][2] * w4[2], acc[j][3] * w4[3])};
        }
    }
    { bf16* XB = (bf16*)(ws + WS_XB); float* RS1 = (float*)(ws + WS_RS1);
    for (int m = gw; m < M; m += NGW) {
        const f32x4* xr = (const f32x4*)(x + (size_t)m * DM) + F.lane; f32x4 v[4]; float s = 0.f;
#pragma unroll
        for (int j = 0; j < 4; ++j) { v[j] = xr[64 * j]; s += (v[j][0] * v[j][0] + v[j][1] * v[j][1]) + (v[j][2] * v[j][2] + v[j][3] * v[j][3]); }
        const float rstd = 1.0f / sqrtf(wave_sum_v(s) * (1.0f / DM) + EPS);
        v2u* o8 = (v2u*)(XB + (size_t)m * DM) + F.lane;
#pragma unroll
        for (int j = 0; j < 4; ++j) { v2u o; o.x = pk2(v[j][0], v[j][1]); o.y = pk2(v[j][2], v[j][3]); o8[64 * j] = o; }
        if (F.lane == 0) RS1[m] = rstd;
    } }
}

typedef float f32x16 __attribute__((ext_vector_type(16)));
typedef short bf16x8 __attribute__((ext_vector_type(8)));
typedef short v4i16_t __attribute__((ext_vector_type(4)));
constexpr int AT_VS = 72;
__device__ __forceinline__ int crow(int r, int hi) { return (r & 3) + 8 * (r >> 2) + 4 * hi; }
__device__ __forceinline__ void attn_mfma(const Ctx F, const bf16* P, bf16* Y) {
    LAS bf16* vt = (LAS bf16*)(F.lds + F.wave * 8192);
    const int lane = F.lane, r32 = lane & 31, hi = lane >> 5;
    const int gw = F.vcu * NWAVES + F.wave, NGW = F.G * NWAVES;
    const LAS bf16* vrd = vt + (4 * hi + ((lane & 15) >> 2)) * AT_VS + 16 * ((lane >> 4) & 1) + 4 * (lane & 3);
#pragma unroll 1
    for (int u = gw; u < BATCH * 4 * (SEQ / 32); u += NGW) {
        const int qb = u & (SEQ / 32 - 1), bh = u / (SEQ / 32), h = bh & 3, b = bh >> 2;
        const int q0 = qb * 32; const size_t rowbase = (size_t)b * SEQ; const int t = q0 + r32;
        bf16x8 qf[4];
#pragma unroll
        for (int d0 = 0; d0 < 4; ++d0) { float f[8]; unpack8(*(const v4u*)(P + (rowbase + q0 + r32) * NP + QOFF + h * 64 + d0 * 16 + hi * 8), f);
#pragma unroll
            for (int i = 0; i < 8; ++i) f[i] *= 0.125f;
            qf[d0] = __builtin_bit_cast(bf16x8, pack8(f)); }
        f32x16 o0, o1;
#pragma unroll
        for (int r = 0; r < 16; ++r) { o0[r] = 0.f; o1[r] = 0.f; }
        float R = 0.f;
        int k0 = q0; bool diag = true;
        v4u kf[4], vr[4];
        { const bf16* kp = P + (rowbase + k0 + r32) * NP + KOFF + h * 64 + hi * 8; const bf16* vp = P + (rowbase + k0 + (lane >> 1)) * NP + VOFF + h * 64 + (lane & 1) * 32;
#pragma unroll
          for (int c = 0; c < 4; ++c) { kf[c] = *(const v4u*)(kp + c * 16); vr[c] = *(const v4u*)(vp + c * 8); } }
#pragma unroll 1
        for (;;) {
#pragma unroll
            for (int c = 0; c < 4; ++c) *(LAS v4u*)(vt + (lane >> 1) * AT_VS + (lane & 1) * 32 + c * 8) = vr[c];
            bf16x8 ka[4];
#pragma unroll
            for (int c = 0; c < 4; ++c) ka[c] = __builtin_bit_cast(bf16x8, kf[c]);
            const int kn = k0 - 32;
            if (kn >= 0) { const bf16* kp = P + (rowbase + kn + r32) * NP + KOFF + h * 64 + hi * 8; const bf16* vp = P + (rowbase + kn + (lane >> 1)) * NP + VOFF + h * 64 + (lane & 1) * 32;
#pragma unroll
                for (int c = 0; c < 4; ++c) { kf[c] = *(const v4u*)(kp + c * 16); vr[c] = *(const v4u*)(vp + c * 8); } }
            f32x16 p;
#pragma unroll
            for (int r = 0; r < 16; ++r) p[r] = 0.f;
#pragma unroll
            for (int d0 = 0; d0 < 4; ++d0) p = __builtin_amdgcn_mfma_f32_32x32x16_bf16(ka[d0], qf[d0], p, 0, 0, 0);
            float l[16], ee[16];
#pragma unroll
            for (int r = 0; r < 16; ++r) { const float z = p[r]; const float sp = fmaxf(z, 0.f) + __logf(1.0f + __expf(-fabsf(z)));
                const bool valid = !diag || (k0 + crow(r, hi) < t);
                l[r] = valid ? -sp : 0.f; ee[r] = valid ? (z - sp) : -INFINITY; }
            float gs[4], pg[4], tot[4], later[4];
#pragma unroll
            for (int g = 0; g < 4; ++g) { gs[g] = (l[4 * g] + l[4 * g + 1]) + (l[4 * g + 2] + l[4 * g + 3]); tot[g] = sum_x32(gs[g]); pg[g] = tot[g] - gs[g]; }
            later[3] = 0.f; later[2] = tot[3]; later[1] = tot[3] + tot[2]; later[0] = later[1] + tot[1];
            if (hi == 0) {
#pragma unroll
                for (int g = 0; g < 4; ++g) later[g] += pg[g]; }
#pragma unroll
            for (int g = 0; g < 4; ++g) { const float base = R + later[g];
                const float s3 = base, s2 = s3 + l[4 * g + 3], s1 = s2 + l[4 * g + 2], s0 = s1 + l[4 * g + 1];
                p[4 * g + 3] = __expf(ee[4 * g + 3] + s3); p[4 * g + 2] = __expf(ee[4 * g + 2] + s2); p[4 * g + 1] = __expf(ee[4 * g + 1] + s1); p[4 * g] = __expf(ee[4 * g] + s0); }
            R += (tot[0] + tot[1]) + (tot[2] + tot[3]);
            bf16x8 pb[2];
#pragma unroll
            for (int ks = 0; ks < 2; ++ks) { float f[8];
#pragma unroll
                for (int j = 0; j < 8; ++j) f[j] = p[8 * ks + j];
                pb[ks] = __builtin_bit_cast(bf16x8, pack8(f)); }
#pragma unroll
            for (int ks = 0; ks < 2; ++ks)
#pragma unroll
                for (int dt = 0; dt < 2; ++dt) {
                    const v4i16_t lo = __builtin_amdgcn_ds_read_tr16_b64_v4i16((LAS v4i16_t*)(vrd + (16 * ks) * AT_VS + 32 * dt));
                    const v4i16_t hi4 = __builtin_amdgcn_ds_read_tr16_b64_v4i16((LAS v4i16_t*)(vrd + (16 * ks + 8) * AT_VS + 32 * dt));
                    const bf16x8 va = (bf16x8){lo[0], lo[1], lo[2], lo[3], hi4[0], hi4[1], hi4[2], hi4[3]};
                    if (dt == 0) o0 = __builtin_amdgcn_mfma_f32_32x32x16_bf16(va, pb[ks], o0, 0, 0, 0); else o1 = __builtin_amdgcn_mfma_f32_32x32x16_bf16(va, pb[ks], o1, 0, 0, 0);
                }
            if (kn < 0 || __all(R < SB_EXIT)) break;
            k0 = kn; diag = false;
        }
        bf16* yp = Y + (rowbase + q0 + r32) * DM + h * 64;
#pragma unroll
        for (int g = 0; g < 4; ++g) { v2u a, c; a.x = pk2(o0[4 * g], o0[4 * g + 1]); a.y = pk2(o0[4 * g + 2], o0[4 * g + 3]); c.x = pk2(o1[4 * g], o1[4 * g + 1]); c.y = pk2(o1[4 * g + 2], o1[4 * g + 3]);
            *(v2u*)(yp + 8 * g + 4 * hi) = a; *(v2u*)(yp + 32 + 8 * g + 4 * hi) = c; }
    }
}
__device__ __forceinline__ void shortconv(const Ctx F, const bf16* P, bf16* Y, const float* cw  ) {
    for (long it = (long)F.vcu * 512 + F.tid; it < (long)(M / 8) * 32; it += (long)F.G * 512) {
        const size_t row0 = (size_t)(it >> 5) * 8; const int c0 = (int)(it & 31) * 8; const int t0 = (int)(row0 & (SEQ - 1));
        v4u cr[10], vr[10], br[8];
#pragma unroll
        for (int j = 0; j < 10; ++j) { const bool ok = (j >= 2) || (t0 > 0);
            cr[j] = ok ? *(const v4u*)(P + (row0 + j - 2) * NP + SCOFF + c0) : (v4u){0u, 0u, 0u, 0u}; vr[j] = ok ? *(const v4u*)(P + (row0 + j - 2) * NP + SVOFF + c0) : (v4u){0u, 0u, 0u, 0u}; }
#pragma unroll
        for (int j = 0; j < 8; ++j) br[j] = *(const v4u*)(P + (row0 + j) * NP + SBOFF + c0);
        float w[3][8];
#pragma unroll
        for (int k = 0; k < 3; ++k) { const f32x4 w0 = *(const f32x4*)(cw + k * 256 + c0), w1 = *(const f32x4*)(cw + k * 256 + c0 + 4);
#pragma unroll
            for (int i = 0; i < 4; ++i) { w[k][i] = w0[i]; w[k][4 + i] = w1[i]; } }
        float cv[10][8];
#pragma unroll
        for (int j = 0; j < 10; ++j) { float c8[8], v8[8]; unpack8(cr[j], c8); unpack8(vr[j], v8);
#pragma unroll
            for (int i = 0; i < 8; ++i) cv[j][i] = c8[i] * v8[i]; }
#pragma unroll
        for (int j = 0; j < 8; ++j) { float b8[8], o[8]; unpack8(br[j], b8);
#pragma unroll
            for (int i = 0; i < 8; ++i) o[i] = b8[i] * (w[0][i] * cv[j][i] + w[1][i] * cv[j + 1][i] + w[2][i] * cv[j + 2][i]);
            *(v4u*)(Y + (row0 + j) * DM + 768 + c0) = pack8(o); }
    }
}
constexpr int XTS = 72, BNS = 136;
constexpr int L_XT = 0, L_BN = L_XT + 512 * XTS * 2, L_BT = L_BN + 64 * BNS * 2, L_CN = L_BT + 128 * XTS * 2, L_GG = L_CN + 64 * BNS * 2, L_DT = L_GG + 128 * XTS * 2, L_ACS = L_DT + 2048, L_WL = L_ACS + 2048, L_SSD_END = L_WL + 2048;
static_assert(L_SSD_END <= LDSCTL_OFF, "SSD part 1 LDS");
typedef float f32x4v __attribute__((ext_vector_type(4)));
__device__ __forceinline__ void ssd_part1(const Ctx F, const bf16* P, bf16* Y, const float* cw  , const float* cb  , const float* dt_bias, const float* A_log, const float* Dp,
                                          bf16* CC, float* EA, float* CD, bf16* ST) {
    LAS bf16* XT = (LAS bf16*)(F.lds + L_XT); LAS bf16* BN = (LAS bf16*)(F.lds + L_BN); LAS bf16* BT = (LAS bf16*)(F.lds + L_BT); LAS bf16* CN = (LAS bf16*)(F.lds + L_CN); LAS bf16* GG = (LAS bf16*)(F.lds + L_GG);
    LAS float* DTH = (LAS float*)(F.lds + L_DT); LAS float* ACH = (LAS float*)(F.lds + L_ACS); LAS float* WLH = (LAS float*)(F.lds + L_WL);
    const int lane = F.lane, fr = lane & 15, fq = lane >> 4;
#pragma unroll 1
    for (int u = F.vcu; u < BATCH * NCHUNK; u += F.G) {
        const int b = u / NCHUNK, c = u % NCHUNK, t0 = c * 64; const size_t r0 = (size_t)b * SEQ + t0;
        __syncthreads();
        if (F.tid < 384) { const int ch = 2 * F.tid;
            float w0[4], w1[4];
#pragma unroll
            for (int k = 0; k < 4; ++k) { w0[k] = cw[k * 768 + ch]; w1[k] = cw[k * 768 + ch + 1]; }
            const float b0 = cb[ch], b1 = cb[ch + 1];
            const bf16* pin = P + ((size_t)b * SEQ + t0) * NP + XOFF + ch;
            unsigned h0 = 0u, h1 = 0u, h2 = 0u;
            if (t0 > 0) { h0 = *(const unsigned*)(pin - 3 * (ptrdiff_t)NP); h1 = *(const unsigned*)(pin - 2 * (ptrdiff_t)NP); h2 = *(const unsigned*)(pin - (ptrdiff_t)NP); }
#pragma unroll 1
            for (int tq = 0; tq < 4; ++tq) {
                unsigned r[16];
#pragma unroll
                for (int j = 0; j < 16; ++j) r[j] = *(const unsigned*)(pin + (size_t)(16 * tq + j) * NP);
#pragma unroll
                for (int tg4 = 0; tg4 < 4; ++tg4) { const int tg = 4 * tq + tg4;
                    const unsigned in[7] = {tg4 == 0 ? h0 : r[4 * tg4 - 3], tg4 == 0 ? h1 : r[4 * tg4 - 2], tg4 == 0 ? h2 : r[4 * tg4 - 1], r[4 * tg4], r[4 * tg4 + 1], r[4 * tg4 + 2], r[4 * tg4 + 3]};
                    float y0[4], y1[4];
#pragma unroll
                    for (int j = 0; j < 4; ++j) { float a0 = b0, a1 = b1;
#pragma unroll
                        for (int k = 0; k < 4; ++k) { a0 += w0[k] * bflo(in[j + k]); a1 += w1[k] * bfhi(in[j + k]); }
                        y0[j] = silu_f(a0); y1[j] = silu_f(a1); }
                    const v2u t0v = (v2u){pk2(y0[0], y0[1]), pk2(y0[2], y0[3])}, t1v = (v2u){pk2(y1[0], y1[1]), pk2(y1[2], y1[3])};
                    if (ch < 512) { *(LAS v2u*)(XT + ch * XTS + 4 * tg) = t0v; *(LAS v2u*)(XT + (ch + 1) * XTS + 4 * tg) = t1v; }
                    else if (ch < 640) { const int nb = ch - 512; *(LAS v2u*)(BT + nb * XTS + 4 * tg) = t0v; *(LAS v2u*)(BT + (nb + 1) * XTS + 4 * tg) = t1v;
#pragma unroll
                        for (int j = 0; j < 4; ++j) *(LAS unsigned*)(BN + (4 * tg + j) * BNS + nb) = pk2(y0[j], y1[j]); }
                    else { const int nc = ch - 640;
#pragma unroll
                        for (int j = 0; j < 4; ++j) { const unsigned pk = pk2(y0[j], y1[j]); *(LAS unsigned*)(CN + (4 * tg + j) * BNS + nc) = pk; *(unsigned*)(CC + (r0 + 4 * tg + j) * 128 + nc) = pk; } }
                }
                h0 = r[13]; h1 = r[14]; h2 = r[15];
            }
        }
        { const int h = F.wave, l = lane; const float xx = bf2f(P[(r0 + l) * NP + DTOFF + h]) + dt_bias[h]; const float dt = xx > 20.f ? xx : log1pf(__expf(xx));
          const float A = -__expf(A_log[h]); float cs = dt * A;
#pragma unroll
          for (int o = 1; o < 64; o <<= 1) { const float tmp = __shfl_up(cs, o); if (l >= o) cs += tmp; }
          const float last = __shfl(cs, 63);
          DTH[h * 64 + l] = dt; ACH[h * 64 + l] = cs; WLH[h * 64 + l] = __expf(last - cs) * dt;
          EA[(r0 + l) * 8 + h] = __expf(cs); if (l == 63) CD[(size_t)u * 8 + h] = __expf(cs); }
        __syncthreads();
        { const int g = F.wave >> 2, mt = F.wave & 3;
          const bf16x8 c0 = *(const LAS bf16x8*)(CN + (16 * mt + fr) * BNS + g * 64 + 8 * fq), c1 = *(const LAS bf16x8*)(CN + (16 * mt + fr) * BNS + g * 64 + 32 + 8 * fq);
#pragma unroll 1
          for (int nt = 0; nt <= mt; ++nt) {
              const bf16x8 b0 = *(const LAS bf16x8*)(BN + (16 * nt + fr) * BNS + g * 64 + 8 * fq), b1 = *(const LAS bf16x8*)(BN + (16 * nt + fr) * BNS + g * 64 + 32 + 8 * fq);
              f32x4v acc = (f32x4v){0.f, 0.f, 0.f, 0.f};
              acc = __builtin_amdgcn_mfma_f32_16x16x32_bf16(b0, c0, acc, 0, 0, 0); acc = __builtin_amdgcn_mfma_f32_16x16x32_bf16(b1, c1, acc, 0, 0, 0);
              *(LAS v2u*)(GG + (g * 64 + 16 * mt + fr) * XTS + 16 * nt + 4 * fq) = (v2u){pk2(acc[0], acc[1]), pk2(acc[2], acc[3])}; } }
        __syncthreads();
        { const int h = F.wave, g = h >> 2;
          bf16x8 xa[4][2];
#pragma unroll
          for (int nt = 0; nt < 4; ++nt)
#pragma unroll
              for (int ks = 0; ks < 2; ++ks) xa[nt][ks] = *(const LAS bf16x8*)(XT + (h * 64 + 16 * nt + fr) * XTS + 32 * ks + 8 * fq);
          {
            f32x4v acc[4][4];
#pragma unroll
            for (int nt = 0; nt < 4; ++nt)
#pragma unroll
                for (int mt = 0; mt < 4; ++mt) acc[nt][mt] = (f32x4v){0.f, 0.f, 0.f, 0.f};
#pragma unroll
            for (int mt = 0; mt < 4; ++mt)
#pragma unroll
                for (int ks = 0; ks < 2; ++ks) if (32 * ks <= 16 * mt + 15) {
                    const int l = 16 * mt + fr, s0 = 32 * ks + 8 * fq;
                    float gf[8]; unpack8(*(const LAS v4u*)(GG + (g * 64 + l) * XTS + s0), gf);
                    const float al = ACH[h * 64 + l]; const f32x4 a0 = *(const LAS f32x4*)(ACH + h * 64 + s0), a1 = *(const LAS f32x4*)(ACH + h * 64 + s0 + 4), d0 = *(const LAS f32x4*)(DTH + h * 64 + s0), d1 = *(const LAS f32x4*)(DTH + h * 64 + s0 + 4);
                    float mf[8];
#pragma unroll
                    for (int j = 0; j < 4; ++j) { mf[j] = (s0 + j <= l) ? gf[j] * __expf(al - a0[j]) * d0[j] : 0.f; mf[4 + j] = (s0 + 4 + j <= l) ? gf[4 + j] * __expf(al - a1[j]) * d1[j] : 0.f; }
                    const bf16x8 mfr = __builtin_bit_cast(bf16x8, pack8(mf));
#pragma unroll
                    for (int nt = 0; nt < 4; ++nt) acc[nt][mt] = __builtin_amdgcn_mfma_f32_16x16x32_bf16(xa[nt][ks], mfr, acc[nt][mt], 0, 0, 0);
                }
            const float Dh = Dp[h];
#pragma unroll
            for (int mt = 0; mt < 4; ++mt)
#pragma unroll
                for (int nt = 0; nt < 4; ++nt) { const int l = 16 * mt + fr, p0 = 16 * nt + 4 * fq; float o[4];
#pragma unroll
                    for (int r = 0; r < 4; ++r) o[r] = acc[nt][mt][r] + Dh * bf2f(XT[(h * 64 + p0 + r) * XTS + l]);
                    *(v2u*)(Y + (r0 + l) * DM + 256 + h * 64 + p0) = (v2u){pk2(o[0], o[1]), pk2(o[2], o[3])}; }
          }
          {
#pragma unroll
            for (int ks = 0; ks < 2; ++ks) { const f32x4 w0 = *(const LAS f32x4*)(WLH + h * 64 + 32 * ks + 8 * fq), w1 = *(const LAS f32x4*)(WLH + h * 64 + 32 * ks + 8 * fq + 4);
#pragma unroll
                for (int nt = 0; nt < 4; ++nt) { float f[8]; unpack8(__builtin_bit_cast(v4u, xa[nt][ks]), f);
#pragma unroll
                    for (int j = 0; j < 4; ++j) { f[j] *= w0[j]; f[4 + j] *= w1[j]; }
                    xa[nt][ks] = __builtin_bit_cast(bf16x8, pack8(f)); } }
            f32x4v acc[4][4];
#pragma unroll
            for (int n4 = 0; n4 < 4; ++n4)
#pragma unroll
                for (int pt = 0; pt < 4; ++pt) acc[n4][pt] = (f32x4v){0.f, 0.f, 0.f, 0.f};
#pragma unroll
            for (int n4 = 0; n4 < 4; ++n4)
#pragma unroll
                for (int ks = 0; ks < 2; ++ks) { const bf16x8 bt = *(const LAS bf16x8*)(BT + (g * 64 + 16 * n4 + fr) * XTS + 32 * ks + 8 * fq);
#pragma unroll
                    for (int pt = 0; pt < 4; ++pt) acc[n4][pt] = __builtin_amdgcn_mfma_f32_16x16x32_bf16(bt, xa[pt][ks], acc[n4][pt], 0, 0, 0); }
#pragma unroll
            for (int n4 = 0; n4 < 4; ++n4)
#pragma unroll
                for (int pt = 0; pt < 4; ++pt) *(v2u*)(ST + (((size_t)u * 8 + h) * 64 + 16 * pt + fr) * 64 + 16 * n4 + 4 * fq) = (v2u){pk2(acc[n4][pt][0], acc[n4][pt][1]), pk2(acc[n4][pt][2], acc[n4][pt][3])};
          }
        }
    }
    __syncthreads();
}
__device__ __forceinline__ void convert_tables(const int lane, const float* pu, const float* pv, unsigned char* ws, int L, int wid, int nw) {
    unsigned char* U8 = ws + WS_U8; unsigned char* V8 = ws + WS_V8; float* USc = (float*)(ws + WS_US); float* VSc = (float*)(ws + WS_VS);
#pragma unroll 1
    for (int r = wid; r < 2 * 16384; r += nw) {
        const bool isv = r >= 16384; const int rr = L * 16384 + (isv ? r - 16384 : r); const float* src = (isv ? pv : pu) + (size_t)rr * DM + lane * 16;
        f32x4 v[4]; float am = 0.f;
#pragma unroll
        for (int j = 0; j < 4; ++j) { v[j] = *(const f32x4*)(src + 4 * j); am = fmaxf(am, fmaxf(fmaxf(fabsf(v[j][0]), fabsf(v[j][1])), fmaxf(fabsf(v[j][2]), fabsf(v[j][3])))); }
        am = fmaxf(am, dppf<0xB1>(am)); am = fmaxf(am, dppf<0x4E>(am)); am = fmaxf(am, dppf<0x141>(am)); am = fmaxf(am, dppf<0x128>(am));
        { const auto r16 = __builtin_amdgcn_permlane16_swap(__float_as_uint(am), __float_as_uint(am), false, false); am = fmaxf(__uint_as_float(r16[0]), __uint_as_float(r16[1]));
          const auto r32 = __builtin_amdgcn_permlane32_swap(__float_as_uint(am), __float_as_uint(am), false, false); am = fmaxf(__uint_as_float(r32[0]), __uint_as_float(r32[1])); }
        int ex = 0; if (am > 0.f) (void)frexpf(am, &ex); else ex = 8;
        const float sc = ldexpf(1.0f, 8 - ex), isc = ldexpf(1.0f, ex - 8);
        v4u o;
#pragma unroll
        for (int j = 0; j < 4; ++j) { int w = 0; w = __builtin_amdgcn_cvt_pk_fp8_f32(v[j][0] * sc, v[j][1] * sc, w, false); w = __builtin_amdgcn_cvt_pk_fp8_f32(v[j][2] * sc, v[j][3] * sc, w, true); o[j] = (unsigned)w; }
        *(v4u*)((isv ? V8 : U8) + (size_t)rr * DM + lane * 16) = o;
        if (lane == 0) (isv ? VSc : USc)[rr] = isc;
    }
}
__device__ __forceinline__ void ssd_scan(const Ctx F, bf16* ST, const float* CD, bool dry) {
    if (F.tid < 128) for (int e = F.vcu * 128 + F.tid; e < BATCH * 16384; e += F.G * 128) {
        const int b = e >> 14, hpn2 = e & 16383, h = hpn2 >> 11; float r0 = 0.f, r1 = 0.f;
        unsigned* sp = (unsigned*)ST + ((size_t)b * NCHUNK << 14) + hpn2; const float* dp = CD + (size_t)b * NCHUNK * 8 + h;
#pragma unroll 1
        for (int c = 0; c < NCHUNK; c += 32) { unsigned s[32]; float d[32];
#pragma unroll
            for (int i = 0; i < 32; ++i) { s[i] = sp[(size_t)(c + i) << 14]; d[i] = dp[(c + i) * 8]; }
#pragma unroll
            for (int i = 0; i < 32; ++i) { if (!dry) sp[(size_t)(c + i) << 14] = pk2(r0, r1); r0 = r0 * d[i] + bflo(s[i]); r1 = r1 * d[i] + bfhi(s[i]); } }
        asm volatile("" :: "v"(r0), "v"(r1));
    }
}
__device__ __forceinline__ void ssd_part2(const Ctx F, const bf16* P, bf16* Y, const bf16* CC, const float* EA, const bf16* ST, const float* nw  , bool dry) {
    LAS float* SSH = (LAS float*)F.lds;
    const int lane = F.lane, fr = lane & 15, fq = lane >> 4, h = F.wave, g = h >> 2;
#pragma unroll 1
    for (int u = F.vcu; u < BATCH * NCHUNK; u += F.G) {
        const int b = u / NCHUNK, c = u % NCHUNK; const size_t r0 = (size_t)b * SEQ + c * 64;
        bf16x8 pa[4][2], cbf[4][2];
#pragma unroll
        for (int pt = 0; pt < 4; ++pt)
#pragma unroll
            for (int ks = 0; ks < 2; ++ks) { pa[pt][ks] = __builtin_bit_cast(bf16x8, *(const v4u*)(ST + (((size_t)u * 8 + h) * 64 + 16 * pt + fr) * 64 + 32 * ks + 8 * fq));
                cbf[pt][ks] = __builtin_bit_cast(bf16x8, *(const v4u*)(CC + (r0 + 16 * pt + fr) * 128 + g * 64 + 32 * ks + 8 * fq)); }
        v2u yv4[4][4], zv4[4][4]; float ea4[4];
#pragma unroll
        for (int lt = 0; lt < 4; ++lt) { const int l = 16 * lt + fr; ea4[lt] = EA[(r0 + l) * 8 + h];
#pragma unroll
            for (int pt = 0; pt < 4; ++pt) { const int p0 = 16 * pt + 4 * fq; yv4[lt][pt] = *(const v2u*)(Y + (r0 + l) * DM + 256 + h * 64 + p0); zv4[lt][pt] = *(const v2u*)(P + (r0 + l) * NP + ZOFF + h * 64 + p0); } }
        f32x4v acc[4][4];
#pragma unroll
        for (int pt = 0; pt < 4; ++pt)
#pragma unroll
            for (int lt = 0; lt < 4; ++lt) { acc[pt][lt] = (f32x4v){0.f, 0.f, 0.f, 0.f};
#pragma unroll
                for (int ks = 0; ks < 2; ++ks) acc[pt][lt] = __builtin_amdgcn_mfma_f32_16x16x32_bf16(pa[pt][ks], cbf[lt][ks], acc[pt][lt], 0, 0, 0); }
        float ssl[4];
#pragma unroll
        for (int lt = 0; lt < 4; ++lt) { const float ea = ea4[lt]; ssl[lt] = 0.f;
#pragma unroll
            for (int pt = 0; pt < 4; ++pt) { const v2u yv = yv4[lt][pt], zv = zv4[lt][pt];
                const float yd[4] = {bflo(yv.x), bfhi(yv.x), bflo(yv.y), bfhi(yv.y)}, zz[4] = {bflo(zv.x), bfhi(zv.x), bflo(zv.y), bfhi(zv.y)};
#pragma unroll
                for (int r = 0; r < 4; ++r) { const float v = (yd[r] + ea * acc[pt][lt][r]) * silu_f(zz[r]); acc[pt][lt][r] = v; ssl[lt] += v * v; } } }
        __syncthreads();
#pragma unroll
        for (int lt = 0; lt < 4; ++lt) { const float s = sum_x32(sum_x16(ssl[lt])); if (fq == 0) SSH[h * 64 + 16 * lt + fr] = s; }
        __syncthreads();
#pragma unroll
        for (int lt = 0; lt < 4; ++lt) { const int l = 16 * lt + fr; float t = 0.f;
#pragma unroll
            for (int hh = 0; hh < 8; ++hh) t += SSH[hh * 64 + l];
            const float rstd = 1.0f / sqrtf(t * (1.0f / 512.0f) + EPS);
#pragma unroll
            for (int pt = 0; pt < 4; ++pt) { const int p0 = 16 * pt + 4 * fq; const f32x4 w4 = *(const f32x4*)(nw + h * 64 + p0);
                const v2u o = (v2u){pk2(acc[pt][lt][0] * rstd * w4[0], acc[pt][lt][1] * rstd * w4[1]), pk2(acc[pt][lt][2] * rstd * w4[2], acc[pt][lt][3] * rstd * w4[3])};
                if (!dry) *(v2u*)(Y + (r0 + l) * DM + 256 + h * 64 + p0) = o; } }
    }
}
constexpr int L7_EI = 0, L7_CF = 16384, L7_PT = L7_CF + 32768, L7_RS = L7_PT + 32768, L7_SSQ = L7_RS + 512, L7_W2 = L7_SSQ + 512, L7_SCL = L7_W2 + 4096, L7_END = L7_SCL + 8 * 9216;
static_assert(L7_END <= LDSCTL_OFF, "PEER LDS");
__device__ __forceinline__ unsigned mk_key(float f, unsigned idx) { const unsigned u = __float_as_uint(f); unsigned k = (u & 0x80000000u) ? ~u : (u | 0x80000000u); return (k & ~127u) | (127u - idx); }
__device__ __forceinline__ float key_val(unsigned k) { const unsigned kk = k & ~127u; return __uint_as_float((kk & 0x80000000u) ? (kk & 0x7fffffffu) : ~kk); }
__device__ __forceinline__ void ce_desc(unsigned& a, unsigned& b) { const unsigned hi = a > b ? a : b; const unsigned lo = a > b ? b : a; a = hi; b = lo; }
__device__ __forceinline__ void bitonic_sort16_desc(unsigned (&v)[16]) {
#pragma unroll
    for (int k = 2; k <= 16; k <<= 1)
#pragma unroll
        for (int j = k >> 1; j > 0; j >>= 1)
#pragma unroll
            for (int i = 0; i < 16; ++i) { const int l = i ^ j; if (l > i) { if ((i & k) == 0) ce_desc(v[i], v[l]); else ce_desc(v[l], v[i]); } }
}
__device__ __forceinline__ void bitonic_merge16_desc(unsigned (&v)[16]) {
#pragma unroll
    for (int j = 8; j > 0; j >>= 1)
#pragma unroll
        for (int i = 0; i < 16; ++i) { const int l = i ^ j; if (l > i) ce_desc(v[i], v[l]); }
}
__device__ __forceinline__ void topk16_slice(const float* sp, unsigned (&lst)[16]) {
    { const f32x4 a = *(const f32x4*)sp, b = *(const f32x4*)(sp + 4), c = *(const f32x4*)(sp + 8), d = *(const f32x4*)(sp + 12);
#pragma unroll
      for (int e = 0; e < 4; ++e) { lst[e] = mk_key(a[e], (unsigned)e); lst[4 + e] = mk_key(b[e], (unsigned)(4 + e)); lst[8 + e] = mk_key(c[e], (unsigned)(8 + e)); lst[12 + e] = mk_key(d[e], (unsigned)(12 + e)); } }
    bitonic_sort16_desc(lst);
#pragma unroll 1
    for (int ch = 1; ch < 8; ++ch) { unsigned cv[16];
        const f32x4 a = *(const f32x4*)(sp + 16 * ch), b = *(const f32x4*)(sp + 16 * ch + 4), c = *(const f32x4*)(sp + 16 * ch + 8), d = *(const f32x4*)(sp + 16 * ch + 12);
#pragma unroll
        for (int e = 0; e < 4; ++e) { cv[e] = mk_key(a[e], (unsigned)(16 * ch + e)); cv[4 + e] = mk_key(b[e], (unsigned)(16 * ch + 4 + e)); cv[8 + e] = mk_key(c[e], (unsigned)(16 * ch + 8 + e)); cv[12 + e] = mk_key(d[e], (unsigned)(16 * ch + 12 + e)); }
        bitonic_sort16_desc(cv);
#pragma unroll
        for (int q = 0; q < 16; ++q) lst[q] = lst[q] > cv[15 - q] ? lst[q] : cv[15 - q];
        bitonic_merge16_desc(lst); }
}
typedef float f32x2 __attribute__((ext_vector_type(2)));
__device__ __forceinline__ void dec16(const v4u q, float (&f)[16]) {
#pragma unroll
    for (int w = 0; w < 4; ++w) { const f32x2 lo = __builtin_amdgcn_cvt_pk_f32_fp8((int)q[w], false), hi = __builtin_amdgcn_cvt_pk_f32_fp8((int)q[w], true);
        f[4 * w] = lo.x; f[4 * w + 1] = lo.y; f[4 * w + 2] = hi.x; f[4 * w + 3] = hi.y; }
}
__device__ __forceinline__ void peer_phase(const Ctx F, const float* SC, const float* SS2, const unsigned char* U8, const unsigned char* V8, const float* US, const float* VS, const float* w2  ,
                                           const bf16* X1B  , bf16* XB  , float* RS1  , float* OUT  , const float* fw  , bool last, bool dry, int dry2, const void* ST_CODE = nullptr) {
    LAS unsigned short* EI = (LAS unsigned short*)(F.lds + L7_EI); LAS float* CF = (LAS float*)(F.lds + L7_CF); LAS float* PT = (LAS float*)(F.lds + L7_PT);
    LAS float* RS = (LAS float*)(F.lds + L7_RS); LAS float* SSQ = (LAS float*)(F.lds + L7_SSQ); LAS float* W2L = (LAS float*)(F.lds + L7_W2);
#pragma unroll 1
    for (int tile = F.vcu; tile < M / 128; tile += F.G) {
        int lane_o = F.lane; asm volatile("" : "+v"(lane_o));
        const int g = lane_o >> 3, i = lane_o & 7;
        __syncthreads();
        {
            const int tokl = F.tid >> 2, hh = F.tid & 3; const size_t row = (size_t)tile * 128 + tokl;
            unsigned l0[16], l1[16];
            topk16_slice(SC + row * 1024 + hh * 256, l0); topk16_slice(SC + row * 1024 + hh * 256 + 128, l1);
            float s0[16], s1[16];
#pragma unroll
            for (int j = 0; j < 16; ++j) { s0[j] = key_val(l0[j]); s1[j] = key_val(l1[j]); }
            {
                LAS unsigned* slot = (LAS unsigned*)(PT + tokl * 64 + hh * 16);
#pragma unroll
                for (int j = 0; j < 8; ++j) { slot[j] = (127u - (l0[2 * j] & 127u)) | ((127u - (l0[2 * j + 1] & 127u)) << 16); slot[8 + j] = (127u - (l1[2 * j] & 127u)) | ((127u - (l1[2 * j + 1] & 127u)) << 16); } }
            unsigned best[16];
#define CKEY(i_, j_) ((({ const unsigned u_ = __float_as_uint(s0[i_] + s1[j_]); (u_ & 0x80000000u) ? ~u_ : (u_ | 0x80000000u); }) & ~255u) | (255u - (unsigned)(16 * (i_) + (j_))))
#pragma unroll
            for (int j = 0; j < 16; ++j) best[j] = CKEY(0, j);
#pragma unroll
            for (int ii = 1; ii < 8; ++ii) { constexpr int NR[8] = {16, 8, 5, 4, 3, 2, 2, 2};
#pragma unroll
                for (int j = 0; j < 16; ++j) if (j < NR[ii]) { const unsigned c = CKEY(ii, j); best[15 - j] = best[15 - j] > c ? best[15 - j] : c; }
                bitonic_merge16_desc(best); }
#pragma unroll
            for (int ii = 8; ii < 16; ++ii) { unsigned k = CKEY(ii, 0);
#pragma unroll
                for (int q = 0; q < 16; ++q) { const unsigned hi = best[q] > k ? best[q] : k; k = best[q] > k ? k : best[q]; best[q] = hi; } }
#undef CKEY
            float e[16], bv[16], sum = 0.f;
#pragma unroll
            for (int j = 0; j < 16; ++j) { const unsigned kk = best[j] & ~255u; bv[j] = __uint_as_float((kk & 0x80000000u) ? (kk & 0x7fffffffu) : ~kk); }
#pragma unroll
            for (int j = 0; j < 16; ++j) { e[j] = __expf(bv[j] - bv[0]); sum += e[j]; }
            const float inv = 1.0f / sum;
            { const LAS unsigned short* slot = (const LAS unsigned short*)(PT + tokl * 64 + hh * 16);
#pragma unroll
              for (int j = 0; j < 16; ++j) { const unsigned pos = 255u - (best[j] & 255u); const unsigned ex = (unsigned)slot[pos >> 4] * 128u + (unsigned)slot[16 + (pos & 15u)];
                  EI[tokl * 64 + hh * 16 + j] = (unsigned short)ex; CF[tokl * 64 + hh * 16 + j] = e[j] * inv; } }
        }
        if (F.tid < 256) *(LAS f32x4*)(W2L + 4 * F.tid) = *(const f32x4*)(w2 + 4 * F.tid);
        if (F.lane < 16) { const int tok = F.wave * 16 + F.lane; const f32x4* sp = (const f32x4*)(SS2 + ((size_t)tile * 128 + tok) * 16); const f32x4 a = sp[0], b = sp[1], c = sp[2], d = sp[3];
            const float t = ((a[0] + a[1]) + (a[2] + a[3])) + ((b[0] + b[1]) + (b[2] + b[3])) + ((c[0] + c[1]) + (c[2] + c[3])) + ((d[0] + d[1]) + (d[2] + d[3]));
            RS[tok] = 1.0f / sqrtf(t * (1.0f / DM) + EPS); SSQ[tok] = 0.f; }
        __syncthreads();
#define U_LOAD(it_, Q, X) do { const int s_ = (it_) >> 4, tok_ = F.wave * 16 + ((it_) & 15); \
            _Pragma("unroll") for (int j = 0; j < 8; ++j) { const unsigned e_ = EI[tok_ * 64 + 8 * j + g]; Q[j] = *(const v4u*)(U8 + (size_t)e_ * 1024 + 128 * s_ + 16 * i); } \
            const bf16* xp_ = X1B + ((size_t)tile * 128 + tok_) * DM + 128 * s_ + 16 * i; \
            X[0] = *(const v4u*)xp_; X[1] = *(const v4u*)(xp_ + 8); } while (0)
#define U_COMP(it_, Q, X) do { const int s_ = (it_) >> 4, tok_ = F.wave * 16 + ((it_) & 15); float hw[16]; \
            { float xf_[16]; { float t8_[8]; unpack8(X[0], t8_); _Pragma("unroll") for (int q = 0; q < 8; ++q) xf_[q] = t8_[q]; unpack8(X[1], t8_); _Pragma("unroll") for (int q = 0; q < 8; ++q) xf_[8 + q] = t8_[q]; } \
            _Pragma("unroll") for (int q = 0; q < 16; ++q) hw[q] = xf_[q] * w2r[q]; } \
            float d[8]; \
            _Pragma("unroll") for (int j = 0; j < 8; ++j) { float f[16]; dec16(Q[j], f); float a0 = 0.f, a1 = 0.f; \
                _Pragma("unroll") for (int m = 0; m < 8; ++m) { a0 += hw[2 * m] * f[2 * m]; a1 += hw[2 * m + 1] * f[2 * m + 1]; } \
                d[j] = a0 + a1; } \
            float d2[4], d3[2]; \
            _Pragma("unroll") for (int m = 0; m < 4; ++m) { const float snd = (i & 4) ? d[m] : d[4 + m]; const float kp = (i & 4) ? d[4 + m] : d[m]; d2[m] = kp + dppf<0x141>(snd); }     \
            _Pragma("unroll") for (int m = 0; m < 2; ++m) { const float snd = (i & 2) ? d2[m] : d2[2 + m]; const float kp = (i & 2) ? d2[2 + m] : d2[m]; d3[m] = kp + dppf<0x4E>(snd); } \
            const float snd = (i & 1) ? d3[0] : d3[1]; const float kp = (i & 1) ? d3[1] : d3[0]; const float tot = kp + dppf<0xB1>(snd); \
            const int pi = tok_ * 64 + 8 * i + g; PT[pi] = (s_ == 0) ? tot : PT[pi] + tot; } while (0)
#pragma unroll 1
        for (int repu = 0; repu < ((dry2 >> 1) & 1) + 1; ++repu)
        {
            v4u qa[8], qb[8]; v4u xa[2], xb[2]; float w2r[16];
            U_LOAD(0, qa, xa);
#pragma unroll 1
            for (int it = 0; it < 128; it += 2) {
                if ((it & 15) == 0) {
#pragma unroll
                    for (int q = 0; q < 4; ++q) { const f32x4 w_ = *(const LAS f32x4*)(W2L + 8 * it + 16 * i + 4 * q); w2r[4 * q] = w_[0]; w2r[4 * q + 1] = w_[1]; w2r[4 * q + 2] = w_[2]; w2r[4 * q + 3] = w_[3]; } }
                U_LOAD(it + 1, qb, xb);
                if ((dry2 & 8) && repu == 0) { unsigned acc_ = 0; _Pragma("unroll") for (int j = 0; j < 8; ++j) acc_ ^= qa[j][0] ^ qa[j][1] ^ qa[j][2] ^ qa[j][3]; acc_ ^= xa[0][0] ^ xa[1][3]; asm volatile("" :: "v"(acc_)); } else
                U_COMP(it, qa, xa);
                { const int itn = (it + 2 < 128) ? it + 2 : 127; U_LOAD(itn, qa, xa); }
                if ((dry2 & 8) && repu == 0) { unsigned acc_ = 0; _Pragma("unroll") for (int j = 0; j < 8; ++j) acc_ ^= qb[j][0] ^ qb[j][1] ^ qb[j][2] ^ qb[j][3]; acc_ ^= xb[0][0] ^ xb[1][3]; asm volatile("" :: "v"(acc_)); } else
                U_COMP(it + 1, qb, xb);
            }
        }
#undef U_LOAD
#undef U_COMP
#pragma unroll 1
        for (int n = 0; n < 16; ++n) { const int idx = (F.wave * 16 + n) * 64 + F.lane; const unsigned e = EI[idx]; const float dd = PT[idx] * US[e] * RS[F.wave * 16 + n];
            CF[idx] = CF[idx] * (0.5f * dd * (1.0f + erff(dd * 0.70710678118654752f))) * VS[e]; }
#define V_LOAD(it_, Q, X) do { const int s_ = (it_) >> 4, tok_ = F.wave * 16 + ((it_) & 15); \
            _Pragma("unroll") for (int j = 0; j < 8; ++j) { const unsigned e_ = EI[tok_ * 64 + 8 * j + g]; Q[j] = *(const v4u*)(V8 + (size_t)e_ * 1024 + 128 * s_ + 16 * i); } \
            X = *(const unsigned*)(X1B + ((size_t)tile * 128 + tok_) * DM + 128 * s_ + vd); } while (0)
#define V_COMP(it_, Q, X) do { const int s_ = (it_) >> 4, tok_ = F.wave * 16 + ((it_) & 15); float o[16]; \
            _Pragma("unroll") for (int m = 0; m < 16; ++m) o[m] = 0.f; \
            _Pragma("unroll") for (int j = 0; j < 8; ++j) { const float cf_ = CF[tok_ * 64 + 8 * j + g]; float f[16]; dec16(Q[j], f); \
                _Pragma("unroll") for (int m = 0; m < 16; ++m) o[m] += cf_ * f[m]; } \
            float o2[8], o3[4], o4[2]; \
            _Pragma("unroll") for (int m = 0; m < 8; ++m) { const auto rr_ = __builtin_amdgcn_permlane32_swap(__float_as_uint(o[8 + m]), __float_as_uint(o[m]), false, false); o2[m] = __uint_as_float(rr_[0]) + __uint_as_float(rr_[1]); }     \
            _Pragma("unroll") for (int m = 0; m < 4; ++m) { const auto rr_ = __builtin_amdgcn_permlane16_swap(__float_as_uint(o2[4 + m]), __float_as_uint(o2[m]), false, false); o3[m] = __uint_as_float(rr_[0]) + __uint_as_float(rr_[1]); }     \
            _Pragma("unroll") for (int m = 0; m < 2; ++m) { const float snd = (g & 1) ? o3[m] : o3[2 + m]; const float kp = (g & 1) ? o3[2 + m] : o3[m]; o4[m] = kp + dppf<0x128>(snd); } \
            const float y0 = bflo(X) + o4[0], y1 = bfhi(X) + o4[1]; \
            if (!dry) *(unsigned*)(XB + ((size_t)tile * 128 + tok_) * DM + 128 * s_ + vd) = pk2(y0, y1); \
            } while (0)
#pragma unroll 1
        for (int repv = 0; repv < ((dry2 >> 2) & 1) + 1; ++repv)
        {
            const int vd = 16 * i + 8 * (1 - ((g >> 2) & 1)) + 4 * (1 - ((g >> 1) & 1)) + 2 * (g & 1);
            v4u qa[8], qb[8]; unsigned xa, xb;
            V_LOAD(0, qa, xa);
#pragma unroll 1
            for (int it = 0; it < 128; it += 2) {
                V_LOAD(it + 1, qb, xb);
                V_COMP(it, qa, xa);
                { const int itn = (it + 2 < 128) ? it + 2 : 127; V_LOAD(itn, qa, xa); }
                V_COMP(it + 1, qb, xb);
            }
        }
#undef V_LOAD
#undef V_COMP
        asm volatile("s_waitcnt vmcnt(0)" ::: "memory");
        __builtin_amdgcn_fence(__ATOMIC_ACQUIRE, "agent");
        asm volatile("s_waitcnt vmcnt(0)" ::: "memory");
#pragma unroll 1
        for (int ti = 0; ti < 16; ++ti) {
            const int tok = F.wave * 16 + ti; const size_t row = (size_t)tile * 128 + tok;
            float f0[8], f1[8]; unpack8(*(const v4u*)(XB + row * DM + F.lane * 8), f0); unpack8(*(const v4u*)(XB + row * DM + 512 + F.lane * 8), f1);
            float sq = 0.f;
#pragma unroll
            for (int q = 0; q < 8; ++q) sq += f0[q] * f0[q] + f1[q] * f1[q];
            float rstd = 1.0f / sqrtf(wave_sum_v(sq) * (1.0f / DM) + EPS);
#if defined(SELFTEST)
            rstd *= 1.0f + 0.2f * (float)__hip_atomic_load((const unsigned*)ST_CODE, __ATOMIC_RELAXED, __HIP_MEMORY_SCOPE_AGENT);
#endif
            if (!last) { if (F.lane == 0 && !dry) RS1[row] = rstd; }
            else if (!dry) {
                const f32x4 c0 = *(const f32x4*)(fw + F.lane * 8), d0 = *(const f32x4*)(fw + F.lane * 8 + 4), c1 = *(const f32x4*)(fw + 512 + F.lane * 8), d1 = *(const f32x4*)(fw + 512 + F.lane * 8 + 4);
                *(f32x4*)(OUT + row * DM + F.lane * 8) = (f32x4){f0[0] * rstd * c0[0], f0[1] * rstd * c0[1], f0[2] * rstd * c0[2], f0[3] * rstd * c0[3]};
                *(f32x4*)(OUT + row * DM + F.lane * 8 + 4) = (f32x4){f0[4] * rstd * d0[0], f0[5] * rstd * d0[1], f0[6] * rstd * d0[2], f0[7] * rstd * d0[3]};
                *(f32x4*)(OUT + row * DM + 512 + F.lane * 8) = (f32x4){f1[0] * rstd * c1[0], f1[1] * rstd * c1[1], f1[2] * rstd * c1[2], f1[3] * rstd * c1[3]};
                *(f32x4*)(OUT + row * DM + 512 + F.lane * 8 + 4) = (f32x4){f1[4] * rstd * d1[0], f1[5] * rstd * d1[1], f1[6] * rstd * d1[2], f1[7] * rstd * d1[3]};
            }
        }
    }
}


#if defined(SELFTEST)
__device__ __forceinline__ float st_a(int r, int k) { return (float)(((r * 3 + k) % 5) - 2); }
__device__ __forceinline__ float st_b(int k, int c) { return (float)(((k + 2 * c) % 7) - 3); }
__device__ __forceinline__ void selftest(const Ctx F, gu32* ctl) {
    if (blockIdx.x != 0 || F.wave != 0) return;
    const int lane = F.lane, fr = lane & 15, fq = lane >> 4;
    int aw[2] = {0, 0}, bw[2] = {0, 0};
#pragma unroll
    for (int w = 0; w < 2; ++w) { aw[w] = __builtin_amdgcn_cvt_pk_fp8_f32(st_a(fr, 8 * fq + 4 * w), st_a(fr, 8 * fq + 4 * w + 1), aw[w], false); aw[w] = __builtin_amdgcn_cvt_pk_fp8_f32(st_a(fr, 8 * fq + 4 * w + 2), st_a(fr, 8 * fq + 4 * w + 3), aw[w], true);
                                  bw[w] = __builtin_amdgcn_cvt_pk_fp8_f32(st_b(8 * fq + 4 * w, fr), st_b(8 * fq + 4 * w + 1, fr), bw[w], false); bw[w] = __builtin_amdgcn_cvt_pk_fp8_f32(st_b(8 * fq + 4 * w + 2, fr), st_b(8 * fq + 4 * w + 3, fr), bw[w], true); }
    const long A = (long)(((unsigned long long)(unsigned)aw[1] << 32) | (unsigned)aw[0]), B = (long)(((unsigned long long)(unsigned)bw[1] << 32) | (unsigned)bw[0]);
    f32x4 d = (f32x4){0.f, 0.f, 0.f, 0.f};
    d = __builtin_amdgcn_mfma_f32_16x16x32_fp8_fp8(A, B, d, 0, 0, 0);
    bool ok1 = true;
#pragma unroll
    for (int r = 0; r < 4; ++r) { float e = 0.f; for (int kk = 0; kk < 32; ++kk) e += st_a(4 * fq + r, kk) * st_b(kk, fr); ok1 = ok1 && (d[r] == e); }
    const int t1 = __all(ok1) ? 1 : 0;
    LAS unsigned char* T = F.lds;
    for (int c4 = 0; c4 < 32; ++c4) { unsigned w = 0; for (int b = 0; b < 4; ++b) w |= (unsigned)((37 * lane + 11 * (4 * c4 + b)) & 127) << (8 * b); *(LAS unsigned*)(T + lane * 128 + 4 * c4) = w; }
    asm volatile("s_waitcnt lgkmcnt(0)" ::: "memory");
    int t2 = 0;
#pragma unroll
    for (int hyp = 1; hyp <= 2; ++hyp) {
        const int l16 = lane & 15; const int row = (hyp == 1) ? (l16 >> 1) : (l16 & 7), cc = (hyp == 1) ? 8 * (l16 & 1) : 8 * (l16 >> 3);
        const v2i_t v = __builtin_amdgcn_ds_read_tr8_b64_v2i32((LAS v2i_t*)(T + (8 * fq + row) * 128 + 16 + cc));
        bool ok = true;
#pragma unroll
        for (int j = 0; j < 8; ++j) { const unsigned got = ((unsigned)(j < 4 ? v.x : v.y) >> (8 * (j & 3))) & 255u; ok = ok && (got == (unsigned)((37 * (8 * fq + j) + 11 * (16 + l16)) & 127)); }
        if (__all(ok)) t2 = hyp;
    }
    if (lane == 0) __hip_atomic_store(ctl + 20, (unsigned)(t1 + 2 * t2 + 1), RLX_AGENT);
    asm volatile("s_waitcnt vmcnt(0) lgkmcnt(0)" ::: "memory");
}
#endif
__device__ __forceinline__ Ctx fresh(const Ctx F) { Ctx R = F; int t = F.tid, v = F.vcu, g = F.G; asm volatile("" : "+v"(t)); asm volatile("" : "+s"(v), "+s"(g)); R.tid = t; R.lane = t & 63; R.wave = __builtin_amdgcn_readfirstlane(t >> 6); R.vcu = v; R.G = g; return R; }
struct Args { const float* in[17]; float* out; unsigned char* ws; int ph_lo, ph_hi, li, pad; };
__global__ void __launch_bounds__(NWAVES * 64, 2) mega_fwd(Args args) {
    extern __shared__ __attribute__((aligned(16))) unsigned char lds[];
    Ctx F;
    F.lds = (LAS unsigned char*)lds;
    F.tid = threadIdx.x; F.lane = F.tid & 63; F.wave = __builtin_amdgcn_readfirstlane(F.tid >> 6);
    F.G = gridDim.x; { const int bx = blockIdx.x; F.vcu = (F.G % 8 == 0) ? (bx % 8) * (F.G / 8) + bx / 8 : bx; }
    unsigned char* ws = args.ws;
    gu32* ctl = (gu32*)(ws + WS_CTL);
    volatile LAS unsigned* MISC = (volatile LAS unsigned*)(F.lds + MISC_OFF);
    for (int u = F.tid; u < (LDS_BYTES - LDSCTL_OFF) / 4; u += NWAVES * 64) ((LAS unsigned*)(F.lds + LDSCTL_OFF))[u] = 0u;
    __syncthreads();
    XcdBarrier bar; bar.bar = (unsigned*)(ctl + CW_BAR); bar.x = 0; bar.st = nullptr;
    if (N_LAUNCHES != NPH) bar = xcd_barrier_post((unsigned*)(ctl + CW_BAR), MISC + 8);
    const int lo = args.ph_lo, hi = args.ph_hi;
#define IN(k) (lo <= (k) && (k) < hi)
#ifndef PH_MASK
#define PH_MASK 0x3ff
#endif
#define PHK(i) ((PH_MASK >> (i)) & 1)
#ifndef DUP_KIND
#define DUP_KIND (-1)
#endif
#define DUPK(i) (DUP_KIND == (i))
    const bool dry = (args.pad == 0);
#define SEAM(k) do { if (N_LAUNCHES != NPH) { if (IN(k) && IN((k) + 1)) xcd_barrier(bar); } } while (0)
    const float* x_in = args.in[0]; float* OUT = args.out;
    bf16* XNY = (bf16*)(ws + WS_XNY); bf16* XB = (bf16*)(ws + WS_XB); float* RS1 = (float*)(ws + WS_RS1); bf16* PB = (bf16*)(ws + WS_P); float* SC = (float*)(ws + WS_SC); bf16* X1B = (bf16*)(ws + WS_X1B);
    float* SS2 = (float*)(ws + WS_SS2); float* EA = (float*)(ws + WS_EA); float* CD = (float*)(ws + WS_CD); bf16* CC = (bf16*)(ws + WS_CC); bf16* ST = (bf16*)(ws + WS_ST);
#if defined(SELFTEST)
    if (IN(0)) { selftest(fresh(F), ctl); __syncthreads(); }
#endif
    if (DUPK(0) && IN(0)) p0_prologue(fresh(F), x_in, args.in[1], args.in[2], args.in[10], args.in[11], args.in[12], args.in[13], ws);
    if (PHK(0) && IN(0)) p0_prologue(fresh(F), x_in, args.in[1], args.in[2], args.in[10], args.in[11], args.in[12], args.in[13], ws);
    SEAM(0);
    if (DUPK(15) && N_LAUNCHES != NPH) { for (int r = 0; r < 10; ++r) xcd_barrier(bar); }
#pragma unroll
    for (int L = 0; L < DEPTH; ++L) {
        const int pb = 1 + 7 * L;
#pragma unroll 1
        for (int rep = 0; rep < ((DUPK(1) && L == 0) ? 2 : 1); ++rep)
        if (PHK(1) && IN(pb)) {
            pg8::Gemm g{XB, (const bf16*)(ws + WS_WIN) + (size_t)L * NP * DM, M, NP, DM}; pg8::StaticOrder S; S.init(M, NP, F.G, (int)blockIdx.x);
            pg8::EpiBf16Row E{PB, NP, RS1};
            pg8::gemm_phase<pg8::EpiBf16Row, pg8::StaticOrder, PG8_ALIGN, PG8_SP2>(F.lds, g, S, E);
        }
        SEAM(pb);
        if (IN(pb + 1)) {
            if (DUPK(2) && L == 0) ssd_part1(fresh(F), PB, XNY, args.in[3] + (size_t)L * 4 * 768, args.in[4] + L * 768, args.in[5] + L * 8, args.in[6] + L * 8, args.in[7] + L * 8, CC, EA, CD, ST);
            if (PHK(2)) ssd_part1(fresh(F), PB, XNY, args.in[3] + (size_t)L * 4 * 768, args.in[4] + L * 768, args.in[5] + L * 8, args.in[6] + L * 8, args.in[7] + L * 8, CC, EA, CD, ST);
            if (DUPK(3) && L == 0) attn_mfma(fresh(F), PB, XNY);
            if (PHK(3)) attn_mfma(fresh(F), PB, XNY);
            if (DUPK(4) && L == 0) shortconv(fresh(F), PB, XNY, args.in[9] + (size_t)L * 3 * 256);
            if (PHK(4)) shortconv(fresh(F), PB, XNY, args.in[9] + (size_t)L * 3 * 256);
        }
        SEAM(pb + 1);
        if (DUPK(5) && L == 0 && IN(pb + 2)) ssd_scan(fresh(F), ST, CD, dry);
        if (PHK(5) && IN(pb + 2)) { const Ctx Fs = fresh(F); ssd_scan(Fs, ST, CD, false); if (Fs.wave >= 2) convert_tables(Fs.lane, args.in[14], args.in[15], ws, L, Fs.vcu * 6 + (Fs.wave - 2), Fs.G * 6); }
        SEAM(pb + 2);
        if (DUPK(6) && L == 0 && IN(pb + 3)) ssd_part2(fresh(F), PB, XNY, CC, EA, ST, args.in[8] + L * 512, dry);
        if (PHK(6) && IN(pb + 3)) ssd_part2(fresh(F), PB, XNY, CC, EA, ST, args.in[8] + L * 512, false);
        SEAM(pb + 3);
#pragma unroll 1
        for (int rep = 0; rep < ((DUPK(7) && L == 0) ? 2 : 1); ++rep)
        if (PHK(7) && IN(pb + 4)) {
            pg8::Gemm g{XNY, (const bf16*)(ws + WS_WOUT) + (size_t)L * DM * DM, M, DM, DM}; pg8::StaticOrder S; S.init(M, DM, F.G, (int)blockIdx.x);
            pg8::EpiResidB E{XB, X1B, SS2};
            pg8::gemm_phase<pg8::EpiResidB, pg8::StaticOrder, PG8_ALIGN, PG8_SP2>(F.lds, g, S, E);
        }
        SEAM(pb + 4);
#pragma unroll 1
        for (int rep = 0; rep < ((DUPK(8) && L == 0) ? 2 : 1); ++rep)
        if (PHK(8) && IN(pb + 5)) {
            pg8::Gemm g{X1B, (const bf16*)(ws + WS_WS) + (size_t)L * DM * DM, M, DM, DM}; pg8::StaticOrder S; S.init(M, DM, F.G, (int)blockIdx.x);
            pg8::EpiScore E{SC, SS2, EPS};
            pg8::gemm_phase<pg8::EpiScore, pg8::StaticOrder, PG8_ALIGN, PG8_SP2>(F.lds, g, S, E);
        }
        SEAM(pb + 5);
        if (DUPK(9) && L == 0 && IN(pb + 6)) peer_phase(fresh(F), SC, SS2, ws + WS_U8 + (size_t)L * 16384 * DM, ws + WS_V8 + (size_t)L * 16384 * DM, (const float*)(ws + WS_US) + L * 16384, (const float*)(ws + WS_VS) + L * 16384, args.in[11] + L * DM, X1B, XB, RS1, OUT, args.in[16], L == DEPTH - 1, dry, 0);
        if (PHK(9) && IN(pb + 6)) peer_phase(fresh(F), SC, SS2, ws + WS_U8 + (size_t)L * 16384 * DM, ws + WS_V8 + (size_t)L * 16384 * DM, (const float*)(ws + WS_US) + L * 16384, (const float*)(ws + WS_VS) + L * 16384, args.in[11] + L * DM, X1B, XB, RS1, OUT, args.in[16], L == DEPTH - 1, false, (L == 0 && dry) ? (DUPK(10) ? 1 : DUPK(11) ? 2 : DUPK(12) ? 4 : DUPK(13) ? 10 : DUPK(14) ? 17 : 0) : 0, (const void*)(ctl + 20));
        SEAM(pb + 6);
    }
#undef IN
#undef SEAM
}

extern "C" void kernel_launch(void* const* d_in, const int* in_sizes, int n_in, void* d_out, int out_size, void* d_ws, size_t ws_size, hipStream_t stream) {
    static int grid = 0;
    if (grid == 0) {
        if (n_in != 17 || in_sizes[0] != M * DM || out_size != M * DM || ws_size < WS_END) { fprintf(stderr, "kernel_launch: unexpected shapes (n_in %d, in0 %d, out %d, ws %zu); nothing launched\n", n_in, n_in > 0 ? in_sizes[0] : -1, out_size, ws_size); grid = -1; return; }
        int dev = 0, cus = 0, per_cu = 0;
        if (hipGetDevice(&dev) != hipSuccess || hipDeviceGetAttribute(&cus, hipDeviceAttributeMultiprocessorCount, dev) != hipSuccess) { fprintf(stderr, "kernel_launch: device query failed\n"); grid = -1; return; }
        if (hipFuncSetAttribute((const void*)mega_fwd, hipFuncAttributeMaxDynamicSharedMemorySize, LDS_BYTES) != hipSuccess) { fprintf(stderr, "kernel_launch: hipFuncSetAttribute failed\n"); grid = -1; return; }
        if (hipOccupancyMaxActiveBlocksPerMultiprocessor(&per_cu, (const void*)mega_fwd, NWAVES * 64, LDS_BYTES) != hipSuccess || per_cu < 1) { fprintf(stderr, "kernel_launch: the occupancy query reports %d resident workgroups per CU for %d threads + %d B of LDS; nothing launched\n", per_cu, NWAVES * 64, LDS_BYTES); (void)hipGetLastError(); grid = -1; return; }
        (void)hipGetLastError();
        grid = cus;
    }
    if (grid < 0) return;
    if (hipMemsetAsync((char*)d_ws + WS_CTL, 0, CTL_ZERO_BYTES, stream) != hipSuccess) { fprintf(stderr, "kernel_launch: memset failed\n"); return; }
    Args a{};
    for (int i = 0; i < 17; ++i) a.in[i] = (const float*)d_in[i];
    a.out = (float*)d_out; a.ws = (unsigned char*)d_ws;
    for (int li = 0; li < N_LAUNCHES; ++li) {
        a.ph_lo = (N_LAUNCHES == NPH) ? li : 0; a.ph_hi = (N_LAUNCHES == NPH) ? li + 1 : NPH; a.li = li;
        hipLaunchKernelGGL(mega_fwd, dim3(grid), dim3(NWAVES * 64), LDS_BYTES, stream, a);
        const hipError_t le = hipPeekAtLastError();
        if (le != hipSuccess) { fprintf(stderr, "kernel_launch: launch %d failed: %s\n", li, hipGetErrorName(le)); break; }
    }
}
```

```cpp
#define MK_N_LAUNCHES 1
#include <hip/hip_runtime.h>
#include <cstdio>
#include <cstdint>
#include <cmath>
namespace pg8 {
#define PG8_LAS __attribute__((address_space(3)))
typedef unsigned short bf16_t;
typedef short bf16x8 __attribute__((ext_vector_type(8)));
typedef float f32x4 __attribute__((ext_vector_type(4)));
typedef unsigned u32x4 __attribute__((ext_vector_type(4)));
constexpr int BM = 256, BK = 64, HALF = 128, HTB = HALF * BK * 2  , STAGE_BYTES = 8 * HTB, NXCD = 8, WGM = 8;

__host__ __device__ __forceinline__ int lds_byte(int r, int c) { const int st = (r >> 4) * 2 + (c >> 5), rr = r & 15, cc = c & 31, ob = rr * 64 + cc * 2; return st * 1024 + (ob ^ (((ob >> 9) & 1) << 5)); }
__host__ __device__ __forceinline__ void stage_rc(int b, int& R, int& C) { const int st = b / 1024, sb = b % 1024, swz = sb ^ (((sb >> 9) & 1) << 5); R = (st >> 1) * 16 + swz / 64; C = (st & 1) * 32 + (swz % 64) / 2; }
__host__ __device__ __forceinline__ int perm32(int rho) { const int n = rho >> 4, i = rho & 15; return 8 * (i >> 2) + 4 * n + (i & 3); }

struct Unit { int pm, pn; };
struct Gemm { const bf16_t* A; const bf16_t* Bt; int M, N, K; };

struct StaticOrder {
    int nM, nN, nwg, G, c;
    __host__ __device__ void init(int M, int N, int G_, int c_) { nM = M / BM; nN = N / BM; nwg = nM * nN; G = G_; c = c_; }
    __host__ __device__ bool next(int i, Unit& u) const {
        const long L = (long)i * G + c; if (L >= nwg) return false;
        int wgid = (int)L; { const int q = nwg / NXCD, r = nwg % NXCD, xcd = wgid % NXCD, off = wgid / NXCD; wgid = (xcd < r ? xcd * (q + 1) : r * (q + 1) + (xcd - r) * q) + off; }
        const int nig = WGM * nN, gid = wgid / nig, fm = gid * WGM, gsz = (nM - fm) < WGM ? (nM - fm) : WGM;
        u.pm = fm + ((wgid % nig) % gsz); u.pn = (wgid % nig) / gsz; return true;
    }
    __device__ __forceinline__ void a_ready(const Unit&) const {}
    __device__ __forceinline__ void done(const Unit&) const {}
};

__device__ __forceinline__ unsigned cvt_pk_bf16(float lo, float hi) { unsigned r; asm volatile("v_cvt_pk_bf16_f32 %0, %1, %2" : "=v"(r) : "v"(lo), "v"(hi)); return r; }
typedef float f32x2 __attribute__((ext_vector_type(2)));
__device__ __forceinline__ f32x2 gelu_pk(f32x2 v) {
    const f32x2 av = __builtin_elementwise_abs(v), d = av * 0.2316418882f + 1.0f;
    f32x2 t; t.x = __builtin_amdgcn_rcpf(d.x); t.y = __builtin_amdgcn_rcpf(d.y);
    f32x2 q = t * 0.5307027145f + (-0.7265760135f); q = q * t + 0.7107068705f; q = q * t + (-0.142248368f); q = q * t + 0.127414796f; q = q * t;
    const f32x2 s = (v * v) * (-0.72134752044f);
    f32x2 e; e.x = __builtin_amdgcn_exp2f(s.x); e.y = __builtin_amdgcn_exp2f(s.y);
    const f32x2 m = v * (q * e), r = v - m;
    f32x2 o; o.x = v.x < 0.f ? m.x : r.x; o.y = v.y < 0.f ? m.y : r.y; return o;
}

template <int ACT  > struct EpiBf16 {
    static constexpr bool PERM = true, AFTER_DRAIN = false; static_assert(ACT == 0 || ACT == 1, "EpiBf16: ACT is 0 (none) or 1 (gelu_pk)");
    bf16_t* O; int ldc; const float* bias; int split_cols; size_t split_stride; float scale0;
    __device__ __forceinline__ void operator()(const f32x4 (&acc)[2][2][4][2], const Unit& u, int wr, int wc, int fr, int fq) const {
        const int row0 = u.pm * BM + wr * 64 + fr; int colt = u.pn * BM; bf16_t* base = O;
        float sc = 1.f; if (split_cols) { const int t = colt / split_cols; base += (size_t)t * split_stride; colt -= t * split_cols; if (t == 0) sc = scale0; }
        const int col0 = colt + wc * 32 + 8 * fq, bcol0 = u.pn * BM + wc * 32 + 8 * fq;
        f32x4 bv[2][2];
#pragma unroll
        for (int bj = 0; bj < 2; ++bj)
#pragma unroll
            for (int n = 0; n < 2; ++n) bv[bj][n] = bias ? *(const f32x4*)(bias + bcol0 + bj * HALF + 4 * n) : (f32x4){0.f, 0.f, 0.f, 0.f};
#pragma unroll
        for (int ai = 0; ai < 2; ++ai)
#pragma unroll
            for (int m = 0; m < 4; ++m) { bf16_t* rowp = base + (size_t)(row0 + ai * HALF + m * 16) * ldc + col0;
#pragma unroll
                for (int bj = 0; bj < 2; ++bj) { f32x4 v0 = acc[ai][bj][m][0] + bv[bj][0], v1 = acc[ai][bj][m][1] + bv[bj][1];
                    if (ACT == 1) { f32x2 a = gelu_pk((f32x2){v0[0], v0[1]}), b = gelu_pk((f32x2){v0[2], v0[3]}), c = gelu_pk((f32x2){v1[0], v1[1]}), d = gelu_pk((f32x2){v1[2], v1[3]});
                        v0 = (f32x4){a.x, a.y, b.x, b.y}; v1 = (f32x4){c.x, c.y, d.x, d.y}; }
                    v0 = v0 * sc; v1 = v1 * sc; u32x4 w; w.x = cvt_pk_bf16(v0[0], v0[1]); w.y = cvt_pk_bf16(v0[2], v0[3]); w.z = cvt_pk_bf16(v1[0], v1[1]); w.w = cvt_pk_bf16(v1[2], v1[3]);
                    *(u32x4*)(rowp + bj * HALF) = w; } }
    }
};
struct EpiResid {
    static constexpr bool PERM = true, AFTER_DRAIN = false;
    const float* resid; float* out; bf16_t* xb; float* ss;
    __device__ __forceinline__ void operator()(const f32x4 (&acc)[2][2][4][2], const Unit& u, int wr, int wc, int fr, int fq) const {
        const int row0 = u.pm * BM + wr * 64 + fr; const int col0 = u.pn * BM + wc * 32 + 8 * fq;
#pragma unroll
        for (int ai = 0; ai < 2; ++ai)
#pragma unroll
            for (int m = 0; m < 4; ++m) { const int row = row0 + ai * HALF + m * 16; const size_t off = (size_t)row * 1024 + col0; float s = 0.f;
#pragma unroll
                for (int bj = 0; bj < 2; ++bj) { const float* rp = resid + off + bj * HALF; const f32x4 r0 = *(const f32x4*)rp, r1 = *(const f32x4*)(rp + 4);
                    const f32x4 v0 = acc[ai][bj][m][0] + r0, v1 = acc[ai][bj][m][1] + r1;
                    *(f32x4*)(out + off + bj * HALF) = v0; *(f32x4*)(out + off + bj * HALF + 4) = v1;
                    u32x4 w; w.x = cvt_pk_bf16(v0[0], v0[1]); w.y = cvt_pk_bf16(v0[2], v0[3]); w.z = cvt_pk_bf16(v1[0], v1[1]); w.w = cvt_pk_bf16(v1[2], v1[3]);
                    *(u32x4*)(xb + off + bj * HALF) = w;
                    s += (v0[0] * v0[0] + v0[1] * v0[1]) + (v0[2] * v0[2] + v0[3] * v0[3]) + (v1[0] * v1[0] + v1[1] * v1[1]) + (v1[2] * v1[2] + v1[3] * v1[3]); }
                { const auto r16_ = __builtin_amdgcn_permlane16_swap(__float_as_uint(s), __float_as_uint(s), false, false); s = __uint_as_float(r16_[0]) + __uint_as_float(r16_[1]); const auto r32_ = __builtin_amdgcn_permlane32_swap(__float_as_uint(s), __float_as_uint(s), false, false); s = __uint_as_float(r32_[0]) + __uint_as_float(r32_[1]); }
                if (fq == 0) ss[(size_t)row * 16 + u.pn * 4 + wc] = s; }
    }
};
struct EpiScore {
    static constexpr bool PERM = true, AFTER_DRAIN = false;
    float* out; const float* ss; float eps;
    __device__ __forceinline__ void operator()(const f32x4 (&acc)[2][2][4][2], const Unit& u, int wr, int wc, int fr, int fq) const {
        const int row0 = u.pm * BM + wr * 64 + fr; const int col0 = u.pn * BM + wc * 32 + 8 * fq;
#pragma unroll
        for (int ai = 0; ai < 2; ++ai)
#pragma unroll
            for (int m = 0; m < 4; ++m) { const int row = row0 + ai * HALF + m * 16; const size_t off = (size_t)row * 1024 + col0;
                const f32x4* sp = (const f32x4*)(ss + (size_t)row * 16); const f32x4 a = sp[0], b = sp[1], c = sp[2], d = sp[3];
                const float t = ((a[0] + a[1]) + (a[2] + a[3])) + ((b[0] + b[1]) + (b[2] + b[3])) + ((c[0] + c[1]) + (c[2] + c[3])) + ((d[0] + d[1]) + (d[2] + d[3]));
                const float rstd = 1.0f / sqrtf(t * (1.0f / 1024.0f) + eps);
#pragma unroll
                for (int bj = 0; bj < 2; ++bj) { *(f32x4*)(out + off + bj * HALF) = acc[ai][bj][m][0] * rstd; *(f32x4*)(out + off + bj * HALF + 4) = acc[ai][bj][m][1] * rstd; } }
    }
};

struct EpiBf16Row {
    static constexpr bool PERM = true, AFTER_DRAIN = false;
    bf16_t* O; int ldc; const float* rs;
    __device__ __forceinline__ void operator()(const f32x4 (&acc)[2][2][4][2], const Unit& u, int wr, int wc, int fr, int fq) const {
        const int row0 = u.pm * BM + wr * 64 + fr; const int col0 = u.pn * BM + wc * 32 + 8 * fq;
#pragma unroll
        for (int ai = 0; ai < 2; ++ai)
#pragma unroll
            for (int m = 0; m < 4; ++m) { const int row = row0 + ai * HALF + m * 16; const float sc = rs[row]; bf16_t* rowp = O + (size_t)row * ldc + col0;
#pragma unroll
                for (int bj = 0; bj < 2; ++bj) { const f32x4 v0 = acc[ai][bj][m][0] * sc, v1 = acc[ai][bj][m][1] * sc;
                    u32x4 w; w.x = cvt_pk_bf16(v0[0], v0[1]); w.y = cvt_pk_bf16(v0[2], v0[3]); w.z = cvt_pk_bf16(v1[0], v1[1]); w.w = cvt_pk_bf16(v1[2], v1[3]);
                    *(u32x4*)(rowp + bj * HALF) = w; } }
    }
};
struct EpiResidB {
    static constexpr bool PERM = true, AFTER_DRAIN = false;
    const bf16_t* resid; bf16_t* xb; float* ss;
    __device__ __forceinline__ void operator()(const f32x4 (&acc)[2][2][4][2], const Unit& u, int wr, int wc, int fr, int fq) const {
        const int row0 = u.pm * BM + wr * 64 + fr; const int col0 = u.pn * BM + wc * 32 + 8 * fq;
#pragma unroll
        for (int ai = 0; ai < 2; ++ai)
#pragma unroll
            for (int m = 0; m < 4; ++m) { const int row = row0 + ai * HALF + m * 16; const size_t off = (size_t)row * 1024 + col0; float s = 0.f;
#pragma unroll
                for (int bj = 0; bj < 2; ++bj) { const u32x4 r = *(const u32x4*)(resid + off + bj * HALF);
                    const f32x4 r0 = (f32x4){__uint_as_float(r.x << 16), __uint_as_float(r.x & 0xffff0000u), __uint_as_float(r.y << 16), __uint_as_float(r.y & 0xffff0000u)};
                    const f32x4 r1 = (f32x4){__uint_as_float(r.z << 16), __uint_as_float(r.z & 0xffff0000u), __uint_as_float(r.w << 16), __uint_as_float(r.w & 0xffff0000u)};
                    const f32x4 v0 = acc[ai][bj][m][0] + r0, v1 = acc[ai][bj][m][1] + r1;
                    u32x4 w; w.x = cvt_pk_bf16(v0[0], v0[1]); w.y = cvt_pk_bf16(v0[2], v0[3]); w.z = cvt_pk_bf16(v1[0], v1[1]); w.w = cvt_pk_bf16(v1[2], v1[3]);
                    *(u32x4*)(xb + off + bj * HALF) = w;
                    s += (v0[0] * v0[0] + v0[1] * v0[1]) + (v0[2] * v0[2] + v0[3] * v0[3]) + (v1[0] * v1[0] + v1[1] * v1[1]) + (v1[2] * v1[2] + v1[3] * v1[3]); }
                { const auto r16_ = __builtin_amdgcn_permlane16_swap(__float_as_uint(s), __float_as_uint(s), false, false); s = __uint_as_float(r16_[0]) + __uint_as_float(r16_[1]); const auto r32_ = __builtin_amdgcn_permlane32_swap(__float_as_uint(s), __float_as_uint(s), false, false); s = __uint_as_float(r32_[0]) + __uint_as_float(r32_[1]); }
                if (fq == 0) ss[(size_t)row * 16 + u.pn * 4 + wc] = s; }
    }
};
template <class Epi, class Sched, bool ALIGN_EPI = false, bool SP2 = false>
__device__ __forceinline__ void gemm_phase(PG8_LAS unsigned char* lds, const Gemm g, const Sched& S, const Epi& E) {
    int tid_ = threadIdx.x; asm volatile("" : "+v"(tid_));
    const int tid = tid_, wid = __builtin_amdgcn_readfirstlane(tid >> 6), lane = tid & 63, wr = wid >> 2, wc = wid & 3, fr = lane & 15, fq = lane >> 4;
    const int K = g.K, nt = K / BK;
    unsigned voffA[2], voffB[2];
#pragma unroll
    for (int i = 0; i < 2; ++i) { int R, C; stage_rc(tid * 16 + i * 8192, R, C); const int Rb = Epi::PERM ? ((R & ~31) + perm32(R & 31)) : R;
        voffA[i] = (unsigned)(R * K + C) * 2u; voffB[i] = (unsigned)(Rb * K + C) * 2u; }
    const size_t kstep = (size_t)(BK * 2);
    const size_t hstep = (size_t)HALF * K * 2;
    const size_t tstep = 2 * hstep;
    const unsigned ldsw = (unsigned)wid * 1024u;
    const int aoff = lds_byte(wr * 64 + fr, fq * 8), boff = lds_byte(wc * 32 + fr, fq * 8);
#define PG8_SA(b, h) (((b) * 2 + (h)) * HTB)
#define PG8_SB(b, h) ((4 + (b) * 2 + (h)) * HTB)
#define PG8_STAGE(bufoff, gbase, voff) do { _Pragma("unroll") for (int _i = 0; _i < 2; ++_i) \
        __builtin_amdgcn_global_load_lds((const unsigned*)((const char*)(gbase) + (voff)[_i]), (PG8_LAS unsigned*)(lds + (bufoff) + ldsw + _i * 8192), 16, 0, 0); } while (0)
#define PG8_LDA(dst, b, h) do { _Pragma("unroll") for (int m = 0; m < 4; ++m) _Pragma("unroll") for (int k = 0; k < 2; ++k) dst[m][k] = *(const PG8_LAS bf16x8*)(lds + PG8_SA(b, h) + aoff + m * 2048 + k * 1024); } while (0)
#define PG8_LDB(dst, b, h) do { _Pragma("unroll") for (int n = 0; n < 2; ++n) _Pragma("unroll") for (int k = 0; k < 2; ++k) dst[n][k] = *(const PG8_LAS bf16x8*)(lds + PG8_SB(b, h) + boff + n * 2048 + k * 1024); } while (0)
#define PG8_MMA(ai, bj, At, Bt) do { __builtin_amdgcn_s_setprio(1); _Pragma("unroll") for (int m = 0; m < 4; ++m) _Pragma("unroll") for (int n = 0; n < 2; ++n) _Pragma("unroll") for (int k = 0; k < 2; ++k) \
        acc[ai][bj][m][n] = __builtin_amdgcn_mfma_f32_16x16x32_bf16(Bt[n][k], At[m][k], acc[ai][bj][m][n], 0, 0, 0); __builtin_amdgcn_s_setprio(0); } while (0)
#define PG8_WAIT_V(n) asm volatile("s_waitcnt vmcnt(" #n ")" ::: "memory")
#define PG8_WAIT_L(n) asm volatile("s_waitcnt lgkmcnt(" #n ")" ::: "memory")
#define PG8_BAR __builtin_amdgcn_s_barrier()
#define PG8_SCHED __builtin_amdgcn_sched_barrier(0)
    Unit cur, nxt; int ui = 0;
    if (!S.next(0, cur)) return;
    f32x4 acc[2][2][4][2];
#pragma unroll
    for (int a = 0; a < 2; ++a)
#pragma unroll
        for (int b = 0; b < 2; ++b)
#pragma unroll
            for (int m = 0; m < 4; ++m)
#pragma unroll
                for (int n = 0; n < 2; ++n) acc[a][b][m][n] = (f32x4){0.f, 0.f, 0.f, 0.f};
    bf16x8 At[4][2], B0[2][2], B1[2][2];
    const char* cA = (const char*)g.A + (size_t)cur.pm * tstep; const char* cB = (const char*)g.Bt + (size_t)cur.pn * tstep;
    S.a_ready(cur);
    if constexpr (SP2) {
        PG8_STAGE(PG8_SB(0, 0), cB, voffB); PG8_STAGE(PG8_SB(0, 1), cB + hstep, voffB); PG8_STAGE(PG8_SA(0, 0), cA, voffA); PG8_STAGE(PG8_SA(0, 1), cA + hstep, voffA);
        if (wr == 1) PG8_BAR;
        PG8_WAIT_V(2); PG8_BAR;
        PG8_STAGE(PG8_SB(1, 0), cB + kstep, voffB); PG8_STAGE(PG8_SA(1, 0), cA + kstep, voffA); PG8_STAGE(PG8_SB(1, 1), cB + hstep + kstep, voffB);
        PG8_WAIT_V(6); PG8_BAR;
    } else {
        PG8_STAGE(PG8_SB(0, 0), cB, voffB); PG8_STAGE(PG8_SA(0, 0), cA, voffA); PG8_STAGE(PG8_SB(0, 1), cB + hstep, voffB); PG8_STAGE(PG8_SA(0, 1), cA + hstep, voffA);
        if (wr == 1) PG8_BAR;
        PG8_WAIT_V(4); PG8_BAR;
        PG8_STAGE(PG8_SB(1, 0), cB + kstep, voffB); PG8_STAGE(PG8_SA(1, 0), cA + kstep, voffA); PG8_STAGE(PG8_SB(1, 1), cB + hstep + kstep, voffB);
        PG8_WAIT_V(6); PG8_BAR;
    }
    for (;;) {
        const bool has_next = S.next(ui + 1, nxt);
        const char* nA = has_next ? (const char*)g.A + (size_t)nxt.pm * tstep : cA; const char* nB = has_next ? (const char*)g.Bt + (size_t)nxt.pn * tstep : cB;
        for (int t = 0; t < nt; t += 2) {
            const bool last = (t == nt - 2);
            const char* a1 = cA + (size_t)(t + 1) * kstep;
            const char* a2 = last ? nA : cA + (size_t)(t + 2) * kstep; const char* b2 = last ? nB : cB + (size_t)(t + 2) * kstep;
            const char* a3 = a2 + kstep; const char* b3 = b2 + kstep;
            if (last && has_next) S.a_ready(nxt);
            if constexpr (SP2) {
            PG8_LDB(B0, 0, 0); PG8_LDB(B1, 0, 1); PG8_SCHED; PG8_LDA(At, 0, 0); PG8_STAGE(PG8_SA(1, 1), a1 + hstep, voffA);
            PG8_WAIT_V(8); PG8_WAIT_L(0); PG8_BAR; PG8_MMA(0, 0, At, B0); PG8_MMA(0, 1, At, B1); PG8_BAR; PG8_SCHED;
            PG8_LDA(At, 0, 1); PG8_STAGE(PG8_SB(0, 0), b2, voffB); PG8_STAGE(PG8_SB(0, 1), b2 + hstep, voffB); PG8_STAGE(PG8_SA(0, 0), a2, voffA);
            PG8_WAIT_V(8); PG8_WAIT_L(0); PG8_BAR; PG8_MMA(1, 0, At, B0); PG8_MMA(1, 1, At, B1); PG8_BAR; PG8_SCHED;
            PG8_LDB(B0, 1, 0); PG8_LDB(B1, 1, 1); PG8_SCHED; PG8_LDA(At, 1, 0); PG8_STAGE(PG8_SA(0, 1), a2 + hstep, voffA);
            PG8_WAIT_V(8); PG8_WAIT_L(0); PG8_BAR; PG8_MMA(0, 0, At, B0); PG8_MMA(0, 1, At, B1); PG8_BAR; PG8_SCHED;
            PG8_LDA(At, 1, 1); PG8_STAGE(PG8_SB(1, 0), b3, voffB); PG8_STAGE(PG8_SB(1, 1), b3 + hstep, voffB); PG8_STAGE(PG8_SA(1, 0), a3, voffA);
            PG8_WAIT_V(8); PG8_WAIT_L(0); PG8_BAR; PG8_MMA(1, 0, At, B0); PG8_MMA(1, 1, At, B1); PG8_BAR; PG8_SCHED;
            } else {
            PG8_LDB(B0, 0, 0); PG8_SCHED; PG8_LDA(At, 0, 0); PG8_STAGE(PG8_SA(1, 1), a1 + hstep, voffA);
            PG8_WAIT_L(8); PG8_BAR; PG8_WAIT_L(0); PG8_MMA(0, 0, At, B0); PG8_BAR; PG8_SCHED;
            PG8_LDB(B1, 0, 1); PG8_STAGE(PG8_SB(0, 0), b2, voffB);
            PG8_BAR; PG8_WAIT_L(0); PG8_MMA(0, 1, At, B1); PG8_BAR;
            PG8_LDA(At, 0, 1); PG8_STAGE(PG8_SA(0, 0), a2, voffA);
            PG8_BAR; PG8_WAIT_L(0); PG8_MMA(1, 0, At, B0); PG8_BAR; PG8_SCHED;
            PG8_STAGE(PG8_SB(0, 1), b2 + hstep, voffB);
            PG8_WAIT_V(6); PG8_BAR; PG8_MMA(1, 1, At, B1); PG8_BAR;
            PG8_LDB(B0, 1, 0); PG8_SCHED; PG8_LDA(At, 1, 0); PG8_STAGE(PG8_SA(0, 1), a2 + hstep, voffA);
            PG8_WAIT_L(8); PG8_BAR; PG8_WAIT_L(0); PG8_MMA(0, 0, At, B0); PG8_BAR; PG8_SCHED;
            PG8_LDB(B1, 1, 1); PG8_STAGE(PG8_SB(1, 0), b3, voffB);
            PG8_BAR; PG8_WAIT_L(0); PG8_MMA(0, 1, At, B1); PG8_BAR;
            PG8_LDA(At, 1, 1); PG8_STAGE(PG8_SA(1, 0), a3, voffA);
            PG8_BAR; PG8_WAIT_L(0); PG8_MMA(1, 0, At, B0); PG8_BAR; PG8_SCHED;
            PG8_STAGE(PG8_SB(1, 1), b3 + hstep, voffB);
            PG8_WAIT_V(6); PG8_BAR; PG8_MMA(1, 1, At, B1); PG8_BAR;
            }
        }
        if constexpr (ALIGN_EPI) { if (wr == 0) PG8_BAR; }
        if constexpr (!Epi::AFTER_DRAIN) { E(acc, cur, wr, wc, fr, fq); S.done(cur); }
        if (!has_next) break;
#pragma unroll
        for (int a = 0; a < 2; ++a)
#pragma unroll
            for (int b = 0; b < 2; ++b)
#pragma unroll
                for (int m = 0; m < 4; ++m)
#pragma unroll
                    for (int n = 0; n < 2; ++n) acc[a][b][m][n] = (f32x4){0.f, 0.f, 0.f, 0.f};
        cur = nxt; cA = nA; cB = nB; ++ui;
        if constexpr (ALIGN_EPI) { if (wr == 1) PG8_BAR; }
    }
    PG8_WAIT_V(0);
    if constexpr (!ALIGN_EPI) { if (wr == 0) PG8_BAR; }
    PG8_BAR;
    if constexpr (Epi::AFTER_DRAIN) { E.fused(acc, cur, wr, wc, fr, fq, lds, wid, lane); S.done(cur); }
#undef PG8_SA
#undef PG8_SB
#undef PG8_STAGE
#undef PG8_LDA
#undef PG8_LDB
#undef PG8_MMA
#undef PG8_WAIT_V
#undef PG8_WAIT_L
#undef PG8_BAR
#undef PG8_SCHED
}
}

#ifndef PG8_SP2
#define PG8_SP2 true
#endif
#ifndef PG8_ALIGN
#define PG8_ALIGN true
#endif
constexpr int NWAVES = 8;
constexpr int NPH = 15;
#ifndef MK_N_LAUNCHES
#define MK_N_LAUNCHES 1
#endif
constexpr int N_LAUNCHES = MK_N_LAUNCHES;

constexpr int BATCH = 2, SEQ = 16384, DM = 1024, DEPTH = 2;
constexpr int M = BATCH * SEQ;
constexpr int INW = 2824;
constexpr int NP = 3072;
constexpr int QOFF = 0, KOFF = 256, VOFF = 512, ZOFF = 768, XOFF = 1280, SBOFF = 2048, SCOFF = 2304, SVOFF = 2560, DTOFF = 2816;
constexpr int NCHUNK = SEQ / 64;
constexpr float EPS = 1e-6f;
constexpr float SB_EXIT = -104.0f;

constexpr size_t MiB = 1u << 20;
constexpr size_t WS_CTL = 0, CTL_ZERO_BYTES = 1 * MiB;
constexpr size_t WS_WIN = 2 * MiB;
constexpr size_t WS_WOUT = 14 * MiB;
constexpr size_t WS_WS = 18 * MiB;
constexpr size_t WS_SS2 = 22 * MiB;
constexpr size_t WS_EA = 24 * MiB;
constexpr size_t WS_CD = 25 * MiB;
constexpr size_t WS_CC = 26 * MiB;
constexpr size_t WS_U8 = 34 * MiB;
constexpr size_t WS_V8 = 66 * MiB;
constexpr size_t WS_US = 25 * MiB + 128 * 1024;
constexpr size_t WS_VS = 25 * MiB + 256 * 1024;
constexpr size_t WS_RS1 = 25 * MiB + 512 * 1024;
constexpr size_t WS_XB = 98 * MiB;
constexpr size_t WS_XNY = 162 * MiB;
constexpr size_t WS_P = 226 * MiB;
constexpr size_t WS_SC = WS_P, WS_X1B = WS_P + 128 * MiB;
constexpr size_t WS_ST = 418 * MiB;
constexpr size_t WS_END = 482 * MiB;
constexpr int CW_BAR = 4096;

constexpr int LDS_BYTES = 163840;
constexpr int LDSCTL_OFF = 161792, MISC_OFF = LDSCTL_OFF + 320;
static_assert(MISC_OFF + 128 <= LDS_BYTES, "LDS map");

#define GAS __attribute__((address_space(1)))
#define LAS __attribute__((address_space(3)))
typedef unsigned short bf16;
typedef unsigned v4u __attribute__((ext_vector_type(4)));
typedef unsigned v2u __attribute__((ext_vector_type(2)));
typedef float f32x4 __attribute__((ext_vector_type(4)));
typedef GAS unsigned gu32;
#define RLX_AGENT __ATOMIC_RELAXED, __HIP_MEMORY_SCOPE_AGENT
#define LDS_WAIT() asm volatile("s_waitcnt lgkmcnt(0)" ::: "memory")
#define VM_WAIT() asm volatile("s_waitcnt vmcnt(0)" ::: "memory")
__device__ __forceinline__ unsigned f2bf(float f) { unsigned u = __builtin_bit_cast(unsigned, f); return (u + 0x7fffu + ((u >> 16) & 1u)) >> 16; }
__device__ __forceinline__ unsigned pk2(float lo, float hi) { return f2bf(lo) | (f2bf(hi) << 16); }
__device__ __forceinline__ float bflo(unsigned u) { return __uint_as_float(u << 16); }
__device__ __forceinline__ float bfhi(unsigned u) { return __uint_as_float(u & 0xffff0000u); }
__device__ __forceinline__ float bf2f(bf16 h) { return __uint_as_float(((unsigned)h) << 16); }
__device__ __forceinline__ void unpack8(const v4u v, float (&f)[8]) { f[0] = bflo(v.x); f[1] = bfhi(v.x); f[2] = bflo(v.y); f[3] = bfhi(v.y); f[4] = bflo(v.z); f[5] = bfhi(v.z); f[6] = bflo(v.w); f[7] = bfhi(v.w); }
__device__ __forceinline__ v4u pack8(const float (&f)[8]) { v4u o; o.x = pk2(f[0], f[1]); o.y = pk2(f[2], f[3]); o.z = pk2(f[4], f[5]); o.w = pk2(f[6], f[7]); return o; }
__device__ __forceinline__ float wave_sum(float v) {
#pragma unroll
    for (int o = 1; o < 64; o <<= 1) v += __shfl_xor(v, o);
    return v;
}
template <int CTRL> __device__ __forceinline__ float dppf(float x) { return __int_as_float(__builtin_amdgcn_update_dpp(0, __float_as_int(x), CTRL, 0xf, 0xf, false)); }
__device__ __forceinline__ float sum_x16(float x) { const auto r = __builtin_amdgcn_permlane16_swap(__float_as_uint(x), __float_as_uint(x), false, false); return __uint_as_float(r[0]) + __uint_as_float(r[1]); }
__device__ __forceinline__ float sum_x32(float x) { const auto r = __builtin_amdgcn_permlane32_swap(__float_as_uint(x), __float_as_uint(x), false, false); return __uint_as_float(r[0]) + __uint_as_float(r[1]); }
__device__ __forceinline__ float wave_sum_v(float x) { x += dppf<0xB1>(x); x += dppf<0x4E>(x); x += dppf<0x141>(x); x += dppf<0x128>(x); x = sum_x16(x); return sum_x32(x); }
__device__ __forceinline__ float silu_f(float x) { return x / (1.0f + __expf(-x)); }

#define XB_TMO      128
#define XB_XCNT(j)  (256  + 64 * (j))
#define XB_XSUB(j)  (1280 + 64 * (j))
#define XB_XGEN(j)  (2304 + 64 * (j))
#define XB_TOP      3328
#define XB_TOPGEN   3392
#define XCD_BAR_WORDS 3456
#define XB_SPIN_CAP (1u << 18)

__device__ __forceinline__ unsigned xb_ld(unsigned* p)              { return __hip_atomic_load(p, __ATOMIC_RELAXED, __HIP_MEMORY_SCOPE_AGENT); }
__device__ __forceinline__ unsigned xb_add(unsigned* p, unsigned v) { return __hip_atomic_fetch_add(p, v, __ATOMIC_RELAXED, __HIP_MEMORY_SCOPE_AGENT); }
__device__ __forceinline__ unsigned xb_xcc_id() { return (unsigned)__builtin_amdgcn_s_getreg((3 << 11) | 20) & 0xFu; }
#define XB_SPIN(cond, bar) do { unsigned _sp = 0; while (cond) { __builtin_amdgcn_s_sleep(1); \
    if ((++_sp & 255u) == 0u) { if (xb_ld(&(bar)[XB_TMO])) break; if (_sp > XB_SPIN_CAP) { atomicAdd(&(bar)[XB_TMO], 1u); break; } } } } while (0)

struct XcdBarrier {
    unsigned* bar; unsigned x;
    volatile LAS unsigned* st;
};

__device__ __forceinline__ XcdBarrier xcd_barrier_post(unsigned* bar, volatile LAS unsigned* st) {
    XcdBarrier b; b.bar = bar; b.x = xb_xcc_id(); b.st = st;
    if (threadIdx.x == 0) (void)xb_add(&bar[XB_XCNT(b.x)], 1u);
    return b;
}
__device__ __forceinline__ void xcd_barrier_complete(unsigned* bar, unsigned x, unsigned& nloc, unsigned& nx) {
    const unsigned G = gridDim.x * gridDim.y * gridDim.z;
    unsigned sum, cnt, mine, sp = 0u;
    for (;;) {
        sum = 0u; cnt = 0u; mine = 0u;
#pragma unroll
        for (unsigned j = 0; j < 16; ++j) { const unsigned c = xb_ld(&bar[XB_XCNT(j)]); sum += c; cnt += (c > 0u) ? 1u : 0u; mine = (j == x) ? c : mine; }
        if (sum == G) break;
        __builtin_amdgcn_s_sleep(1);
        if ((++sp & 255u) == 0u) { if (xb_ld(&bar[XB_TMO])) break; if (sp > XB_SPIN_CAP) { atomicAdd(&bar[XB_TMO], 1u); break; } }
    }
    nloc = mine > 0u ? mine : 1u; nx = cnt > 0u ? cnt : 1u;
}

__device__ __forceinline__ void xcd_barrier(const XcdBarrier& b) {
    asm volatile("s_waitcnt vmcnt(0)" ::: "memory");
    __syncthreads();
    if (threadIdx.x == 0) {
        unsigned* bar = b.bar;
        __builtin_amdgcn_s_waitcnt(0);
        unsigned nloc = b.st[0], nx = b.st[1];
        if (nloc == 0u) { xcd_barrier_complete(bar, b.x, nloc, nx); b.st[0] = nloc; b.st[1] = nx; }
        const unsigned old = xb_add(&bar[XB_XSUB(b.x)], 1u);
        const unsigned gen = old / nloc;
        if (old + 1u == (gen + 1u) * nloc) {
            __builtin_amdgcn_fence(__ATOMIC_RELEASE, "agent");
            asm volatile("s_waitcnt vmcnt(0)" ::: "memory");
            const unsigned og = xb_add(&bar[XB_TOP], 1u);
            const unsigned tg = og / nx;
            if (og + 1u == (tg + 1u) * nx) xb_add(&bar[XB_TOPGEN], 1u);
            else XB_SPIN(xb_ld(&bar[XB_TOPGEN]) == tg, bar);
            __builtin_amdgcn_fence(__ATOMIC_ACQUIRE, "agent");
            xb_add(&bar[XB_XGEN(b.x)], 1u);
            asm volatile("s_waitcnt vmcnt(0)" ::: "memory");
        } else {
            XB_SPIN(xb_ld(&bar[XB_XGEN(b.x)]) == gen, bar);
            __builtin_amdgcn_fence(__ATOMIC_ACQUIRE, "agent");
            asm volatile("s_waitcnt vmcnt(0)" ::: "memory");
        }
    }
    __syncthreads();
}

struct Ctx { LAS unsigned char* lds; int tid, lane, wave, vcu, G; };

__device__ __forceinline__ int win_colmap(int n) { return n < 2048 ? n : (n < 2816 ? n + 8 : (n < INW ? n - 2816 + 2048 : -1)); }
__device__ __forceinline__ void tr_item(const float* W, int Nsrc, int K, bf16* WT, const float* rowscale, LAS float* scr, int kb, int nb, int lane, bool mapped) {
    const int k0 = 64 * kb, n0 = 32 * nb; const int n = n0 + (lane & 31); const int sc = mapped ? win_colmap(n) : n;
#pragma unroll 8
    for (int i = 0; i < 32; ++i) { const int kk = 2 * i + (lane >> 5); float v = 0.f; if (sc >= 0) { v = W[(size_t)(k0 + kk) * Nsrc + sc]; if (rowscale) v *= rowscale[k0 + kk]; } scr[kk * 33 + (lane & 31)] = v; }
    LDS_WAIT(); asm volatile("" ::: "memory");
    const int c = lane & 7;
#pragma unroll
    for (int j = 0; j < 4; ++j) { const int nn = (lane >> 3) + 8 * j; const LAS float* s = scr + (8 * c) * 33 + nn;
        v4u o; o.x = pk2(s[0 * 33], s[1 * 33]); o.y = pk2(s[2 * 33], s[3 * 33]); o.z = pk2(s[4 * 33], s[5 * 33]); o.w = pk2(s[6 * 33], s[7 * 33]);
        *(GAS v4u*)(WT + (size_t)(n0 + nn) * K + k0 + 8 * c) = o; }
    LDS_WAIT(); asm volatile("" ::: "memory");
}
__device__ __forceinline__ void p0_prologue(const Ctx F, const float* x, const float* norm1_w, const float* w_in, const float* w_out, const float* norm2_w, const float* w_q, const float* sub_keys, unsigned char* ws) {
    bf16* WIN = (bf16*)(ws + WS_WIN); bf16* WOUT = (bf16*)(ws + WS_WOUT); bf16* WST = (bf16*)(ws + WS_WS);
    LAS float* scr = (LAS float*)(F.lds + F.wave * 16384);
    const int gw = F.vcu * NWAVES + F.wave, NGW = F.G * NWAVES;
    constexpr int I_IN = (DM / 64) * (NP / 32), I_OUT = (DM / 64) * (DM / 32);
    for (int it = gw; it < DEPTH * (I_IN + I_OUT); it += NGW) {
        int r = it;
        if (r < DEPTH * I_IN) { const int L = r / I_IN; r -= L * I_IN; tr_item(w_in + (size_t)L * DM * INW, INW, DM, WIN + (size_t)L * NP * DM, norm1_w + L * DM, scr, r / (NP / 32), r % (NP / 32), F.lane, true); }
        else { r -= DEPTH * I_IN; const int L = r / I_OUT; r -= L * I_OUT; tr_item(w_out + (size_t)L * DM * DM, DM, DM, WOUT + (size_t)L * DM * DM, nullptr, scr, r / (DM / 32), r % (DM / 32), F.lane, false); }
    }
    {
        typedef float f32x4w __attribute__((ext_vector_type(4)));
        const int fr = F.lane & 15, fq = F.lane >> 4;
        for (int u = gw; u < DEPTH * 8 * 64 * 2; u += NGW) {
            const int jh = u & 1, dt = (u >> 1) & 63, sl = (u >> 7) & 7, L = u >> 10, half = sl & 1;
            const float* Aq = w_q + (size_t)L * DM * DM + (size_t)(16 * dt + fr) * DM + sl * 128 + fq;
            const float* Bk = sub_keys + ((size_t)L * 2 + half) * 128 * 128 + (size_t)(64 * jh + fr) * 128 + fq;
            f32x4w acc[4];
#pragma unroll
            for (int j = 0; j < 4; ++j) acc[j] = (f32x4w){0.f, 0.f, 0.f, 0.f};
#pragma unroll 4
            for (int kk = 0; kk < 32; ++kk) { const float a = Aq[4 * kk];
#pragma unroll
                for (int j = 0; j < 4; ++j) acc[j] = __builtin_amdgcn_mfma_f32_16x16x4f32(a, Bk[(size_t)(16 * j) * 128 + 4 * kk], acc[j], 0, 0, 0); }
            const f32x4 w4 = *(const f32x4*)(norm2_w + L * DM + 16 * dt + 4 * fq);
#pragma unroll
            for (int j = 0; j < 4; ++j) *(v2u*)(WST + (size_t)L * DM * DM + (size_t)(sl * 128 + 64 * jh + 16 * j + fr) * DM + 16 * dt + 4 * fq) = (v2u){pk2(acc[j][0] * w4[0], acc[j][1] * w4[1]), pk2(acc[j][2] * w4[2], acc[j][3] * w4[3])};
        }
    }
    { bf16* XB = (bf16*)(ws + WS_XB); float* RS1 = (float*)(ws + WS_RS1);
    for (int m = gw; m < M; m += NGW) {
        const f32x4* xr = (const f32x4*)(x + (size_t)m * DM) + F.lane; f32x4 v[4]; float s = 0.f;
#pragma unroll
        for (int j = 0; j < 4; ++j) { v[j] = xr[64 * j]; s += (v[j][0] * v[j][0] + v[j][1] * v[j][1]) + (v[j][2] * v[j][2] + v[j][3] * v[j][3]); }
        const float rstd = 1.0f / sqrtf(wave_sum_v(s) * (1.0f / DM) + EPS);
        v2u* o8 = (v2u*)(XB + (size_t)m * DM) + F.lane;
#pragma unroll
        for (int j = 0; j < 4; ++j) { v2u o; o.x = pk2(v[j][0], v[j][1]); o.y = pk2(v[j][2], v[j][3]); o8[64 * j] = o; }
        if (F.lane == 0) RS1[m] = rstd;
    } }
}

typedef float f32x16 __attribute__((ext_vector_type(16)));
typedef short bf16x8 __attribute__((ext_vector_type(8)));
typedef short v4i16_t __attribute__((ext_vector_type(4)));
constexpr int AT_VS = 72;
__device__ __forceinline__ int crow(int r, int hi) { return (r & 3) + 8 * (r >> 2) + 4 * hi; }
__device__ __forceinline__ void attn_mfma(const Ctx F, const bf16* P, bf16* Y) {
    LAS bf16* vt = (LAS bf16*)(F.lds + F.wave * 8192);
    const int lane = F.lane, r32 = lane & 31, hi = lane >> 5;
    const int gw = F.vcu * NWAVES + F.wave, NGW = F.G * NWAVES;
    const LAS bf16* vrd = vt + (4 * hi + ((lane & 15) >> 2)) * AT_VS + 16 * ((lane >> 4) & 1) + 4 * (lane & 3);
#pragma unroll 1
    for (int u = gw; u < BATCH * 4 * (SEQ / 32); u += NGW) {
        const int qb = u & (SEQ / 32 - 1), bh = u / (SEQ / 32), h = bh & 3, b = bh >> 2;
        const int q0 = qb * 32; const size_t rowbase = (size_t)b * SEQ; const int t = q0 + r32;
        bf16x8 qf[4];
#pragma unroll
        for (int d0 = 0; d0 < 4; ++d0) { float f[8]; unpack8(*(const v4u*)(P + (rowbase + q0 + r32) * NP + QOFF + h * 64 + d0 * 16 + hi * 8), f);
#pragma unroll
            for (int i = 0; i < 8; ++i) f[i] *= 0.125f;
            qf[d0] = __builtin_bit_cast(bf16x8, pack8(f)); }
        f32x16 o0, o1;
#pragma unroll
        for (int r = 0; r < 16; ++r) { o0[r] = 0.f; o1[r] = 0.f; }
        float R = 0.f;
        int k0 = q0; bool diag = true;
        v4u kf[4], vr[4];
        { const bf16* kp = P + (rowbase + k0 + r32) * NP + KOFF + h * 64 + hi * 8; const bf16* vp = P + (rowbase + k0 + (lane >> 1)) * NP + VOFF + h * 64 + (lane & 1) * 32;
#pragma unroll
          for (int c = 0; c < 4; ++c) { kf[c] = *(const v4u*)(kp + c * 16); vr[c] = *(const v4u*)(vp + c * 8); } }
#pragma unroll 1
        for (;;) {
#pragma unroll
            for (int c = 0; c < 4; ++c) *(LAS v4u*)(vt + (lane >> 1) * AT_VS + (lane & 1) * 32 + c * 8) = vr[c];
            bf16x8 ka[4];
#pragma unroll
            for (int c = 0; c < 4; ++c) ka[c] = __builtin_bit_cast(bf16x8, kf[c]);
            const int kn = k0 - 32;
            if (kn >= 0) { const bf16* kp = P + (rowbase + kn + r32) * NP + KOFF + h * 64 + hi * 8; const bf16* vp = P + (rowbase + kn + (lane >> 1)) * NP + VOFF + h * 64 + (lane & 1) * 32;
#pragma unroll
                for (int c = 0; c < 4; ++c) { kf[c] = *(const v4u*)(kp + c * 16); vr[c] = *(const v4u*)(vp + c * 8); } }
            f32x16 p;
#pragma unroll
            for (int r = 0; r < 16; ++r) p[r] = 0.f;
#pragma unroll
            for (int d0 = 0; d0 < 4; ++d0) p = __builtin_amdgcn_mfma_f32_32x32x16_bf16(ka[d0], qf[d0], p, 0, 0, 0);
            float l[16], ee[16];
#pragma unroll
            for (int r = 0; r < 16; ++r) { const float z = p[r]; const float sp = fmaxf(z, 0.f) + __logf(1.0f + __expf(-fabsf(z)));
                const bool valid = !diag || (k0 + crow(r, hi) < t);
                l[r] = valid ? -sp : 0.f; ee[r] = valid ? (z - sp) : -INFINITY; }
            float gs[4], pg[4], tot[4], later[4];
#pragma unroll
            for (int g = 0; g < 4; ++g) { gs[g] = (l[4 * g] + l[4 * g + 1]) + (l[4 * g + 2] + l[4 * g + 3]); tot[g] = sum_x32(gs[g]); pg[g] = tot[g] - gs[g]; }
            later[3] = 0.f; later[2] = tot[3]; later[1] = tot[3] + tot[2]; later[0] = later[1] + tot[1];
            if (hi == 0) {
#pragma unroll
                for (int g = 0; g < 4; ++g) later[g] += pg[g]; }
#pragma unroll
            for (int g = 0; g < 4; ++g) { const float base = R + later[g];
                const float s3 = base, s2 = s3 + l[4 * g + 3], s1 = s2 + l[4 * g + 2], s0 = s1 + l[4 * g + 1];
                p[4 * g + 3] = __expf(ee[4 * g + 3] + s3); p[4 * g + 2] = __expf(ee[4 * g + 2] + s2); p[4 * g + 1] = __expf(ee[4 * g + 1] + s1); p[4 * g] = __expf(ee[4 * g] + s0); }
            R += (tot[0] + tot[1]) + (tot[2] + tot[3]);
            bf16x8 pb[2];
#pragma unroll
            for (int ks = 0; ks < 2; ++ks) { float f[8];
#pragma unroll
                for (int j = 0; j < 8; ++j) f[j] = p[8 * ks + j];
                pb[ks] = __builtin_bit_cast(bf16x8, pack8(f)); }
#pragma unroll
            for (int ks = 0; ks < 2; ++ks)
#pragma unroll
                for (int dt = 0; dt < 2; ++dt) {
                    const v4i16_t lo = __builtin_amdgcn_ds_read_tr16_b64_v4i16((LAS v4i16_t*)(vrd + (16 * ks) * AT_VS + 32 * dt));
                    const v4i16_t hi4 = __builtin_amdgcn_ds_read_tr16_b64_v4i16((LAS v4i16_t*)(vrd + (16 * ks + 8) * AT_VS + 32 * dt));
                    const bf16x8 va = (bf16x8){lo[0], lo[1], lo[2], lo[3], hi4[0], hi4[1], hi4[2], hi4[3]};
                    if (dt == 0) o0 = __builtin_amdgcn_mfma_f32_32x32x16_bf16(va, pb[ks], o0, 0, 0, 0); else o1 = __builtin_amdgcn_mfma_f32_32x32x16_bf16(va, pb[ks], o1, 0, 0, 0);
                }
            if (kn < 0 || __all(R < SB_EXIT)) break;
            k0 = kn; diag = false;
        }
        bf16* yp = Y + (rowbase + q0 + r32) * DM + h * 64;
#pragma unroll
        for (int g = 0; g < 4; ++g) { v2u a, c; a.x = pk2(o0[4 * g], o0[4 * g + 1]); a.y = pk2(o0[4 * g + 2], o0[4 * g + 3]); c.x = pk2(o1[4 * g], o1[4 * g + 1]); c.y = pk2(o1[4 * g + 2], o1[4 * g + 3]);
            *(v2u*)(yp + 8 * g + 4 * hi) = a; *(v2u*)(yp + 32 + 8 * g + 4 * hi) = c; }
    }
}
__device__ __forceinline__ void shortconv(const Ctx F, const bf16* P, bf16* Y, const float* cw  ) {
    for (long it = (long)F.vcu * 512 + F.tid; it < (long)(M / 8) * 32; it += (long)F.G * 512) {
        const size_t row0 = (size_t)(it >> 5) * 8; const int c0 = (int)(it & 31) * 8; const int t0 = (int)(row0 & (SEQ - 1));
        v4u cr[10], vr[10], br[8];
#pragma unroll
        for (int j = 0; j < 10; ++j) { const bool ok = (j >= 2) || (t0 > 0);
            cr[j] = ok ? *(const v4u*)(P + (row0 + j - 2) * NP + SCOFF + c0) : (v4u){0u, 0u, 0u, 0u}; vr[j] = ok ? *(const v4u*)(P + (row0 + j - 2) * NP + SVOFF + c0) : (v4u){0u, 0u, 0u, 0u}; }
#pragma unroll
        for (int j = 0; j < 8; ++j) br[j] = *(const v4u*)(P + (row0 + j) * NP + SBOFF + c0);
        float w[3][8];
#pragma unroll
        for (int k = 0; k < 3; ++k) { const f32x4 w0 = *(const f32x4*)(cw + k * 256 + c0), w1 = *(const f32x4*)(cw + k * 256 + c0 + 4);
#pragma unroll
            for (int i = 0; i < 4; ++i) { w[k][i] = w0[i]; w[k][4 + i] = w1[i]; } }
        float cv[10][8];
#pragma unroll
        for (int j = 0; j < 10; ++j) { float c8[8], v8[8]; unpack8(cr[j], c8); unpack8(vr[j], v8);
#pragma unroll
            for (int i = 0; i < 8; ++i) cv[j][i] = c8[i] * v8[i]; }
#pragma unroll
        for (int j = 0; j < 8; ++j) { float b8[8], o[8]; unpack8(br[j], b8);
#pragma unroll
            for (int i = 0; i < 8; ++i) o[i] = b8[i] * (w[0][i] * cv[j][i] + w[1][i] * cv[j + 1][i] + w[2][i] * cv[j + 2][i]);
            *(v4u*)(Y + (row0 + j) * DM + 768 + c0) = pack8(o); }
    }
}
constexpr int XTS = 72, BNS = 136;
constexpr int L_XT = 0, L_BN = L_XT + 512 * XTS * 2, L_BT = L_BN + 64 * BNS * 2, L_CN = L_BT + 128 * XTS * 2, L_GG = L_CN + 64 * BNS * 2, L_DT = L_GG + 128 * XTS * 2, L_ACS = L_DT + 2048, L_WL = L_ACS + 2048, L_SSD_END = L_WL + 2048;
static_assert(L_SSD_END <= LDSCTL_OFF, "SSD part 1 LDS");
typedef float f32x4v __attribute__((ext_vector_type(4)));
__device__ __forceinline__ void ssd_part1(const Ctx F, const bf16* P, bf16* Y, const float* cw  , const float* cb  , const float* dt_bias, const float* A_log, const float* Dp,
                                          bf16* CC, float* EA, float* CD, bf16* ST) {
    LAS bf16* XT = (LAS bf16*)(F.lds + L_XT); LAS bf16* BN = (LAS bf16*)(F.lds + L_BN); LAS bf16* BT = (LAS bf16*)(F.lds + L_BT); LAS bf16* CN = (LAS bf16*)(F.lds + L_CN); LAS bf16* GG = (LAS bf16*)(F.lds + L_GG);
    LAS float* DTH = (LAS float*)(F.lds + L_DT); LAS float* ACH = (LAS float*)(F.lds + L_ACS); LAS float* WLH = (LAS float*)(F.lds + L_WL);
    const int lane = F.lane, fr = lane & 15, fq = lane >> 4;
#pragma unroll 1
    for (int u = F.vcu; u < BATCH * NCHUNK; u += F.G) {
        const int b = u / NCHUNK, c = u % NCHUNK, t0 = c * 64; const size_t r0 = (size_t)b * SEQ + t0;
        __syncthreads();
        if (F.tid < 384) { const int ch = 2 * F.tid;
            float w0[4], w1[4];
#pragma unroll
            for (int k = 0; k < 4; ++k) { w0[k] = cw[k * 768 + ch]; w1[k] = cw[k * 768 + ch + 1]; }
            const float b0 = cb[ch], b1 = cb[ch + 1];
            const bf16* pin = P + ((size_t)b * SEQ + t0) * NP + XOFF + ch;
            unsigned h0 = 0u, h1 = 0u, h2 = 0u;
            if (t0 > 0) { h0 = *(const unsigned*)(pin - 3 * (ptrdiff_t)NP); h1 = *(const unsigned*)(pin - 2 * (ptrdiff_t)NP); h2 = *(const unsigned*)(pin - (ptrdiff_t)NP); }
#pragma unroll 1
            for (int tq = 0; tq < 4; ++tq) {
                unsigned r[16];
#pragma unroll
                for (int j = 0; j < 16; ++j) r[j] = *(const unsigned*)(pin + (size_t)(16 * tq + j) * NP);
#pragma unroll
                for (int tg4 = 0; tg4 < 4; ++tg4) { const int tg = 4 * tq + tg4;
                    const unsigned in[7] = {tg4 == 0 ? h0 : r[4 * tg4 - 3], tg4 == 0 ? h1 : r[4 * tg4 - 2], tg4 == 0 ? h2 : r[4 * tg4 - 1], r[4 * tg4], r[4 * tg4 + 1], r[4 * tg4 + 2], r[4 * tg4 + 3]};
                    float y0[4], y1[4];
#pragma unroll
                    for (int j = 0; j < 4; ++j) { float a0 = b0, a1 = b1;
#pragma unroll
                        for (int k = 0; k < 4; ++k) { a0 += w0[k] * bflo(in[j + k]); a1 += w1[k] * bfhi(in[j + k]); }
                        y0[j] = silu_f(a0); y1[j] = silu_f(a1); }
                    const v2u t0v = (v2u){pk2(y0[0], y0[1]), pk2(y0[2], y0[3])}, t1v = (v2u){pk2(y1[0], y1[1]), pk2(y1[2], y1[3])};
                    if (ch < 512) { *(LAS v2u*)(XT + ch * XTS + 4 * tg) = t0v; *(LAS v2u*)(XT + (ch + 1) * XTS + 4 * tg) = t1v; }
                    else if (ch < 640) { const int nb = ch - 512; *(LAS v2u*)(BT + nb * XTS + 4 * tg) = t0v; *(LAS v2u*)(BT + (nb + 1) * XTS + 4 * tg) = t1v;
#pragma unroll
                        for (int j = 0; j < 4; ++j) *(LAS unsigned*)(BN + (4 * tg + j) * BNS + nb) = pk2(y0[j], y1[j]); }
                    else { const int nc = ch - 640;
#pragma unroll
                        for (int j = 0; j < 4; ++j) { const unsigned pk = pk2(y0[j], y1[j]); *(LAS unsigned*)(CN + (4 * tg + j) * BNS + nc) = pk; *(unsigned*)(CC + (r0 + 4 * tg + j) * 128 + nc) = pk; } }
                }
                h0 = r[13]; h1 = r[14]; h2 = r[15];
            }
        }
        { const int h = F.wave, l = lane; const float xx = bf2f(P[(r0 + l) * NP + DTOFF + h]) + dt_bias[h]; const float dt = xx > 20.f ? xx : log1pf(__expf(xx));
          const float A = -__expf(A_log[h]); float cs = dt * A;
#pragma unroll
          for (int o = 1; o < 64; o <<= 1) { const float tmp = __shfl_up(cs, o); if (l >= o) cs += tmp; }
          const float last = __shfl(cs, 63);
          DTH[h * 64 + l] = dt; ACH[h * 64 + l] = cs; WLH[h * 64 + l] = __expf(last - cs) * dt;
          EA[(r0 + l) * 8 + h] = __expf(cs); if (l == 63) CD[(size_t)u * 8 + h] = __expf(cs); }
        __syncthreads();
        { const int g = F.wave >> 2, mt = F.wave & 3;
          const bf16x8 c0 = *(const LAS bf16x8*)(CN + (16 * mt + fr) * BNS + g * 64 + 8 * fq), c1 = *(const LAS bf16x8*)(CN + (16 * mt + fr) * BNS + g * 64 + 32 + 8 * fq);
#pragma unroll 1
          for (int nt = 0; nt <= mt; ++nt) {
              const bf16x8 b0 = *(const LAS bf16x8*)(BN + (16 * nt + fr) * BNS + g * 64 + 8 * fq), b1 = *(const LAS bf16x8*)(BN + (16 * nt + fr) * BNS + g * 64 + 32 + 8 * fq);
              f32x4v acc = (f32x4v){0.f, 0.f, 0.f, 0.f};
              acc = __builtin_amdgcn_mfma_f32_16x16x32_bf16(b0, c0, acc, 0, 0, 0); acc = __builtin_amdgcn_mfma_f32_16x16x32_bf16(b1, c1, acc, 0, 0, 0);
              *(LAS v2u*)(GG + (g * 64 + 16 * mt + fr) * XTS + 16 * nt + 4 * fq) = (v2u){pk2(acc[0], acc[1]), pk2(acc[2], acc[3])}; } }
        __syncthreads();
        { const int h = F.wave, g = h >> 2;
          bf16x8 xa[4][2];
#pragma unroll
          for (int nt = 0; nt < 4; ++nt)
#pragma unroll
              for (int ks = 0; ks < 2; ++ks) xa[nt][ks] = *(const LAS bf16x8*)(XT + (h * 64 + 16 * nt + fr) * XTS + 32 * ks + 8 * fq);
          {
            f32x4v acc[4][4];
#pragma unroll
            for (int nt = 0; nt < 4; ++nt)
#pragma unroll
                for (int mt = 0; mt < 4; ++mt) acc[nt][mt] = (f32x4v){0.f, 0.f, 0.f, 0.f};
#pragma unroll
            for (int mt = 0; mt < 4; ++mt)
#pragma unroll
                for (int ks = 0; ks < 2; ++ks) if (32 * ks <= 16 * mt + 15) {
                    const int l = 16 * mt + fr, s0 = 32 * ks + 8 * fq;
                    float gf[8]; unpack8(*(const LAS v4u*)(GG + (g * 64 + l) * XTS + s0), gf);
                    const float al = ACH[h * 64 + l]; const f32x4 a0 = *(const LAS f32x4*)(ACH + h * 64 + s0), a1 = *(const LAS f32x4*)(ACH + h * 64 + s0 + 4), d0 = *(const LAS f32x4*)(DTH + h * 64 + s0), d1 = *(const LAS f32x4*)(DTH + h * 64 + s0 + 4);
                    float mf[8];
#pragma unroll
                    for (int j = 0; j < 4; ++j) { mf[j] = (s0 + j <= l) ? gf[j] * __expf(al - a0[j]) * d0[j] : 0.f; mf[4 + j] = (s0 + 4 + j <= l) ? gf[4 + j] * __expf(al - a1[j]) * d1[j] : 0.f; }
                    const bf16x8 mfr = __builtin_bit_cast(bf16x8, pack8(mf));
#pragma unroll
                    for (int nt = 0; nt < 4; ++nt) acc[nt][mt] = __builtin_amdgcn_mfma_f32_16x16x32_bf16(xa[nt][ks], mfr, acc[nt][mt], 0, 0, 0);
                }
            const float Dh = Dp[h];
#pragma unroll
            for (int mt = 0; mt < 4; ++mt)
#pragma unroll
                for (int nt = 0; nt < 4; ++nt) { const int l = 16 * mt + fr, p0 = 16 * nt + 4 * fq; float o[4];
#pragma unroll
                    for (int r = 0; r < 4; ++r) o[r] = acc[nt][mt][r] + Dh * bf2f(XT[(h * 64 + p0 + r) * XTS + l]);
                    *(v2u*)(Y + (r0 + l) * DM + 256 + h * 64 + p0) = (v2u){pk2(o[0], o[1]), pk2(o[2], o[3])}; }
          }
          {
#pragma unroll
            for (int ks = 0; ks < 2; ++ks) { const f32x4 w0 = *(const LAS f32x4*)(WLH + h * 64 + 32 * ks + 8 * fq), w1 = *(const LAS f32x4*)(WLH + h * 64 + 32 * ks + 8 * fq + 4);
#pragma unroll
                for (int nt = 0; nt < 4; ++nt) { float f[8]; unpack8(__builtin_bit_cast(v4u, xa[nt][ks]), f);
#pragma unroll
                    for (int j = 0; j < 4; ++j) { f[j] *= w0[j]; f[4 + j] *= w1[j]; }
                    xa[nt][ks] = __builtin_bit_cast(bf16x8, pack8(f)); } }
            f32x4v acc[4][4];
#pragma unroll
            for (int n4 = 0; n4 < 4; ++n4)
#pragma unroll
                for (int pt = 0; pt < 4; ++pt) acc[n4][pt] = (f32x4v){0.f, 0.f, 0.f, 0.f};
#pragma unroll
            for (int n4 = 0; n4 < 4; ++n4)
#pragma unroll
                for (int ks = 0; ks < 2; ++ks) { const bf16x8 bt = *(const LAS bf16x8*)(BT + (g * 64 + 16 * n4 + fr) * XTS + 32 * ks + 8 * fq);
#pragma unroll
                    for (int pt = 0; pt < 4; ++pt) acc[n4][pt] = __builtin_amdgcn_mfma_f32_16x16x32_bf16(bt, xa[pt][ks], acc[n4][pt], 0, 0, 0); }
#pragma unroll
            for (int n4 = 0; n4 < 4; ++n4)
#pragma unroll
                for (int pt = 0; pt < 4; ++pt) *(v2u*)(ST + (((size_t)u * 8 + h) * 64 + 16 * pt + fr) * 64 + 16 * n4 + 4 * fq) = (v2u){pk2(acc[n4][pt][0], acc[n4][pt][1]), pk2(acc[n4][pt][2], acc[n4][pt][3])};
          }
        }
    }
    __syncthreads();
}
__device__ __forceinline__ void convert_tables(const int lane, const float* pu, const float* pv, const float* w2, unsigned char* ws, int L, int wid, int nw) {
    unsigned char* U8 = ws + WS_U8; unsigned char* V8 = ws + WS_V8; float* USc = (float*)(ws + WS_US); float* VSc = (float*)(ws + WS_VS);
    float w2q[16];
#pragma unroll
    for (int j = 0; j < 4; ++j) { const f32x4 w_ = *(const f32x4*)(w2 + lane * 16 + 4 * j); w2q[4 * j] = w_[0]; w2q[4 * j + 1] = w_[1]; w2q[4 * j + 2] = w_[2]; w2q[4 * j + 3] = w_[3]; }
#pragma unroll 1
    for (int r = wid; r < 2 * 16384; r += nw) {
        const bool isv = r >= 16384; const int rl = isv ? r - 16384 : r; const int rr = L * 16384 + rl; const float* src = (isv ? pv : pu) + (size_t)rr * DM + lane * 16;
        f32x4 v[4]; float am = 0.f;
#pragma unroll
        for (int j = 0; j < 4; ++j) { v[j] = *(const f32x4*)(src + 4 * j);
            if (!isv) { v[j][0] *= w2q[4 * j]; v[j][1] *= w2q[4 * j + 1]; v[j][2] *= w2q[4 * j + 2]; v[j][3] *= w2q[4 * j + 3]; }
            am = fmaxf(am, fmaxf(fmaxf(fabsf(v[j][0]), fabsf(v[j][1])), fmaxf(fabsf(v[j][2]), fabsf(v[j][3])))); }
        am = fmaxf(am, dppf<0xB1>(am)); am = fmaxf(am, dppf<0x4E>(am)); am = fmaxf(am, dppf<0x141>(am)); am = fmaxf(am, dppf<0x128>(am));
        { const auto r16 = __builtin_amdgcn_permlane16_swap(__float_as_uint(am), __float_as_uint(am), false, false); am = fmaxf(__uint_as_float(r16[0]), __uint_as_float(r16[1]));
          const auto r32 = __builtin_amdgcn_permlane32_swap(__float_as_uint(am), __float_as_uint(am), false, false); am = fmaxf(__uint_as_float(r32[0]), __uint_as_float(r32[1])); }
        if (isv) {
            int ex = 0; if (am > 0.f) (void)frexpf(am, &ex); else ex = 8;
            const float sc = ldexpf(1.0f, 8 - ex), isc = ldexpf(1.0f, ex - 8);
            v4u o;
#pragma unroll
            for (int j = 0; j < 4; ++j) { int w = 0; w = __builtin_amdgcn_cvt_pk_fp8_f32(v[j][0] * sc, v[j][1] * sc, w, false); w = __builtin_amdgcn_cvt_pk_fp8_f32(v[j][2] * sc, v[j][3] * sc, w, true); o[j] = (unsigned)w; }
            *(v4u*)(V8 + (size_t)L * 16384 * DM + (size_t)(lane >> 3) * (16384 * 128) + (size_t)rl * 128 + (lane & 7) * 16) = o;
            if (lane == 0) VSc[rr] = isc;
        } else {
            const float sc = am > 0.f ? 7.0f / am : 0.f;
            v2u o;
#pragma unroll
            for (int h = 0; h < 2; ++h) { unsigned w = 0u;
#pragma unroll
                for (int k = 0; k < 8; ++k) w |= ((unsigned)__float2int_rn(v[2 * h + (k >> 2)][k & 3] * sc) & 15u) << (4 * k);
                o[h] = w; }
            *(v2u*)(U8 + (size_t)L * 16384 * DM + (size_t)(lane >> 4) * (16384 * 128) + (size_t)rl * 128 + (lane & 15) * 8) = o;
            if (lane == 0) USc[rr] = am * (1.0f / 7.0f);
        }
    }
}
__device__ __forceinline__ void ssd_scan(const Ctx F, bf16* ST, const float* CD, bool dry) {
    if (F.tid < 128) for (int e = F.vcu * 128 + F.tid; e < BATCH * 16384; e += F.G * 128) {
        const int b = e >> 14, hpn2 = e & 16383, h = hpn2 >> 11; float r0 = 0.f, r1 = 0.f;
        unsigned* sp = (unsigned*)ST + ((size_t)b * NCHUNK << 14) + hpn2; const float* dp = CD + (size_t)b * NCHUNK * 8 + h;
#pragma unroll 1
        for (int c = 0; c < NCHUNK; c += 32) { unsigned s[32]; float d[32];
#pragma unroll
            for (int i = 0; i < 32; ++i) { s[i] = sp[(size_t)(c + i) << 14]; d[i] = dp[(c + i) * 8]; }
#pragma unroll
            for (int i = 0; i < 32; ++i) { if (!dry) sp[(size_t)(c + i) << 14] = pk2(r0, r1); r0 = r0 * d[i] + bflo(s[i]); r1 = r1 * d[i] + bfhi(s[i]); } }
        asm volatile("" :: "v"(r0), "v"(r1));
    }
}
__device__ __forceinline__ void ssd_part2(const Ctx F, const bf16* P, bf16* Y, const bf16* CC, const float* EA, const bf16* ST, const float* nw  , bool dry) {
    LAS float* SSH = (LAS float*)F.lds;
    const int lane = F.lane, fr = lane & 15, fq = lane >> 4, h = F.wave, g = h >> 2;
#pragma unroll 1
    for (int u = F.vcu; u < BATCH * NCHUNK; u += F.G) {
        const int b = u / NCHUNK, c = u % NCHUNK; const size_t r0 = (size_t)b * SEQ + c * 64;
        bf16x8 pa[4][2], cbf[4][2];
#pragma unroll
        for (int pt = 0; pt < 4; ++pt)
#pragma unroll
            for (int ks = 0; ks < 2; ++ks) { pa[pt][ks] = __builtin_bit_cast(bf16x8, *(const v4u*)(ST + (((size_t)u * 8 + h) * 64 + 16 * pt + fr) * 64 + 32 * ks + 8 * fq));
                cbf[pt][ks] = __builtin_bit_cast(bf16x8, *(const v4u*)(CC + (r0 + 16 * pt + fr) * 128 + g * 64 + 32 * ks + 8 * fq)); }
        v2u yv4[4][4], zv4[4][4]; float ea4[4];
#pragma unroll
        for (int lt = 0; lt < 4; ++lt) { const int l = 16 * lt + fr; ea4[lt] = EA[(r0 + l) * 8 + h];
#pragma unroll
            for (int pt = 0; pt < 4; ++pt) { const int p0 = 16 * pt + 4 * fq; yv4[lt][pt] = *(const v2u*)(Y + (r0 + l) * DM + 256 + h * 64 + p0); zv4[lt][pt] = *(const v2u*)(P + (r0 + l) * NP + ZOFF + h * 64 + p0); } }
        f32x4v acc[4][4];
#pragma unroll
        for (int pt = 0; pt < 4; ++pt)
#pragma unroll
            for (int lt = 0; lt < 4; ++lt) { acc[pt][lt] = (f32x4v){0.f, 0.f, 0.f, 0.f};
#pragma unroll
                for (int ks = 0; ks < 2; ++ks) acc[pt][lt] = __builtin_amdgcn_mfma_f32_16x16x32_bf16(pa[pt][ks], cbf[lt][ks], acc[pt][lt], 0, 0, 0); }
        float ssl[4];
#pragma unroll
        for (int lt = 0; lt < 4; ++lt) { const float ea = ea4[lt]; ssl[lt] = 0.f;
#pragma unroll
            for (int pt = 0; pt < 4; ++pt) { const v2u yv = yv4[lt][pt], zv = zv4[lt][pt];
                const float yd[4] = {bflo(yv.x), bfhi(yv.x), bflo(yv.y), bfhi(yv.y)}, zz[4] = {bflo(zv.x), bfhi(zv.x), bflo(zv.y), bfhi(zv.y)};
#pragma unroll
                for (int r = 0; r < 4; ++r) { const float v = (yd[r] + ea * acc[pt][lt][r]) * silu_f(zz[r]); acc[pt][lt][r] = v; ssl[lt] += v * v; } } }
        __syncthreads();
#pragma unroll
        for (int lt = 0; lt < 4; ++lt) { const float s = sum_x32(sum_x16(ssl[lt])); if (fq == 0) SSH[h * 64 + 16 * lt + fr] = s; }
        __syncthreads();
#pragma unroll
        for (int lt = 0; lt < 4; ++lt) { const int l = 16 * lt + fr; float t = 0.f;
#pragma unroll
            for (int hh = 0; hh < 8; ++hh) t += SSH[hh * 64 + l];
            const float rstd = 1.0f / sqrtf(t * (1.0f / 512.0f) + EPS);
#pragma unroll
            for (int pt = 0; pt < 4; ++pt) { const int p0 = 16 * pt + 4 * fq; const f32x4 w4 = *(const f32x4*)(nw + h * 64 + p0);
                const v2u o = (v2u){pk2(acc[pt][lt][0] * rstd * w4[0], acc[pt][lt][1] * rstd * w4[1]), pk2(acc[pt][lt][2] * rstd * w4[2], acc[pt][lt][3] * rstd * w4[3])};
                if (!dry) *(v2u*)(Y + (r0 + l) * DM + 256 + h * 64 + p0) = o; } }
    }
}
constexpr int L7_EI = 0, L7_CF = 16384, L7_PT = L7_CF + 32768, L7_RS = L7_PT + 32768, L7_SSQ = L7_RS + 512, L7_W2 = L7_SSQ + 512, L7_SCL = L7_W2 + 4096, L7_END = L7_SCL + 8 * 9216;
static_assert(L7_END <= LDSCTL_OFF, "PEER LDS");
__device__ __forceinline__ unsigned mk_key(float f, unsigned idx) { const unsigned u = __float_as_uint(f); unsigned k = (u & 0x80000000u) ? ~u : (u | 0x80000000u); return (k & ~127u) | (127u - idx); }
__device__ __forceinline__ float key_val(unsigned k) { const unsigned kk = k & ~127u; return __uint_as_float((kk & 0x80000000u) ? (kk & 0x7fffffffu) : ~kk); }
__device__ __forceinline__ void ce_desc(unsigned& a, unsigned& b) { const unsigned hi = a > b ? a : b; const unsigned lo = a > b ? b : a; a = hi; b = lo; }
__device__ __forceinline__ void bitonic_sort16_desc(unsigned (&v)[16]) {
#pragma unroll
    for (int k = 2; k <= 16; k <<= 1)
#pragma unroll
        for (int j = k >> 1; j > 0; j >>= 1)
#pragma unroll
            for (int i = 0; i < 16; ++i) { const int l = i ^ j; if (l > i) { if ((i & k) == 0) ce_desc(v[i], v[l]); else ce_desc(v[l], v[i]); } }
}
__device__ __forceinline__ void bitonic_merge16_desc(unsigned (&v)[16]) {
#pragma unroll
    for (int j = 8; j > 0; j >>= 1)
#pragma unroll
        for (int i = 0; i < 16; ++i) { const int l = i ^ j; if (l > i) ce_desc(v[i], v[l]); }
}
__device__ __forceinline__ void topk16_slice(const float* sp, unsigned (&lst)[16]) {
    { const f32x4 a = *(const f32x4*)sp, b = *(const f32x4*)(sp + 4), c = *(const f32x4*)(sp + 8), d = *(const f32x4*)(sp + 12);
#pragma unroll
      for (int e = 0; e < 4; ++e) { lst[e] = mk_key(a[e], (unsigned)e); lst[4 + e] = mk_key(b[e], (unsigned)(4 + e)); lst[8 + e] = mk_key(c[e], (unsigned)(8 + e)); lst[12 + e] = mk_key(d[e], (unsigned)(12 + e)); } }
    bitonic_sort16_desc(lst);
#pragma unroll 1
    for (int ch = 1; ch < 8; ++ch) { unsigned cv[16];
        const f32x4 a = *(const f32x4*)(sp + 16 * ch), b = *(const f32x4*)(sp + 16 * ch + 4), c = *(const f32x4*)(sp + 16 * ch + 8), d = *(const f32x4*)(sp + 16 * ch + 12);
#pragma unroll
        for (int e = 0; e < 4; ++e) { cv[e] = mk_key(a[e], (unsigned)(16 * ch + e)); cv[4 + e] = mk_key(b[e], (unsigned)(16 * ch + 4 + e)); cv[8 + e] = mk_key(c[e], (unsigned)(16 * ch + 8 + e)); cv[12 + e] = mk_key(d[e], (unsigned)(16 * ch + 12 + e)); }
        bitonic_sort16_desc(cv);
#pragma unroll
        for (int q = 0; q < 16; ++q) lst[q] = lst[q] > cv[15 - q] ? lst[q] : cv[15 - q];
        bitonic_merge16_desc(lst); }
}
typedef float f32x2 __attribute__((ext_vector_type(2)));
__device__ __forceinline__ void dec16(const v4u q, float (&f)[16]) {
#pragma unroll
    for (int w = 0; w < 4; ++w) { const f32x2 lo = __builtin_amdgcn_cvt_pk_f32_fp8((int)q[w], false), hi = __builtin_amdgcn_cvt_pk_f32_fp8((int)q[w], true);
        f[4 * w] = lo.x; f[4 * w + 1] = lo.y; f[4 * w + 2] = hi.x; f[4 * w + 3] = hi.y; }
}
__device__ __forceinline__ void peer_phase(const Ctx F, const float* SC, const float* SS2, const unsigned char* U8, const unsigned char* V8, const float* US, const float* VS, const float* w2  ,
                                           const bf16* X1B  , unsigned char* HQ  , bf16* XB  , float* RS1  , float* OUT  , const float* fw  , bool last, bool dry, int dry2, const void* ST_CODE = nullptr) {
    LAS unsigned short* EI = (LAS unsigned short*)(F.lds + L7_EI); LAS float* CF = (LAS float*)(F.lds + L7_CF); LAS float* PT = (LAS float*)(F.lds + L7_PT);
    LAS float* RS = (LAS float*)(F.lds + L7_RS); LAS float* SSQ = (LAS float*)(F.lds + L7_SSQ); LAS float* W2L = (LAS float*)(F.lds + L7_W2);
#pragma unroll 1
    for (int tile = F.vcu; tile < M / 128; tile += F.G) {
        int lane_o = F.lane; asm volatile("" : "+v"(lane_o));
        const int g = lane_o >> 3, i = lane_o & 7;
        __syncthreads();
        {
            const int tokl = F.tid >> 2, hh = F.tid & 3; const size_t row = (size_t)tile * 128 + tokl;
            unsigned l0[16], l1[16];
            topk16_slice(SC + row * 1024 + hh * 256, l0); topk16_slice(SC + row * 1024 + hh * 256 + 128, l1);
            float s0[16], s1[16];
#pragma unroll
            for (int j = 0; j < 16; ++j) { s0[j] = key_val(l0[j]); s1[j] = key_val(l1[j]); }
            {
                LAS unsigned* slot = (LAS unsigned*)(PT + tokl * 64 + hh * 16);
#pragma unroll
                for (int j = 0; j < 8; ++j) { slot[j] = (127u - (l0[2 * j] & 127u)) | ((127u - (l0[2 * j + 1] & 127u)) << 16); slot[8 + j] = (127u - (l1[2 * j] & 127u)) | ((127u - (l1[2 * j + 1] & 127u)) << 16); } }
            unsigned best[16];
#define CKEY(i_, j_) ((({ const unsigned u_ = __float_as_uint(s0[i_] + s1[j_]); (u_ & 0x80000000u) ? ~u_ : (u_ | 0x80000000u); }) & ~255u) | (255u - (unsigned)(16 * (i_) + (j_))))
#pragma unroll
            for (int j = 0; j < 16; ++j) best[j] = CKEY(0, j);
#pragma unroll
            for (int ii = 1; ii < 8; ++ii) { constexpr int NR[8] = {16, 8, 5, 4, 3, 2, 2, 2};
#pragma unroll
                for (int j = 0; j < 16; ++j) if (j < NR[ii]) { const unsigned c = CKEY(ii, j); best[15 - j] = best[15 - j] > c ? best[15 - j] : c; }
                bitonic_merge16_desc(best); }
#pragma unroll
            for (int ii = 8; ii < 16; ++ii) { unsigned k = CKEY(ii, 0);
#pragma unroll
                for (int q = 0; q < 16; ++q) { const unsigned hi = best[q] > k ? best[q] : k; k = best[q] > k ? k : best[q]; best[q] = hi; } }
#undef CKEY
            float e[16], bv[16], sum = 0.f;
#pragma unroll
            for (int j = 0; j < 16; ++j) { const unsigned kk = best[j] & ~255u; bv[j] = __uint_as_float((kk & 0x80000000u) ? (kk & 0x7fffffffu) : ~kk); }
#pragma unroll
            for (int j = 0; j < 16; ++j) { e[j] = __expf(bv[j] - bv[0]); sum += e[j]; }
            const float inv = 1.0f / sum;
            { const LAS unsigned short* slot = (const LAS unsigned short*)(PT + tokl * 64 + hh * 16);
#pragma unroll
              for (int j = 0; j < 16; ++j) { const unsigned pos = 255u - (best[j] & 255u); const unsigned ex = (unsigned)slot[pos >> 4] * 128u + (unsigned)slot[16 + (pos & 15u)];
                  EI[tokl * 64 + hh * 16 + j] = (unsigned short)ex; CF[tokl * 64 + hh * 16 + j] = e[j] * inv; } }
        }
        if (F.tid < 256) *(LAS f32x4*)(W2L + 4 * F.tid) = *(const f32x4*)(w2 + 4 * F.tid);
        if (F.lane < 16) { const int tok = F.wave * 16 + F.lane; const f32x4* sp = (const f32x4*)(SS2 + ((size_t)tile * 128 + tok) * 16); const f32x4 a = sp[0], b = sp[1], c = sp[2], d = sp[3];
            const float t = ((a[0] + a[1]) + (a[2] + a[3])) + ((b[0] + b[1]) + (b[2] + b[3])) + ((c[0] + c[1]) + (c[2] + c[3])) + ((d[0] + d[1]) + (d[2] + d[3]));
            RS[tok] = 1.0f / sqrtf(t * (1.0f / DM) + EPS); SSQ[tok] = 0.f; }
        __syncthreads();
        {
#pragma unroll 1
            for (int t4 = 0; t4 < 16; t4 += 4) {
                v4u xr[4][2];
#pragma unroll
                for (int u = 0; u < 4; ++u) { const size_t row = (size_t)tile * 128 + F.wave * 16 + t4 + u; xr[u][0] = *(const v4u*)(X1B + row * DM + lane_o * 16); xr[u][1] = *(const v4u*)(X1B + row * DM + lane_o * 16 + 8); }
#pragma unroll
                for (int u = 0; u < 4; ++u) { const int tok = F.wave * 16 + t4 + u; const size_t row = (size_t)tile * 128 + tok;
                    float hv[16]; { float t8[8]; unpack8(xr[u][0], t8);
#pragma unroll
                        for (int q = 0; q < 8; ++q) hv[q] = t8[q];
                        unpack8(xr[u][1], t8);
#pragma unroll
                        for (int q = 0; q < 8; ++q) hv[8 + q] = t8[q]; }
                    float am = 0.f;
#pragma unroll
                    for (int q = 0; q < 16; ++q) am = fmaxf(am, fabsf(hv[q]));
                    am = fmaxf(am, dppf<0xB1>(am)); am = fmaxf(am, dppf<0x4E>(am)); am = fmaxf(am, dppf<0x141>(am)); am = fmaxf(am, dppf<0x128>(am));
                    { const auto r16 = __builtin_amdgcn_permlane16_swap(__float_as_uint(am), __float_as_uint(am), false, false); am = fmaxf(__uint_as_float(r16[0]), __uint_as_float(r16[1]));
                      const auto r32 = __builtin_amdgcn_permlane32_swap(__float_as_uint(am), __float_as_uint(am), false, false); am = fmaxf(__uint_as_float(r32[0]), __uint_as_float(r32[1])); }
                    const float s1 = am > 0.f ? 119.0f / am : 0.f;
                    v2u hi, lo;
#pragma unroll
                    for (int h = 0; h < 2; ++h) { unsigned hw_ = 0u, lw_ = 0u;
#pragma unroll
                        for (int k = 0; k < 8; ++k) { const int qv = __float2int_rn(hv[8 * h + k] * s1); lw_ |= ((unsigned)qv & 15u) << (4 * k); hw_ |= ((unsigned)((qv + 8) >> 4) & 15u) << (4 * k); }
                        hi[h] = hw_; lo[h] = lw_; }
                    unsigned char* hp = HQ + row * 1024 + (lane_o >> 4) * 256 + ((lane_o & 15) >> 1) * 32 + (lane_o & 1) * 8;
                    *(v2u*)hp = hi; *(v2u*)(hp + 16) = lo;
                    if (lane_o == 0) SSQ[tok] = am * (1.0f / 119.0f);
                }
            }
            asm volatile("s_waitcnt vmcnt(0)" ::: "memory");
        }
#define U_LOAD(it_, Q, X) do { const int s_ = (it_) >> 4, tok_ = F.wave * 16 + ((it_) & 15); \
            _Pragma("unroll") for (int j = 0; j < 8; ++j) { const unsigned e_ = EI[tok_ * 64 + 8 * j + g]; Q[j] = *(const v4u*)(U8 + (size_t)s_ * (16384 * 128) + (size_t)e_ * 128 + 16 * i); } \
            const unsigned char* xp_ = HQ + ((size_t)tile * 128 + tok_) * 1024 + 256 * s_ + 32 * i; \
            X[0] = *(const v4u*)xp_; X[1] = *(const v4u*)(xp_ + 16); } while (0)
#define U_COMP(it_, Q, X) do { const int s_ = (it_) >> 4, tok_ = F.wave * 16 + ((it_) & 15); \
            float d[8]; \
            _Pragma("unroll") for (int j = 0; j < 8; ++j) { int a_ = 0, b_ = 0; \
                _Pragma("unroll") for (int w = 0; w < 4; ++w) { a_ = __builtin_amdgcn_sdot8((int)Q[j][w], (int)X[0][w], a_, false); b_ = __builtin_amdgcn_sdot8((int)Q[j][w], (int)X[1][w], b_, false); } \
                d[j] = (float)(a_ * 16 + b_); } \
            float d2[4], d3[2]; \
            _Pragma("unroll") for (int m = 0; m < 4; ++m) { const float snd = (i & 4) ? d[m] : d[4 + m]; const float kp = (i & 4) ? d[4 + m] : d[m]; d2[m] = kp + dppf<0x141>(snd); }     \
            _Pragma("unroll") for (int m = 0; m < 2; ++m) { const float snd = (i & 2) ? d2[m] : d2[2 + m]; const float kp = (i & 2) ? d2[2 + m] : d2[m]; d3[m] = kp + dppf<0x4E>(snd); } \
            const float snd = (i & 1) ? d3[0] : d3[1]; const float kp = (i & 1) ? d3[1] : d3[0]; const float tot = kp + dppf<0xB1>(snd); \
            const int pi = tok_ * 64 + 8 * i + g; PT[pi] = (s_ == 0) ? tot : PT[pi] + tot; } while (0)
        {
            v4u qa[8], qb[8]; v4u xa[2], xb[2];
            U_LOAD(0, qa, xa);
#pragma unroll 1
            for (int it = 0; it < 64; it += 2) {
                U_LOAD(it + 1, qb, xb);
                U_COMP(it, qa, xa);
                { const int itn = (it + 2 < 64) ? it + 2 : 63; U_LOAD(itn, qa, xa); }
                U_COMP(it + 1, qb, xb);
            }
        }
#undef U_LOAD
#undef U_COMP
#pragma unroll 1
        for (int n = 0; n < 16; ++n) { const int idx = (F.wave * 16 + n) * 64 + F.lane; const unsigned e = EI[idx]; const float dd = PT[idx] * US[e] * (RS[F.wave * 16 + n] * SSQ[F.wave * 16 + n]);
            CF[idx] = CF[idx] * (0.5f * dd * (1.0f + erff(dd * 0.70710678118654752f))) * VS[e]; }
#define V_LOAD(it_, Q, X) do { const int s_ = (it_) >> 4, tok_ = F.wave * 16 + ((it_) & 15); \
            _Pragma("unroll") for (int j = 0; j < 8; ++j) { const unsigned e_ = EI[tok_ * 64 + 8 * j + g]; Q[j] = *(const v4u*)(V8 + (size_t)s_ * (16384 * 128) + (size_t)e_ * 128 + 16 * i); } \
            X = *(const unsigned*)(X1B + ((size_t)tile * 128 + tok_) * DM + 128 * s_ + vd); } while (0)
#define V_COMP(it_, Q, X) do { const int s_ = (it_) >> 4, tok_ = F.wave * 16 + ((it_) & 15); float o[16]; \
            _Pragma("unroll") for (int m = 0; m < 16; ++m) o[m] = 0.f; \
            _Pragma("unroll") for (int j = 0; j < 8; ++j) { const float cf_ = CF[tok_ * 64 + 8 * j + g]; float f[16]; dec16(Q[j], f); \
                _Pragma("unroll") for (int m = 0; m < 16; ++m) o[m] += cf_ * f[m]; } \
            float o2[8], o3[4], o4[2]; \
            _Pragma("unroll") for (int m = 0; m < 8; ++m) { const auto rr_ = __builtin_amdgcn_permlane32_swap(__float_as_uint(o[8 + m]), __float_as_uint(o[m]), false, false); o2[m] = __uint_as_float(rr_[0]) + __uint_as_float(rr_[1]); }     \
            _Pragma("unroll") for (int m = 0; m < 4; ++m) { const auto rr_ = __builtin_amdgcn_permlane16_swap(__float_as_uint(o2[4 + m]), __float_as_uint(o2[m]), false, false); o3[m] = __uint_as_float(rr_[0]) + __uint_as_float(rr_[1]); }     \
            _Pragma("unroll") for (int m = 0; m < 2; ++m) { const float snd = (g & 1) ? o3[m] : o3[2 + m]; const float kp = (g & 1) ? o3[2 + m] : o3[m]; o4[m] = kp + dppf<0x128>(snd); } \
            const float y0 = bflo(X) + o4[0], y1 = bfhi(X) + o4[1]; \
            if (!dry) *(unsigned*)(XB + ((size_t)tile * 128 + tok_) * DM + 128 * s_ + vd) = pk2(y0, y1); \
            } while (0)
#pragma unroll 1
        for (int repv = 0; repv < ((dry2 >> 2) & 1) + 1; ++repv)
        {
            const int vd = 16 * i + 8 * (1 - ((g >> 2) & 1)) + 4 * (1 - ((g >> 1) & 1)) + 2 * (g & 1);
            v4u qa[8], qb[8]; unsigned xa, xb;
            V_LOAD(0, qa, xa);
#pragma unroll 1
            for (int it = 0; it < 128; it += 2) {
                V_LOAD(it + 1, qb, xb);
                V_COMP(it, qa, xa);
                { const int itn = (it + 2 < 128) ? it + 2 : 127; V_LOAD(itn, qa, xa); }
                V_COMP(it + 1, qb, xb);
            }
        }
#undef V_LOAD
#undef V_COMP
        asm volatile("s_waitcnt vmcnt(0)" ::: "memory");
        __builtin_amdgcn_fence(__ATOMIC_ACQUIRE, "agent");
        asm volatile("s_waitcnt vmcnt(0)" ::: "memory");
#pragma unroll 1
        for (int ti = 0; ti < 16; ++ti) {
            const int tok = F.wave * 16 + ti; const size_t row = (size_t)tile * 128 + tok;
            float f0[8], f1[8]; unpack8(*(const v4u*)(XB + row * DM + F.lane * 8), f0); unpack8(*(const v4u*)(XB + row * DM + 512 + F.lane * 8), f1);
            float sq = 0.f;
#pragma unroll
            for (int q = 0; q < 8; ++q) sq += f0[q] * f0[q] + f1[q] * f1[q];
            float rstd = 1.0f / sqrtf(wave_sum_v(sq) * (1.0f / DM) + EPS);
#if defined(SELFTEST)
            rstd *= 1.0f + 0.2f * (float)__hip_atomic_load((const unsigned*)ST_CODE, __ATOMIC_RELAXED, __HIP_MEMORY_SCOPE_AGENT);
#endif
            if (!last) { if (F.lane == 0 && !dry) RS1[row] = rstd; }
            else if (!dry) {
                const f32x4 c0 = *(const f32x4*)(fw + F.lane * 8), d0 = *(const f32x4*)(fw + F.lane * 8 + 4), c1 = *(const f32x4*)(fw + 512 + F.lane * 8), d1 = *(const f32x4*)(fw + 512 + F.lane * 8 + 4);
                *(f32x4*)(OUT + row * DM + F.lane * 8) = (f32x4){f0[0] * rstd * c0[0], f0[1] * rstd * c0[1], f0[2] * rstd * c0[2], f0[3] * rstd * c0[3]};
                *(f32x4*)(OUT + row * DM + F.lane * 8 + 4) = (f32x4){f0[4] * rstd * d0[0], f0[5] * rstd * d0[1], f0[6] * rstd * d0[2], f0[7] * rstd * d0[3]};
                *(f32x4*)(OUT + row * DM + 512 + F.lane * 8) = (f32x4){f1[0] * rstd * c1[0], f1[1] * rstd * c1[1], f1[2] * rstd * c1[2], f1[3] * rstd * c1[3]};
                *(f32x4*)(OUT + row * DM + 512 + F.lane * 8 + 4) = (f32x4){f1[4] * rstd * d1[0], f1[5] * rstd * d1[1], f1[6] * rstd * d1[2], f1[7] * rstd * d1[3]};
            }
        }
    }
}


#if defined(SELFTEST)
__device__ __forceinline__ float st_a(int r, int k) { return (float)(((r * 3 + k) % 5) - 2); }
__device__ __forceinline__ float st_b(int k, int c) { return (float)(((k + 2 * c) % 7) - 3); }
__device__ __forceinline__ void selftest(const Ctx F, gu32* ctl) {
    if (blockIdx.x != 0 || F.wave != 0) return;
    const int lane = F.lane, fr = lane & 15, fq = lane >> 4;
    int aw[2] = {0, 0}, bw[2] = {0, 0};
#pragma unroll
    for (int w = 0; w < 2; ++w) { aw[w] = __builtin_amdgcn_cvt_pk_fp8_f32(st_a(fr, 8 * fq + 4 * w), st_a(fr, 8 * fq + 4 * w + 1), aw[w], false); aw[w] = __builtin_amdgcn_cvt_pk_fp8_f32(st_a(fr, 8 * fq + 4 * w + 2), st_a(fr, 8 * fq + 4 * w + 3), aw[w], true);
                                  bw[w] = __builtin_amdgcn_cvt_pk_fp8_f32(st_b(8 * fq + 4 * w, fr), st_b(8 * fq + 4 * w + 1, fr), bw[w], false); bw[w] = __builtin_amdgcn_cvt_pk_fp8_f32(st_b(8 * fq + 4 * w + 2, fr), st_b(8 * fq + 4 * w + 3, fr), bw[w], true); }
    const long A = (long)(((unsigned long long)(unsigned)aw[1] << 32) | (unsigned)aw[0]), B = (long)(((unsigned long long)(unsigned)bw[1] << 32) | (unsigned)bw[0]);
    f32x4 d = (f32x4){0.f, 0.f, 0.f, 0.f};
    d = __builtin_amdgcn_mfma_f32_16x16x32_fp8_fp8(A, B, d, 0, 0, 0);
    bool ok1 = true;
#pragma unroll
    for (int r = 0; r < 4; ++r) { float e = 0.f; for (int kk = 0; kk < 32; ++kk) e += st_a(4 * fq + r, kk) * st_b(kk, fr); ok1 = ok1 && (d[r] == e); }
    const int t1 = __all(ok1) ? 1 : 0;
    LAS unsigned char* T = F.lds;
    for (int c4 = 0; c4 < 32; ++c4) { unsigned w = 0; for (int b = 0; b < 4; ++b) w |= (unsigned)((37 * lane + 11 * (4 * c4 + b)) & 127) << (8 * b); *(LAS unsigned*)(T + lane * 128 + 4 * c4) = w; }
    asm volatile("s_waitcnt lgkmcnt(0)" ::: "memory");
    int t2 = 0;
#pragma unroll
    for (int hyp = 1; hyp <= 2; ++hyp) {
        const int l16 = lane & 15; const int row = (hyp == 1) ? (l16 >> 1) : (l16 & 7), cc = (hyp == 1) ? 8 * (l16 & 1) : 8 * (l16 >> 3);
        const v2i_t v = __builtin_amdgcn_ds_read_tr8_b64_v2i32((LAS v2i_t*)(T + (8 * fq + row) * 128 + 16 + cc));
        bool ok = true;
#pragma unroll
        for (int j = 0; j < 8; ++j) { const unsigned got = ((unsigned)(j < 4 ? v.x : v.y) >> (8 * (j & 3))) & 255u; ok = ok && (got == (unsigned)((37 * (8 * fq + j) + 11 * (16 + l16)) & 127)); }
        if (__all(ok)) t2 = hyp;
    }
    if (lane == 0) __hip_atomic_store(ctl + 20, (unsigned)(t1 + 2 * t2 + 1), RLX_AGENT);
    asm volatile("s_waitcnt vmcnt(0) lgkmcnt(0)" ::: "memory");
}
#endif
__device__ __forceinline__ Ctx fresh(const Ctx F) { Ctx R = F; int t = F.tid, v = F.vcu, g = F.G; asm volatile("" : "+v"(t)); asm volatile("" : "+s"(v), "+s"(g)); R.tid = t; R.lane = t & 63; R.wave = __builtin_amdgcn_readfirstlane(t >> 6); R.vcu = v; R.G = g; return R; }
struct Args { const float* in[17]; float* out; unsigned char* ws; int ph_lo, ph_hi, li, pad; };
__global__ void __launch_bounds__(NWAVES * 64, 2) mega_fwd(Args args) {
    extern __shared__ __attribute__((aligned(16))) unsigned char lds[];
    Ctx F;
    F.lds = (LAS unsigned char*)lds;
    F.tid = threadIdx.x; F.lane = F.tid & 63; F.wave = __builtin_amdgcn_readfirstlane(F.tid >> 6);
    F.G = gridDim.x; { const int bx = blockIdx.x; F.vcu = (F.G % 8 == 0) ? (bx % 8) * (F.G / 8) + bx / 8 : bx; }
    unsigned char* ws = args.ws;
    gu32* ctl = (gu32*)(ws + WS_CTL);
    volatile LAS unsigned* MISC = (volatile LAS unsigned*)(F.lds + MISC_OFF);
    for (int u = F.tid; u < (LDS_BYTES - LDSCTL_OFF) / 4; u += NWAVES * 64) ((LAS unsigned*)(F.lds + LDSCTL_OFF))[u] = 0u;
    __syncthreads();
    XcdBarrier bar; bar.bar = (unsigned*)(ctl + CW_BAR); bar.x = 0; bar.st = nullptr;
    if (N_LAUNCHES != NPH) bar = xcd_barrier_post((unsigned*)(ctl + CW_BAR), MISC + 8);
    const int lo = args.ph_lo, hi = args.ph_hi;
#define IN(k) (lo <= (k) && (k) < hi)
#ifndef PH_MASK
#define PH_MASK 0x3ff
#endif
#define PHK(i) ((PH_MASK >> (i)) & 1)
#ifndef DUP_KIND
#define DUP_KIND (-1)
#endif
#define DUPK(i) (DUP_KIND == (i))
    const bool dry = (args.pad == 0);
#define SEAM(k) do { if (N_LAUNCHES != NPH) { if (IN(k) && IN((k) + 1)) xcd_barrier(bar); } } while (0)
    const float* x_in = args.in[0]; float* OUT = args.out;
    bf16* XNY = (bf16*)(ws + WS_XNY); bf16* XB = (bf16*)(ws + WS_XB); float* RS1 = (float*)(ws + WS_RS1); bf16* PB = (bf16*)(ws + WS_P); float* SC = (float*)(ws + WS_SC); bf16* X1B = (bf16*)(ws + WS_X1B);
    float* SS2 = (float*)(ws + WS_SS2); float* EA = (float*)(ws + WS_EA); float* CD = (float*)(ws + WS_CD); bf16* CC = (bf16*)(ws + WS_CC); bf16* ST = (bf16*)(ws + WS_ST);
#if defined(SELFTEST)
    if (IN(0)) { selftest(fresh(F), ctl); __syncthreads(); }
#endif
    if (DUPK(0) && IN(0)) p0_prologue(fresh(F), x_in, args.in[1], args.in[2], args.in[10], args.in[11], args.in[12], args.in[13], ws);
    if (PHK(0) && IN(0)) p0_prologue(fresh(F), x_in, args.in[1], args.in[2], args.in[10], args.in[11], args.in[12], args.in[13], ws);
    SEAM(0);
    if (DUPK(15) && N_LAUNCHES != NPH) { for (int r = 0; r < 10; ++r) xcd_barrier(bar); }
#pragma unroll
    for (int L = 0; L < DEPTH; ++L) {
        const int pb = 1 + 7 * L;
#pragma unroll 1
        for (int rep = 0; rep < ((DUPK(1) && L == 0) ? 2 : 1); ++rep)
        if (PHK(1) && IN(pb)) {
            pg8::Gemm g{XB, (const bf16*)(ws + WS_WIN) + (size_t)L * NP * DM, M, NP, DM}; pg8::StaticOrder S; S.init(M, NP, F.G, (int)blockIdx.x);
            pg8::EpiBf16Row E{PB, NP, RS1};
            pg8::gemm_phase<pg8::EpiBf16Row, pg8::StaticOrder, PG8_ALIGN, PG8_SP2>(F.lds, g, S, E);
        }
        SEAM(pb);
        if (IN(pb + 1)) {
            if (DUPK(2) && L == 0) ssd_part1(fresh(F), PB, XNY, args.in[3] + (size_t)L * 4 * 768, args.in[4] + L * 768, args.in[5] + L * 8, args.in[6] + L * 8, args.in[7] + L * 8, CC, EA, CD, ST);
            if (PHK(2)) ssd_part1(fresh(F), PB, XNY, args.in[3] + (size_t)L * 4 * 768, args.in[4] + L * 768, args.in[5] + L * 8, args.in[6] + L * 8, args.in[7] + L * 8, CC, EA, CD, ST);
            if (DUPK(3) && L == 0) attn_mfma(fresh(F), PB, XNY);
            if (PHK(3)) attn_mfma(fresh(F), PB, XNY);
            if (DUPK(4) && L == 0) shortconv(fresh(F), PB, XNY, args.in[9] + (size_t)L * 3 * 256);
            if (PHK(4)) shortconv(fresh(F), PB, XNY, args.in[9] + (size_t)L * 3 * 256);
        }
        SEAM(pb + 1);
        if (DUPK(5) && L == 0 && IN(pb + 2)) ssd_scan(fresh(F), ST, CD, dry);
        if (PHK(5) && IN(pb + 2)) { const Ctx Fs = fresh(F); ssd_scan(Fs, ST, CD, false); if (Fs.wave >= 2) convert_tables(Fs.lane, args.in[14], args.in[15], args.in[11] + L * DM, ws, L, Fs.vcu * 6 + (Fs.wave - 2), Fs.G * 6); }
        SEAM(pb + 2);
        if (DUPK(6) && L == 0 && IN(pb + 3)) ssd_part2(fresh(F), PB, XNY, CC, EA, ST, args.in[8] + L * 512, dry);
        if (PHK(6) && IN(pb + 3)) ssd_part2(fresh(F), PB, XNY, CC, EA, ST, args.in[8] + L * 512, false);
        SEAM(pb + 3);
#pragma unroll 1
        for (int rep = 0; rep < ((DUPK(7) && L == 0) ? 2 : 1); ++rep)
        if (PHK(7) && IN(pb + 4)) {
            pg8::Gemm g{XNY, (const bf16*)(ws + WS_WOUT) + (size_t)L * DM * DM, M, DM, DM}; pg8::StaticOrder S; S.init(M, DM, F.G, (int)blockIdx.x);
            pg8::EpiResidB E{XB, X1B, SS2};
            pg8::gemm_phase<pg8::EpiResidB, pg8::StaticOrder, PG8_ALIGN, PG8_SP2>(F.lds, g, S, E);
        }
        SEAM(pb + 4);
#pragma unroll 1
        for (int rep = 0; rep < ((DUPK(8) && L == 0) ? 2 : 1); ++rep)
        if (PHK(8) && IN(pb + 5)) {
            pg8::Gemm g{X1B, (const bf16*)(ws + WS_WS) + (size_t)L * DM * DM, M, DM, DM}; pg8::StaticOrder S; S.init(M, DM, F.G, (int)blockIdx.x);
            pg8::EpiScore E{SC, SS2, EPS};
            pg8::gemm_phase<pg8::EpiScore, pg8::StaticOrder, PG8_ALIGN, PG8_SP2>(F.lds, g, S, E);
        }
        SEAM(pb + 5);
        if (DUPK(9) && L == 0 && IN(pb + 6)) peer_phase(fresh(F), SC, SS2, ws + WS_U8 + (size_t)L * 16384 * DM, ws + WS_V8 + (size_t)L * 16384 * DM, (const float*)(ws + WS_US) + L * 16384, (const float*)(ws + WS_VS) + L * 16384, args.in[11] + L * DM, X1B, ws + WS_ST, XB, RS1, OUT, args.in[16], L == DEPTH - 1, dry, 0);
        if (PHK(9) && IN(pb + 6)) peer_phase(fresh(F), SC, SS2, ws + WS_U8 + (size_t)L * 16384 * DM, ws + WS_V8 + (size_t)L * 16384 * DM, (const float*)(ws + WS_US) + L * 16384, (const float*)(ws + WS_VS) + L * 16384, args.in[11] + L * DM, X1B, ws + WS_ST, XB, RS1, OUT, args.in[16], L == DEPTH - 1, false, (L == 0 && dry) ? (DUPK(10) ? 1 : DUPK(11) ? 2 : DUPK(12) ? 4 : DUPK(13) ? 10 : DUPK(14) ? 17 : 0) : 0, (const void*)(ctl + 20));
        SEAM(pb + 6);
    }
#undef IN
#undef SEAM
}

extern "C" void kernel_launch(void* const* d_in, const int* in_sizes, int n_in, void* d_out, int out_size, void* d_ws, size_t ws_size, hipStream_t stream) {
    static int grid = 0;
    if (grid == 0) {
        if (n_in != 17 || in_sizes[0] != M * DM || out_size != M * DM || ws_size < WS_END) { fprintf(stderr, "kernel_launch: unexpected shapes (n_in %d, in0 %d, out %d, ws %zu); nothing launched\n", n_in, n_in > 0 ? in_sizes[0] : -1, out_size, ws_size); grid = -1; return; }
        int dev = 0, cus = 0, per_cu = 0;
        if (hipGetDevice(&dev) != hipSuccess || hipDeviceGetAttribute(&cus, hipDeviceAttributeMultiprocessorCount, dev) != hipSuccess) { fprintf(stderr, "kernel_launch: device query failed\n"); grid = -1; return; }
        if (hipFuncSetAttribute((const void*)mega_fwd, hipFuncAttributeMaxDynamicSharedMemorySize, LDS_BYTES) != hipSuccess) { fprintf(stderr, "kernel_launch: hipFuncSetAttribute failed\n"); grid = -1; return; }
        if (hipOccupancyMaxActiveBlocksPerMultiprocessor(&per_cu, (const void*)mega_fwd, NWAVES * 64, LDS_BYTES) != hipSuccess || per_cu < 1) { fprintf(stderr, "kernel_launch: the occupancy query reports %d resident workgroups per CU for %d threads + %d B of LDS; nothing launched\n", per_cu, NWAVES * 64, LDS_BYTES); (void)hipGetLastError(); grid = -1; return; }
        (void)hipGetLastError();
        grid = cus;
    }
    if (grid < 0) return;
    if (hipMemsetAsync((char*)d_ws + WS_CTL, 0, CTL_ZERO_BYTES, stream) != hipSuccess) { fprintf(stderr, "kernel_launch: memset failed\n"); return; }
    Args a{};
    for (int i = 0; i < 17; ++i) a.in[i] = (const float*)d_in[i];
    a.out = (float*)d_out; a.ws = (unsigned char*)d_ws;
    for (int li = 0; li < N_LAUNCHES; ++li) {
        a.ph_lo = (N_LAUNCHES == NPH) ? li : 0; a.ph_hi = (N_LAUNCHES == NPH) ? li + 1 : NPH; a.li = li;
        hipLaunchKernelGGL(mega_fwd, dim3(grid), dim3(NWAVES * 64), LDS_BYTES, stream, a);
        const hipError_t le = hipPeekAtLastError();
        if (le != hipSuccess) { fprintf(stderr, "kernel_launch: launch %d failed: %s\n", li, hipGetErrorName(le)); break; }
    }
}
```

```cpp
#define MK_N_LAUNCHES 1
#include <hip/hip_runtime.h>
#include <cstdio>
#include <cstdint>
#include <cmath>
namespace pg8 {
#define PG8_LAS __attribute__((address_space(3)))
typedef unsigned short bf16_t;
typedef short bf16x8 __attribute__((ext_vector_type(8)));
typedef float f32x4 __attribute__((ext_vector_type(4)));
typedef unsigned u32x4 __attribute__((ext_vector_type(4)));
constexpr int BM = 256, BK = 64, HALF = 128, HTB = HALF * BK * 2  , STAGE_BYTES = 8 * HTB, NXCD = 8, WGM = 8;

__host__ __device__ __forceinline__ int lds_byte(int r, int c) { const int st = (r >> 4) * 2 + (c >> 5), rr = r & 15, cc = c & 31, ob = rr * 64 + cc * 2; return st * 1024 + (ob ^ (((ob >> 9) & 1) << 5)); }
__host__ __device__ __forceinline__ void stage_rc(int b, int& R, int& C) { const int st = b / 1024, sb = b % 1024, swz = sb ^ (((sb >> 9) & 1) << 5); R = (st >> 1) * 16 + swz / 64; C = (st & 1) * 32 + (swz % 64) / 2; }
__host__ __device__ __forceinline__ int perm32(int rho) { const int n = rho >> 4, i = rho & 15; return 8 * (i >> 2) + 4 * n + (i & 3); }

struct Unit { int pm, pn; };
struct Gemm { const bf16_t* A; const bf16_t* Bt; int M, N, K; };

struct StaticOrder {
    int nM, nN, nwg, G, c;
    __host__ __device__ void init(int M, int N, int G_, int c_) { nM = M / BM; nN = N / BM; nwg = nM * nN; G = G_; c = c_; }
    __host__ __device__ bool next(int i, Unit& u) const {
        const long L = (long)i * G + c; if (L >= nwg) return false;
        int wgid = (int)L; { const int q = nwg / NXCD, r = nwg % NXCD, xcd = wgid % NXCD, off = wgid / NXCD; wgid = (xcd < r ? xcd * (q + 1) : r * (q + 1) + (xcd - r) * q) + off; }
        const int nig = WGM * nN, gid = wgid / nig, fm = gid * WGM, gsz = (nM - fm) < WGM ? (nM - fm) : WGM;
        u.pm = fm + ((wgid % nig) % gsz); u.pn = (wgid % nig) / gsz; return true;
    }
    __device__ __forceinline__ void a_ready(const Unit&) const {}
    __device__ __forceinline__ void done(const Unit&) const {}
};

__device__ __forceinline__ unsigned cvt_pk_bf16(float lo, float hi) { unsigned r; asm volatile("v_cvt_pk_bf16_f32 %0, %1, %2" : "=v"(r) : "v"(lo), "v"(hi)); return r; }
typedef float f32x2 __attribute__((ext_vector_type(2)));
__device__ __forceinline__ f32x2 gelu_pk(f32x2 v) {
    const f32x2 av = __builtin_elementwise_abs(v), d = av * 0.2316418882f + 1.0f;
    f32x2 t; t.x = __builtin_amdgcn_rcpf(d.x); t.y = __builtin_amdgcn_rcpf(d.y);
    f32x2 q = t * 0.5307027145f + (-0.7265760135f); q = q * t + 0.7107068705f; q = q * t + (-0.142248368f); q = q * t + 0.127414796f; q = q * t;
    const f32x2 s = (v * v) * (-0.72134752044f);
    f32x2 e; e.x = __builtin_amdgcn_exp2f(s.x); e.y = __builtin_amdgcn_exp2f(s.y);
    const f32x2 m = v * (q * e), r = v - m;
    f32x2 o; o.x = v.x < 0.f ? m.x : r.x; o.y = v.y < 0.f ? m.y : r.y; return o;
}

template <int ACT  > struct EpiBf16 {
    static constexpr bool PERM = true, AFTER_DRAIN = false; static_assert(ACT == 0 || ACT == 1, "EpiBf16: ACT is 0 (none) or 1 (gelu_pk)");
    bf16_t* O; int ldc; const float* bias; int split_cols; size_t split_stride; float scale0;
    __device__ __forceinline__ void operator()(const f32x4 (&acc)[2][2][4][2], const Unit& u, int wr, int wc, int fr, int fq) const {
        const int row0 = u.pm * BM + wr * 64 + fr; int colt = u.pn * BM; bf16_t* base = O;
        float sc = 1.f; if (split_cols) { const int t = colt / split_cols; base += (size_t)t * split_stride; colt -= t * split_cols; if (t == 0) sc = scale0; }
        const int col0 = colt + wc * 32 + 8 * fq, bcol0 = u.pn * BM + wc * 32 + 8 * fq;
        f32x4 bv[2][2];
#pragma unroll
        for (int bj = 0; bj < 2; ++bj)
#pragma unroll
            for (int n = 0; n < 2; ++n) bv[bj][n] = bias ? *(const f32x4*)(bias + bcol0 + bj * HALF + 4 * n) : (f32x4){0.f, 0.f, 0.f, 0.f};
#pragma unroll
        for (int ai = 0; ai < 2; ++ai)
#pragma unroll
            for (int m = 0; m < 4; ++m) { bf16_t* rowp = base + (size_t)(row0 + ai * HALF + m * 16) * ldc + col0;
#pragma unroll
                for (int bj = 0; bj < 2; ++bj) { f32x4 v0 = acc[ai][bj][m][0] + bv[bj][0], v1 = acc[ai][bj][m][1] + bv[bj][1];
                    if (ACT == 1) { f32x2 a = gelu_pk((f32x2){v0[0], v0[1]}), b = gelu_pk((f32x2){v0[2], v0[3]}), c = gelu_pk((f32x2){v1[0], v1[1]}), d = gelu_pk((f32x2){v1[2], v1[3]});
                        v0 = (f32x4){a.x, a.y, b.x, b.y}; v1 = (f32x4){c.x, c.y, d.x, d.y}; }
                    v0 = v0 * sc; v1 = v1 * sc; u32x4 w; w.x = cvt_pk_bf16(v0[0], v0[1]); w.y = cvt_pk_bf16(v0[2], v0[3]); w.z = cvt_pk_bf16(v1[0], v1[1]); w.w = cvt_pk_bf16(v1[2], v1[3]);
                    *(u32x4*)(rowp + bj * HALF) = w; } }
    }
};
struct EpiResid {
    static constexpr bool PERM = true, AFTER_DRAIN = false;
    const float* resid; float* out; bf16_t* xb; float* ss;
    __device__ __forceinline__ void operator()(const f32x4 (&acc)[2][2][4][2], const Unit& u, int wr, int wc, int fr, int fq) const {
        const int row0 = u.pm * BM + wr * 64 + fr; const int col0 = u.pn * BM + wc * 32 + 8 * fq;
#pragma unroll
        for (int ai = 0; ai < 2; ++ai)
#pragma unroll
            for (int m = 0; m < 4; ++m) { const int row = row0 + ai * HALF + m * 16; const size_t off = (size_t)row * 1024 + col0; float s = 0.f;
#pragma unroll
                for (int bj = 0; bj < 2; ++bj) { const float* rp = resid + off + bj * HALF; const f32x4 r0 = *(const f32x4*)rp, r1 = *(const f32x4*)(rp + 4);
                    const f32x4 v0 = acc[ai][bj][m][0] + r0, v1 = acc[ai][bj][m][1] + r1;
                    *(f32x4*)(out + off + bj * HALF) = v0; *(f32x4*)(out + off + bj * HALF + 4) = v1;
                    u32x4 w; w.x = cvt_pk_bf16(v0[0], v0[1]); w.y = cvt_pk_bf16(v0[2], v0[3]); w.z = cvt_pk_bf16(v1[0], v1[1]); w.w = cvt_pk_bf16(v1[2], v1[3]);
                    *(u32x4*)(xb + off + bj * HALF) = w;
                    s += (v0[0] * v0[0] + v0[1] * v0[1]) + (v0[2] * v0[2] + v0[3] * v0[3]) + (v1[0] * v1[0] + v1[1] * v1[1]) + (v1[2] * v1[2] + v1[3] * v1[3]); }
                { const auto r16_ = __builtin_amdgcn_permlane16_swap(__float_as_uint(s), __float_as_uint(s), false, false); s = __uint_as_float(r16_[0]) + __uint_as_float(r16_[1]); const auto r32_ = __builtin_amdgcn_permlane32_swap(__float_as_uint(s), __float_as_uint(s), false, false); s = __uint_as_float(r32_[0]) + __uint_as_float(r32_[1]); }
                if (fq == 0) ss[(size_t)row * 16 + u.pn * 4 + wc] = s; }
    }
};
struct EpiScore {
    static constexpr bool PERM = true, AFTER_DRAIN = false;
    float* out; const float* ss; float eps;
    __device__ __forceinline__ void operator()(const f32x4 (&acc)[2][2][4][2], const Unit& u, int wr, int wc, int fr, int fq) const {
        const int row0 = u.pm * BM + wr * 64 + fr; const int col0 = u.pn * BM + wc * 32 + 8 * fq;
#pragma unroll
        for (int ai = 0; ai < 2; ++ai)
#pragma unroll
            for (int m = 0; m < 4; ++m) { const int row = row0 + ai * HALF + m * 16; const size_t off = (size_t)row * 1024 + col0;
                const f32x4* sp = (const f32x4*)(ss + (size_t)row * 16); const f32x4 a = sp[0], b = sp[1], c = sp[2], d = sp[3];
                const float t = ((a[0] + a[1]) + (a[2] + a[3])) + ((b[0] + b[1]) + (b[2] + b[3])) + ((c[0] + c[1]) + (c[2] + c[3])) + ((d[0] + d[1]) + (d[2] + d[3]));
                const float rstd = 1.0f / sqrtf(t * (1.0f / 1024.0f) + eps);
#pragma unroll
                for (int bj = 0; bj < 2; ++bj) { *(f32x4*)(out + off + bj * HALF) = acc[ai][bj][m][0] * rstd; *(f32x4*)(out + off + bj * HALF + 4) = acc[ai][bj][m][1] * rstd; } }
    }
};

struct EpiBf16Row {
    static constexpr bool PERM = true, AFTER_DRAIN = false;
    bf16_t* O; int ldc; const float* rs;
    __device__ __forceinline__ void operator()(const f32x4 (&acc)[2][2][4][2], const Unit& u, int wr, int wc, int fr, int fq) const {
        const int row0 = u.pm * BM + wr * 64 + fr; const int col0 = u.pn * BM + wc * 32 + 8 * fq;
#pragma unroll
        for (int ai = 0; ai < 2; ++ai)
#pragma unroll
            for (int m = 0; m < 4; ++m) { const int row = row0 + ai * HALF + m * 16; const float sc = rs[row]; bf16_t* rowp = O + (size_t)row * ldc + col0;
#pragma unroll
                for (int bj = 0; bj < 2; ++bj) { const f32x4 v0 = acc[ai][bj][m][0] * sc, v1 = acc[ai][bj][m][1] * sc;
                    u32x4 w; w.x = cvt_pk_bf16(v0[0], v0[1]); w.y = cvt_pk_bf16(v0[2], v0[3]); w.z = cvt_pk_bf16(v1[0], v1[1]); w.w = cvt_pk_bf16(v1[2], v1[3]);
                    *(u32x4*)(rowp + bj * HALF) = w; } }
    }
};
struct EpiResidB {
    static constexpr bool PERM = true, AFTER_DRAIN = false;
    const bf16_t* resid; bf16_t* xb; float* ss;
    __device__ __forceinline__ void operator()(const f32x4 (&acc)[2][2][4][2], const Unit& u, int wr, int wc, int fr, int fq) const {
        const int row0 = u.pm * BM + wr * 64 + fr; const int col0 = u.pn * BM + wc * 32 + 8 * fq;
#pragma unroll
        for (int ai = 0; ai < 2; ++ai)
#pragma unroll
            for (int m = 0; m < 4; ++m) { const int row = row0 + ai * HALF + m * 16; const size_t off = (size_t)row * 1024 + col0; float s = 0.f;
#pragma unroll
                for (int bj = 0; bj < 2; ++bj) { const u32x4 r = *(const u32x4*)(resid + off + bj * HALF);
                    const f32x4 r0 = (f32x4){__uint_as_float(r.x << 16), __uint_as_float(r.x & 0xffff0000u), __uint_as_float(r.y << 16), __uint_as_float(r.y & 0xffff0000u)};
                    const f32x4 r1 = (f32x4){__uint_as_float(r.z << 16), __uint_as_float(r.z & 0xffff0000u), __uint_as_float(r.w << 16), __uint_as_float(r.w & 0xffff0000u)};
                    const f32x4 v0 = acc[ai][bj][m][0] + r0, v1 = acc[ai][bj][m][1] + r1;
                    u32x4 w; w.x = cvt_pk_bf16(v0[0], v0[1]); w.y = cvt_pk_bf16(v0[2], v0[3]); w.z = cvt_pk_bf16(v1[0], v1[1]); w.w = cvt_pk_bf16(v1[2], v1[3]);
                    *(u32x4*)(xb + off + bj * HALF) = w;
                    s += (v0[0] * v0[0] + v0[1] * v0[1]) + (v0[2] * v0[2] + v0[3] * v0[3]) + (v1[0] * v1[0] + v1[1] * v1[1]) + (v1[2] * v1[2] + v1[3] * v1[3]); }
                { const auto r16_ = __builtin_amdgcn_permlane16_swap(__float_as_uint(s), __float_as_uint(s), false, false); s = __uint_as_float(r16_[0]) + __uint_as_float(r16_[1]); const auto r32_ = __builtin_amdgcn_permlane32_swap(__float_as_uint(s), __float_as_uint(s), false, false); s = __uint_as_float(r32_[0]) + __uint_as_float(r32_[1]); }
                if (fq == 0) ss[(size_t)row * 16 + u.pn * 4 + wc] = s; }
    }
};
template <class Epi, class Sched, bool ALIGN_EPI = false, bool SP2 = false>
__device__ __forceinline__ void gemm_phase(PG8_LAS unsigned char* lds, const Gemm g, const Sched& S, const Epi& E) {
    int tid_ = threadIdx.x; asm volatile("" : "+v"(tid_));
    const int tid = tid_, wid = __builtin_amdgcn_readfirstlane(tid >> 6), lane = tid & 63, wr = wid >> 2, wc = wid & 3, fr = lane & 15, fq = lane >> 4;
    const int K = g.K, nt = K / BK;
    unsigned voffA[2], voffB[2];
#pragma unroll
    for (int i = 0; i < 2; ++i) { int R, C; stage_rc(tid * 16 + i * 8192, R, C); const int Rb = Epi::PERM ? ((R & ~31) + perm32(R & 31)) : R;
        voffA[i] = (unsigned)(R * K + C) * 2u; voffB[i] = (unsigned)(Rb * K + C) * 2u; }
    const size_t kstep = (size_t)(BK * 2);
    const size_t hstep = (size_t)HALF * K * 2;
    const size_t tstep = 2 * hstep;
    const unsigned ldsw = (unsigned)wid * 1024u;
    const int aoff = lds_byte(wr * 64 + fr, fq * 8), boff = lds_byte(wc * 32 + fr, fq * 8);
#define PG8_SA(b, h) (((b) * 2 + (h)) * HTB)
#define PG8_SB(b, h) ((4 + (b) * 2 + (h)) * HTB)
#define PG8_STAGE(bufoff, gbase, voff) do { _Pragma("unroll") for (int _i = 0; _i < 2; ++_i) \
        __builtin_amdgcn_global_load_lds((const unsigned*)((const char*)(gbase) + (voff)[_i]), (PG8_LAS unsigned*)(lds + (bufoff) + ldsw + _i * 8192), 16, 0, 0); } while (0)
#define PG8_LDA(dst, b, h) do { _Pragma("unroll") for (int m = 0; m < 4; ++m) _Pragma("unroll") for (int k = 0; k < 2; ++k) dst[m][k] = *(const PG8_LAS bf16x8*)(lds + PG8_SA(b, h) + aoff + m * 2048 + k * 1024); } while (0)
#define PG8_LDB(dst, b, h) do { _Pragma("unroll") for (int n = 0; n < 2; ++n) _Pragma("unroll") for (int k = 0; k < 2; ++k) dst[n][k] = *(const PG8_LAS bf16x8*)(lds + PG8_SB(b, h) + boff + n * 2048 + k * 1024); } while (0)
#define PG8_MMA(ai, bj, At, Bt) do { __builtin_amdgcn_s_setprio(1); _Pragma("unroll") for (int m = 0; m < 4; ++m) _Pragma("unroll") for (int n = 0; n < 2; ++n) _Pragma("unroll") for (int k = 0; k < 2; ++k) \
        acc[ai][bj][m][n] = __builtin_amdgcn_mfma_f32_16x16x32_bf16(Bt[n][k], At[m][k], acc[ai][bj][m][n], 0, 0, 0); __builtin_amdgcn_s_setprio(0); } while (0)
#define PG8_WAIT_V(n) asm volatile("s_waitcnt vmcnt(" #n ")" ::: "memory")
#define PG8_WAIT_L(n) asm volatile("s_waitcnt lgkmcnt(" #n ")" ::: "memory")
#define PG8_BAR __builtin_amdgcn_s_barrier()
#define PG8_SCHED __builtin_amdgcn_sched_barrier(0)
    Unit cur, nxt; int ui = 0;
    if (!S.next(0, cur)) return;
    f32x4 acc[2][2][4][2];
#pragma unroll
    for (int a = 0; a < 2; ++a)
#pragma unroll
        for (int b = 0; b < 2; ++b)
#pragma unroll
            for (int m = 0; m < 4; ++m)
#pragma unroll
                for (int n = 0; n < 2; ++n) acc[a][b][m][n] = (f32x4){0.f, 0.f, 0.f, 0.f};
    bf16x8 At[4][2], B0[2][2], B1[2][2];
    const char* cA = (const char*)g.A + (size_t)cur.pm * tstep; const char* cB = (const char*)g.Bt + (size_t)cur.pn * tstep;
    S.a_ready(cur);
    if constexpr (SP2) {
        PG8_STAGE(PG8_SB(0, 0), cB, voffB); PG8_STAGE(PG8_SB(0, 1), cB + hstep, voffB); PG8_STAGE(PG8_SA(0, 0), cA, voffA); PG8_STAGE(PG8_SA(0, 1), cA + hstep, voffA);
        if (wr == 1) PG8_BAR;
        PG8_WAIT_V(2); PG8_BAR;
        PG8_STAGE(PG8_SB(1, 0), cB + kstep, voffB); PG8_STAGE(PG8_SA(1, 0), cA + kstep, voffA); PG8_STAGE(PG8_SB(1, 1), cB + hstep + kstep, voffB);
        PG8_WAIT_V(6); PG8_BAR;
    } else {
        PG8_STAGE(PG8_SB(0, 0), cB, voffB); PG8_STAGE(PG8_SA(0, 0), cA, voffA); PG8_STAGE(PG8_SB(0, 1), cB + hstep, voffB); PG8_STAGE(PG8_SA(0, 1), cA + hstep, voffA);
        if (wr == 1) PG8_BAR;
        PG8_WAIT_V(4); PG8_BAR;
        PG8_STAGE(PG8_SB(1, 0), cB + kstep, voffB); PG8_STAGE(PG8_SA(1, 0), cA + kstep, voffA); PG8_STAGE(PG8_SB(1, 1), cB + hstep + kstep, voffB);
        PG8_WAIT_V(6); PG8_BAR;
    }
    for (;;) {
        const bool has_next = S.next(ui + 1, nxt);
        const char* nA = has_next ? (const char*)g.A + (size_t)nxt.pm * tstep : cA; const char* nB = has_next ? (const char*)g.Bt + (size_t)nxt.pn * tstep : cB;
        for (int t = 0; t < nt; t += 2) {
            const bool last = (t == nt - 2);
            const char* a1 = cA + (size_t)(t + 1) * kstep;
            const char* a2 = last ? nA : cA + (size_t)(t + 2) * kstep; const char* b2 = last ? nB : cB + (size_t)(t + 2) * kstep;
            const char* a3 = a2 + kstep; const char* b3 = b2 + kstep;
            if (last && has_next) S.a_ready(nxt);
            if constexpr (SP2) {
            PG8_LDB(B0, 0, 0); PG8_LDB(B1, 0, 1); PG8_SCHED; PG8_LDA(At, 0, 0); PG8_STAGE(PG8_SA(1, 1), a1 + hstep, voffA);
            PG8_WAIT_V(8); PG8_WAIT_L(0); PG8_BAR; PG8_MMA(0, 0, At, B0); PG8_MMA(0, 1, At, B1); PG8_BAR; PG8_SCHED;
            PG8_LDA(At, 0, 1); PG8_STAGE(PG8_SB(0, 0), b2, voffB); PG8_STAGE(PG8_SB(0, 1), b2 + hstep, voffB); PG8_STAGE(PG8_SA(0, 0), a2, voffA);
            PG8_WAIT_V(8); PG8_WAIT_L(0); PG8_BAR; PG8_MMA(1, 0, At, B0); PG8_MMA(1, 1, At, B1); PG8_BAR; PG8_SCHED;
            PG8_LDB(B0, 1, 0); PG8_LDB(B1, 1, 1); PG8_SCHED; PG8_LDA(At, 1, 0); PG8_STAGE(PG8_SA(0, 1), a2 + hstep, voffA);
            PG8_WAIT_V(8); PG8_WAIT_L(0); PG8_BAR; PG8_MMA(0, 0, At, B0); PG8_MMA(0, 1, At, B1); PG8_BAR; PG8_SCHED;
            PG8_LDA(At, 1, 1); PG8_STAGE(PG8_SB(1, 0), b3, voffB); PG8_STAGE(PG8_SB(1, 1), b3 + hstep, voffB); PG8_STAGE(PG8_SA(1, 0), a3, voffA);
            PG8_WAIT_V(8); PG8_WAIT_L(0); PG8_BAR; PG8_MMA(1, 0, At, B0); PG8_MMA(1, 1, At, B1); PG8_BAR; PG8_SCHED;
            } else {
            PG8_LDB(B0, 0, 0); PG8_SCHED; PG8_LDA(At, 0, 0); PG8_STAGE(PG8_SA(1, 1), a1 + hstep, voffA);
            PG8_WAIT_L(8); PG8_BAR; PG8_WAIT_L(0); PG8_MMA(0, 0, At, B0); PG8_BAR; PG8_SCHED;
            PG8_LDB(B1, 0, 1); PG8_STAGE(PG8_SB(0, 0), b2, voffB);
            PG8_BAR; PG8_WAIT_L(0); PG8_MMA(0, 1, At, B1); PG8_BAR;
            PG8_LDA(At, 0, 1); PG8_STAGE(PG8_SA(0, 0), a2, voffA);
            PG8_BAR; PG8_WAIT_L(0); PG8_MMA(1, 0, At, B0); PG8_BAR; PG8_SCHED;
            PG8_STAGE(PG8_SB(0, 1), b2 + hstep, voffB);
            PG8_WAIT_V(6); PG8_BAR; PG8_MMA(1, 1, At, B1); PG8_BAR;
            PG8_LDB(B0, 1, 0); PG8_SCHED; PG8_LDA(At, 1, 0); PG8_STAGE(PG8_SA(0, 1), a2 + hstep, voffA);
            PG8_WAIT_L(8); PG8_BAR; PG8_WAIT_L(0); PG8_MMA(0, 0, At, B0); PG8_BAR; PG8_SCHED;
            PG8_LDB(B1, 1, 1); PG8_STAGE(PG8_SB(1, 0), b3, voffB);
            PG8_BAR; PG8_WAIT_L(0); PG8_MMA(0, 1, At, B1); PG8_BAR;
            PG8_LDA(At, 1, 1); PG8_STAGE(PG8_SA(1, 0), a3, voffA);
            PG8_BAR; PG8_WAIT_L(0); PG8_MMA(1, 0, At, B0); PG8_BAR; PG8_SCHED;
            PG8_STAGE(PG8_SB(1, 1), b3 + hstep, voffB);
            PG8_WAIT_V(6); PG8_BAR; PG8_MMA(1, 1, At, B1); PG8_BAR;
            }
        }
        if constexpr (ALIGN_EPI) { if (wr == 0) PG8_BAR; }
        if constexpr (!Epi::AFTER_DRAIN) { E(acc, cur, wr, wc, fr, fq); S.done(cur); }
        if (!has_next) break;
#pragma unroll
        for (int a = 0; a < 2; ++a)
#pragma unroll
            for (int b = 0; b < 2; ++b)
#pragma unroll
                for (int m = 0; m < 4; ++m)
#pragma unroll
                    for (int n = 0; n < 2; ++n) acc[a][b][m][n] = (f32x4){0.f, 0.f, 0.f, 0.f};
        cur = nxt; cA = nA; cB = nB; ++ui;
        if constexpr (ALIGN_EPI) { if (wr == 1) PG8_BAR; }
    }
    PG8_WAIT_V(0);
    if constexpr (!ALIGN_EPI) { if (wr == 0) PG8_BAR; }
    PG8_BAR;
    if constexpr (Epi::AFTER_DRAIN) { E.fused(acc, cur, wr, wc, fr, fq, lds, wid, lane); S.done(cur); }
#undef PG8_SA
#undef PG8_SB
#undef PG8_STAGE
#undef PG8_LDA
#undef PG8_LDB
#undef PG8_MMA
#undef PG8_WAIT_V
#undef PG8_WAIT_L
#undef PG8_BAR
#undef PG8_SCHED
}
}

#ifndef PG8_SP2
#define PG8_SP2 true
#endif
#ifndef PG8_ALIGN
#define PG8_ALIGN true
#endif
constexpr int NWAVES = 8;
constexpr int NPH = 15;
#ifndef MK_N_LAUNCHES
#define MK_N_LAUNCHES 1
#endif
constexpr int N_LAUNCHES = MK_N_LAUNCHES;

constexpr int BATCH = 2, SEQ = 16384, DM = 1024, DEPTH = 2;
constexpr int M = BATCH * SEQ;
constexpr int INW = 2824;
constexpr int NP = 3072;
constexpr int QOFF = 0, KOFF = 256, VOFF = 512, ZOFF = 768, XOFF = 1280, SBOFF = 2048, SCOFF = 2304, SVOFF = 2560, DTOFF = 2816;
constexpr int NCHUNK = SEQ / 64;
constexpr float EPS = 1e-6f;
constexpr float SB_EXIT = -104.0f;

constexpr size_t MiB = 1u << 20;
constexpr size_t WS_CTL = 0, CTL_ZERO_BYTES = 1 * MiB;
constexpr size_t WS_WIN = 2 * MiB;
constexpr size_t WS_WOUT = 14 * MiB;
constexpr size_t WS_WS = 18 * MiB;
constexpr size_t WS_SS2 = 22 * MiB;
constexpr size_t WS_EA = 24 * MiB;
constexpr size_t WS_CD = 25 * MiB;
constexpr size_t WS_CC = 26 * MiB;
constexpr size_t WS_U8 = 34 * MiB;
constexpr size_t WS_V8 = 66 * MiB;
constexpr size_t WS_US = 25 * MiB + 128 * 1024;
constexpr size_t WS_VS = 25 * MiB + 256 * 1024;
constexpr size_t WS_RS1 = 25 * MiB + 512 * 1024;
constexpr size_t WS_XB = 98 * MiB;
constexpr size_t WS_XNY = 162 * MiB;
constexpr size_t WS_P = 226 * MiB;
constexpr size_t WS_SC = WS_P, WS_X1B = WS_P + 128 * MiB;
constexpr size_t WS_ST = 418 * MiB;
constexpr size_t WS_END = 482 * MiB;
constexpr int CW_BAR = 4096;

constexpr int LDS_BYTES = 163840;
constexpr int LDSCTL_OFF = 161792, MISC_OFF = LDSCTL_OFF + 320;
static_assert(MISC_OFF + 128 <= LDS_BYTES, "LDS map");

#define GAS __attribute__((address_space(1)))
#define LAS __attribute__((address_space(3)))
typedef unsigned short bf16;
typedef unsigned v4u __attribute__((ext_vector_type(4)));
typedef unsigned v2u __attribute__((ext_vector_type(2)));
typedef float f32x4 __attribute__((ext_vector_type(4)));
typedef GAS unsigned gu32;
#define RLX_AGENT __ATOMIC_RELAXED, __HIP_MEMORY_SCOPE_AGENT
#define LDS_WAIT() asm volatile("s_waitcnt lgkmcnt(0)" ::: "memory")
#define VM_WAIT() asm volatile("s_waitcnt vmcnt(0)" ::: "memory")
__device__ __forceinline__ unsigned f2bf(float f) { unsigned u = __builtin_bit_cast(unsigned, f); return (u + 0x7fffu + ((u >> 16) & 1u)) >> 16; }
__device__ __forceinline__ unsigned pk2(float lo, float hi) { return f2bf(lo) | (f2bf(hi) << 16); }
__device__ __forceinline__ float bflo(unsigned u) { return __uint_as_float(u << 16); }
__device__ __forceinline__ float bfhi(unsigned u) { return __uint_as_float(u & 0xffff0000u); }
__device__ __forceinline__ float bf2f(bf16 h) { return __uint_as_float(((unsigned)h) << 16); }
__device__ __forceinline__ void unpack8(const v4u v, float (&f)[8]) { f[0] = bflo(v.x); f[1] = bfhi(v.x); f[2] = bflo(v.y); f[3] = bfhi(v.y); f[4] = bflo(v.z); f[5] = bfhi(v.z); f[6] = bflo(v.w); f[7] = bfhi(v.w); }
__device__ __forceinline__ v4u pack8(const float (&f)[8]) { v4u o; o.x = pk2(f[0], f[1]); o.y = pk2(f[2], f[3]); o.z = pk2(f[4], f[5]); o.w = pk2(f[6], f[7]); return o; }
__device__ __forceinline__ float wave_sum(float v) {
#pragma unroll
    for (int o = 1; o < 64; o <<= 1) v += __shfl_xor(v, o);
    return v;
}
template <int CTRL> __device__ __forceinline__ float dppf(float x) { return __int_as_float(__builtin_amdgcn_update_dpp(0, __float_as_int(x), CTRL, 0xf, 0xf, false)); }
__device__ __forceinline__ float sum_x16(float x) { const auto r = __builtin_amdgcn_permlane16_swap(__float_as_uint(x), __float_as_uint(x), false, false); return __uint_as_float(r[0]) + __uint_as_float(r[1]); }
__device__ __forceinline__ float sum_x32(float x) { const auto r = __builtin_amdgcn_permlane32_swap(__float_as_uint(x), __float_as_uint(x), false, false); return __uint_as_float(r[0]) + __uint_as_float(r[1]); }
__device__ __forceinline__ float wave_sum_v(float x) { x += dppf<0xB1>(x); x += dppf<0x4E>(x); x += dppf<0x141>(x); x += dppf<0x128>(x); x = sum_x16(x); return sum_x32(x); }
__device__ __forceinline__ float silu_f(float x) { return x / (1.0f + __expf(-x)); }

#define XB_TMO      128
#define XB_XCNT(j)  (256  + 64 * (j))
#define XB_XSUB(j)  (1280 + 64 * (j))
#define XB_XGEN(j)  (2304 + 64 * (j))
#define XB_TOP      3328
#define XB_TOPGEN   3392
#define XCD_BAR_WORDS 3456
#define XB_SPIN_CAP (1u << 18)

__device__ __forceinline__ unsigned xb_ld(unsigned* p)              { return __hip_atomic_load(p, __ATOMIC_RELAXED, __HIP_MEMORY_SCOPE_AGENT); }
__device__ __forceinline__ unsigned xb_add(unsigned* p, unsigned v) { return __hip_atomic_fetch_add(p, v, __ATOMIC_RELAXED, __HIP_MEMORY_SCOPE_AGENT); }
__device__ __forceinline__ unsigned xb_xcc_id() { return (unsigned)__builtin_amdgcn_s_getreg((3 << 11) | 20) & 0xFu; }
#define XB_SPIN(cond, bar) do { unsigned _sp = 0; while (cond) { __builtin_amdgcn_s_sleep(1); \
    if ((++_sp & 255u) == 0u) { if (xb_ld(&(bar)[XB_TMO])) break; if (_sp > XB_SPIN_CAP) { atomicAdd(&(bar)[XB_TMO], 1u); break; } } } } while (0)

struct XcdBarrier {
    unsigned* bar; unsigned x;
    volatile LAS unsigned* st;
};

__device__ __forceinline__ XcdBarrier xcd_barrier_post(unsigned* bar, volatile LAS unsigned* st) {
    XcdBarrier b; b.bar = bar; b.x = xb_xcc_id(); b.st = st;
    if (threadIdx.x == 0) (void)xb_add(&bar[XB_XCNT(b.x)], 1u);
    return b;
}
__device__ __forceinline__ void xcd_barrier_complete(unsigned* bar, unsigned x, unsigned& nloc, unsigned& nx) {
    const unsigned G = gridDim.x * gridDim.y * gridDim.z;
    unsigned sum, cnt, mine, sp = 0u;
    for (;;) {
        sum = 0u; cnt = 0u; mine = 0u;
#pragma unroll
        for (unsigned j = 0; j < 16; ++j) { const unsigned c = xb_ld(&bar[XB_XCNT(j)]); sum += c; cnt += (c > 0u) ? 1u : 0u; mine = (j == x) ? c : mine; }
        if (sum == G) break;
        __builtin_amdgcn_s_sleep(1);
        if ((++sp & 255u) == 0u) { if (xb_ld(&bar[XB_TMO])) break; if (sp > XB_SPIN_CAP) { atomicAdd(&bar[XB_TMO], 1u); break; } }
    }
    nloc = mine > 0u ? mine : 1u; nx = cnt > 0u ? cnt : 1u;
}

__device__ __forceinline__ void xcd_barrier(const XcdBarrier& b) {
    asm volatile("s_waitcnt vmcnt(0)" ::: "memory");
    __syncthreads();
    if (threadIdx.x == 0) {
        unsigned* bar = b.bar;
        __builtin_amdgcn_s_waitcnt(0);
        unsigned nloc = b.st[0], nx = b.st[1];
        if (nloc == 0u) { xcd_barrier_complete(bar, b.x, nloc, nx); b.st[0] = nloc; b.st[1] = nx; }
        const unsigned old = xb_add(&bar[XB_XSUB(b.x)], 1u);
        const unsigned gen = old / nloc;
        if (old + 1u == (gen + 1u) * nloc) {
            __builtin_amdgcn_fence(__ATOMIC_RELEASE, "agent");
            asm volatile("s_waitcnt vmcnt(0)" ::: "memory");
            const unsigned og = xb_add(&bar[XB_TOP], 1u);
            const unsigned tg = og / nx;
            if (og + 1u == (tg + 1u) * nx) xb_add(&bar[XB_TOPGEN], 1u);
            else XB_SPIN(xb_ld(&bar[XB_TOPGEN]) == tg, bar);
            __builtin_amdgcn_fence(__ATOMIC_ACQUIRE, "agent");
            xb_add(&bar[XB_XGEN(b.x)], 1u);
            asm volatile("s_waitcnt vmcnt(0)" ::: "memory");
        } else {
            XB_SPIN(xb_ld(&bar[XB_XGEN(b.x)]) == gen, bar);
            __builtin_amdgcn_fence(__ATOMIC_ACQUIRE, "agent");
            asm volatile("s_waitcnt vmcnt(0)" ::: "memory");
        }
    }
    __syncthreads();
}

struct Ctx { LAS unsigned char* lds; int tid, lane, wave, vcu, G; };

__device__ __forceinline__ int win_colmap(int n) { return n < 2048 ? n : (n < 2816 ? n + 8 : (n < INW ? n - 2816 + 2048 : -1)); }
__device__ __forceinline__ void tr_item(const float* W, int Nsrc, int K, bf16* WT, const float* rowscale, LAS float* scr, int kb, int nb, int lane, bool mapped) {
    const int k0 = 64 * kb, n0 = 32 * nb; const int n = n0 + (lane & 31); const int sc = mapped ? win_colmap(n) : n;
#pragma unroll 8
    for (int i = 0; i < 32; ++i) { const int kk = 2 * i + (lane >> 5); float v = 0.f; if (sc >= 0) { v = W[(size_t)(k0 + kk) * Nsrc + sc]; if (rowscale) v *= rowscale[k0 + kk]; } scr[kk * 33 + (lane & 31)] = v; }
    LDS_WAIT(); asm volatile("" ::: "memory");
    const int c = lane & 7;
#pragma unroll
    for (int j = 0; j < 4; ++j) { const int nn = (lane >> 3) + 8 * j; const LAS float* s = scr + (8 * c) * 33 + nn;
        v4u o; o.x = pk2(s[0 * 33], s[1 * 33]); o.y = pk2(s[2 * 33], s[3 * 33]); o.z = pk2(s[4 * 33], s[5 * 33]); o.w = pk2(s[6 * 33], s[7 * 33]);
        *(GAS v4u*)(WT + (size_t)(n0 + nn) * K + k0 + 8 * c) = o; }
    LDS_WAIT(); asm volatile("" ::: "memory");
}
__device__ __forceinline__ void p0_prologue(const Ctx F, const float* x, const float* norm1_w, const float* w_in, const float* w_out, const float* norm2_w, const float* w_q, const float* sub_keys, unsigned char* ws) {
    bf16* WIN = (bf16*)(ws + WS_WIN); bf16* WOUT = (bf16*)(ws + WS_WOUT); bf16* WST = (bf16*)(ws + WS_WS);
    LAS float* scr = (LAS float*)(F.lds + F.wave * 16384);
    const int gw = F.vcu * NWAVES + F.wave, NGW = F.G * NWAVES;
    constexpr int I_IN = (DM / 64) * (NP / 32), I_OUT = (DM / 64) * (DM / 32);
    for (int it = gw; it < DEPTH * (I_IN + I_OUT); it += NGW) {
        int r = it;
        if (r < DEPTH * I_IN) { const int L = r / I_IN; r -= L * I_IN; tr_item(w_in + (size_t)L * DM * INW, INW, DM, WIN + (size_t)L * NP * DM, norm1_w + L * DM, scr, r / (NP / 32), r % (NP / 32), F.lane, true); }
        else { r -= DEPTH * I_IN; const int L = r / I_OUT; r -= L * I_OUT; tr_item(w_out + (size_t)L * DM * DM, DM, DM, WOUT + (size_t)L * DM * DM, nullptr, scr, r / (DM / 32), r % (DM / 32), F.lane, false); }
    }
    {
        typedef float f32x4w __attribute__((ext_vector_type(4)));
        const int fr = F.lane & 15, fq = F.lane >> 4;
        for (int u = gw; u < DEPTH * 8 * 64 * 2; u += NGW) {
            const int jh = u & 1, dt = (u >> 1) & 63, sl = (u >> 7) & 7, L = u >> 10, half = sl & 1;
            const float* Aq = w_q + (size_t)L * DM * DM + (size_t)(16 * dt + fr) * DM + sl * 128 + fq;
            const float* Bk = sub_keys + ((size_t)L * 2 + half) * 128 * 128 + (size_t)(64 * jh + fr) * 128 + fq;
            f32x4w acc[4];
#pragma unroll
            for (int j = 0; j < 4; ++j) acc[j] = (f32x4w){0.f, 0.f, 0.f, 0.f};
#pragma unroll 4
            for (int kk = 0; kk < 32; ++kk) { const float a = Aq[4 * kk];
#pragma unroll
                for (int j = 0; j < 4; ++j) acc[j] = __builtin_amdgcn_mfma_f32_16x16x4f32(a, Bk[(size_t)(16 * j) * 128 + 4 * kk], acc[j], 0, 0, 0); }
            const f32x4 w4 = *(const f32x4*)(norm2_w + L * DM + 16 * dt + 4 * fq);
#pragma unroll
            for (int j = 0; j < 4; ++j) *(v2u*)(WST + (size_t)L * DM * DM + (size_t)(sl * 128 + 64 * jh + 16 * j + fr) * DM + 16 * dt + 4 * fq) = (v2u){pk2(acc[j][0] * w4[0], acc[j][1] * w4[1]), pk2(acc[j][2] * w4[2], acc[j][3] * w4[3])};
        }
    }
    { bf16* XB = (bf16*)(ws + WS_XB); float* RS1 = (float*)(ws + WS_RS1);
    for (int m = gw; m < M; m += NGW) {
        const f32x4* xr = (const f32x4*)(x + (size_t)m * DM) + F.lane; f32x4 v[4]; float s = 0.f;
#pragma unroll
        for (int j = 0; j < 4; ++j) { v[j] = xr[64 * j]; s += (v[j][0] * v[j][0] + v[j][1] * v[j][1]) + (v[j][2] * v[j][2] + v[j][3] * v[j][3]); }
        const float rstd = 1.0f / sqrtf(wave_sum_v(s) * (1.0f / DM) + EPS);
        v2u* o8 = (v2u*)(XB + (size_t)m * DM) + F.lane;
#pragma unroll
        for (int j = 0; j < 4; ++j) { v2u o; o.x = pk2(v[j][0], v[j][1]); o.y = pk2(v[j][2], v[j][3]); o8[64 * j] = o; }
        if (F.lane == 0) RS1[m] = rstd;
    } }
}

typedef float f32x16 __attribute__((ext_vector_type(16)));
typedef short bf16x8 __attribute__((ext_vector_type(8)));
typedef short v4i16_t __attribute__((ext_vector_type(4)));
constexpr int AT_VS = 72;
__device__ __forceinline__ int crow(int r, int hi) { return (r & 3) + 8 * (r >> 2) + 4 * hi; }
__device__ __forceinline__ void attn_mfma(const Ctx F, const bf16* P, bf16* Y) {
    LAS bf16* vt = (LAS bf16*)(F.lds + F.wave * 8192);
    const int lane = F.lane, r32 = lane & 31, hi = lane >> 5;
    const int gw = F.vcu * NWAVES + F.wave, NGW = F.G * NWAVES;
    const LAS bf16* vrd = vt + (4 * hi + ((lane & 15) >> 2)) * AT_VS + 16 * ((lane >> 4) & 1) + 4 * (lane & 3);
#pragma unroll 1
    for (int u = gw; u < BATCH * 4 * (SEQ / 32); u += NGW) {
        const int qb = u & (SEQ / 32 - 1), bh = u / (SEQ / 32), h = bh & 3, b = bh >> 2;
        const int q0 = qb * 32; const size_t rowbase = (size_t)b * SEQ; const int t = q0 + r32;
        bf16x8 qf[4];
#pragma unroll
        for (int d0 = 0; d0 < 4; ++d0) { float f[8]; unpack8(*(const v4u*)(P + (rowbase + q0 + r32) * NP + QOFF + h * 64 + d0 * 16 + hi * 8), f);
#pragma unroll
            for (int i = 0; i < 8; ++i) f[i] *= 0.125f;
            qf[d0] = __builtin_bit_cast(bf16x8, pack8(f)); }
        f32x16 o0, o1;
#pragma unroll
        for (int r = 0; r < 16; ++r) { o0[r] = 0.f; o1[r] = 0.f; }
        float R = 0.f;
        int k0 = q0; bool diag = true;
        v4u kf[4], vr[4];
        { const bf16* kp = P + (rowbase + k0 + r32) * NP + KOFF + h * 64 + hi * 8; const bf16* vp = P + (rowbase + k0 + (lane >> 1)) * NP + VOFF + h * 64 + (lane & 1) * 32;
#pragma unroll
          for (int c = 0; c < 4; ++c) { kf[c] = *(const v4u*)(kp + c * 16); vr[c] = *(const v4u*)(vp + c * 8); } }
#pragma unroll 1
        for (;;) {
#pragma unroll
            for (int c = 0; c < 4; ++c) *(LAS v4u*)(vt + (lane >> 1) * AT_VS + (lane & 1) * 32 + c * 8) = vr[c];
            bf16x8 ka[4];
#pragma unroll
            for (int c = 0; c < 4; ++c) ka[c] = __builtin_bit_cast(bf16x8, kf[c]);
            const int kn = k0 - 32;
            if (kn >= 0) { const bf16* kp = P + (rowbase + kn + r32) * NP + KOFF + h * 64 + hi * 8; const bf16* vp = P + (rowbase + kn + (lane >> 1)) * NP + VOFF + h * 64 + (lane & 1) * 32;
#pragma unroll
                for (int c = 0; c < 4; ++c) { kf[c] = *(const v4u*)(kp + c * 16); vr[c] = *(const v4u*)(vp + c * 8); } }
            f32x16 p;
#pragma unroll
            for (int r = 0; r < 16; ++r) p[r] = 0.f;
#pragma unroll
            for (int d0 = 0; d0 < 4; ++d0) p = __builtin_amdgcn_mfma_f32_32x32x16_bf16(ka[d0], qf[d0], p, 0, 0, 0);
            float l[16], ee[16];
#pragma unroll
            for (int r = 0; r < 16; ++r) { const float z = p[r]; const float sp = fmaxf(z, 0.f) + __logf(1.0f + __expf(-fabsf(z)));
                const bool valid = !diag || (k0 + crow(r, hi) < t);
                l[r] = valid ? -sp : 0.f; ee[r] = valid ? (z - sp) : -INFINITY; }
            float gs[4], pg[4], tot[4], later[4];
#pragma unroll
            for (int g = 0; g < 4; ++g) { gs[g] = (l[4 * g] + l[4 * g + 1]) + (l[4 * g + 2] + l[4 * g + 3]); tot[g] = sum_x32(gs[g]); pg[g] = tot[g] - gs[g]; }
            later[3] = 0.f; later[2] = tot[3]; later[1] = tot[3] + tot[2]; later[0] = later[1] + tot[1];
            if (hi == 0) {
#pragma unroll
                for (int g = 0; g < 4; ++g) later[g] += pg[g]; }
#pragma unroll
            for (int g = 0; g < 4; ++g) { const float base = R + later[g];
                const float s3 = base, s2 = s3 + l[4 * g + 3], s1 = s2 + l[4 * g + 2], s0 = s1 + l[4 * g + 1];
                p[4 * g + 3] = __expf(ee[4 * g + 3] + s3); p[4 * g + 2] = __expf(ee[4 * g + 2] + s2); p[4 * g + 1] = __expf(ee[4 * g + 1] + s1); p[4 * g] = __expf(ee[4 * g] + s0); }
            R += (tot[0] + tot[1]) + (tot[2] + tot[3]);
            bf16x8 pb[2];
#pragma unroll
            for (int ks = 0; ks < 2; ++ks) { float f[8];
#pragma unroll
                for (int j = 0; j < 8; ++j) f[j] = p[8 * ks + j];
                pb[ks] = __builtin_bit_cast(bf16x8, pack8(f)); }
#pragma unroll
            for (int ks = 0; ks < 2; ++ks)
#pragma unroll
                for (int dt = 0; dt < 2; ++dt) {
                    const v4i16_t lo = __builtin_amdgcn_ds_read_tr16_b64_v4i16((LAS v4i16_t*)(vrd + (16 * ks) * AT_VS + 32 * dt));
                    const v4i16_t hi4 = __builtin_amdgcn_ds_read_tr16_b64_v4i16((LAS v4i16_t*)(vrd + (16 * ks + 8) * AT_VS + 32 * dt));
                    const bf16x8 va = (bf16x8){lo[0], lo[1], lo[2], lo[3], hi4[0], hi4[1], hi4[2], hi4[3]};
                    if (dt == 0) o0 = __builtin_amdgcn_mfma_f32_32x32x16_bf16(va, pb[ks], o0, 0, 0, 0); else o1 = __builtin_amdgcn_mfma_f32_32x32x16_bf16(va, pb[ks], o1, 0, 0, 0);
                }
            if (kn < 0 || __all(R < SB_EXIT)) break;
            k0 = kn; diag = false;
        }
        bf16* yp = Y + (rowbase + q0 + r32) * DM + h * 64;
#pragma unroll
        for (int g = 0; g < 4; ++g) { v2u a, c; a.x = pk2(o0[4 * g], o0[4 * g + 1]); a.y = pk2(o0[4 * g + 2], o0[4 * g + 3]); c.x = pk2(o1[4 * g], o1[4 * g + 1]); c.y = pk2(o1[4 * g + 2], o1[4 * g + 3]);
            *(v2u*)(yp + 8 * g + 4 * hi) = a; *(v2u*)(yp + 32 + 8 * g + 4 * hi) = c; }
    }
}
__device__ __forceinline__ void shortconv(const Ctx F, const bf16* P, bf16* Y, const float* cw  ) {
    for (long it = (long)F.vcu * 512 + F.tid; it < (long)(M / 8) * 32; it += (long)F.G * 512) {
        const size_t row0 = (size_t)(it >> 5) * 8; const int c0 = (int)(it & 31) * 8; const int t0 = (int)(row0 & (SEQ - 1));
        v4u cr[10], vr[10], br[8];
#pragma unroll
        for (int j = 0; j < 10; ++j) { const bool ok = (j >= 2) || (t0 > 0);
            cr[j] = ok ? *(const v4u*)(P + (row0 + j - 2) * NP + SCOFF + c0) : (v4u){0u, 0u, 0u, 0u}; vr[j] = ok ? *(const v4u*)(P + (row0 + j - 2) * NP + SVOFF + c0) : (v4u){0u, 0u, 0u, 0u}; }
#pragma unroll
        for (int j = 0; j < 8; ++j) br[j] = *(const v4u*)(P + (row0 + j) * NP + SBOFF + c0);
        float w[3][8];
#pragma unroll
        for (int k = 0; k < 3; ++k) { const f32x4 w0 = *(const f32x4*)(cw + k * 256 + c0), w1 = *(const f32x4*)(cw + k * 256 + c0 + 4);
#pragma unroll
            for (int i = 0; i < 4; ++i) { w[k][i] = w0[i]; w[k][4 + i] = w1[i]; } }
        float cv[10][8];
#pragma unroll
        for (int j = 0; j < 10; ++j) { float c8[8], v8[8]; unpack8(cr[j], c8); unpack8(vr[j], v8);
#pragma unroll
            for (int i = 0; i < 8; ++i) cv[j][i] = c8[i] * v8[i]; }
#pragma unroll
        for (int j = 0; j < 8; ++j) { float b8[8], o[8]; unpack8(br[j], b8);
#pragma unroll
            for (int i = 0; i < 8; ++i) o[i] = b8[i] * (w[0][i] * cv[j][i] + w[1][i] * cv[j + 1][i] + w[2][i] * cv[j + 2][i]);
            *(v4u*)(Y + (row0 + j) * DM + 768 + c0) = pack8(o); }
    }
}
constexpr int XTS = 72, BNS = 136;
constexpr int L_XT = 0, L_BN = L_XT + 512 * XTS * 2, L_BT = L_BN + 64 * BNS * 2, L_CN = L_BT + 128 * XTS * 2, L_GG = L_CN + 64 * BNS * 2, L_DT = L_GG + 128 * XTS * 2, L_ACS = L_DT + 2048, L_WL = L_ACS + 2048, L_SSD_END = L_WL + 2048;
static_assert(L_SSD_END <= LDSCTL_OFF, "SSD part 1 LDS");
typedef float f32x4v __attribute__((ext_vector_type(4)));
__device__ __forceinline__ void ssd_part1(const Ctx F, const bf16* P, bf16* Y, const float* cw  , const float* cb  , const float* dt_bias, const float* A_log, const float* Dp,
                                          bf16* CC, float* EA, float* CD, bf16* ST) {
    LAS bf16* XT = (LAS bf16*)(F.lds + L_XT); LAS bf16* BN = (LAS bf16*)(F.lds + L_BN); LAS bf16* BT = (LAS bf16*)(F.lds + L_BT); LAS bf16* CN = (LAS bf16*)(F.lds + L_CN); LAS bf16* GG = (LAS bf16*)(F.lds + L_GG);
    LAS float* DTH = (LAS float*)(F.lds + L_DT); LAS float* ACH = (LAS float*)(F.lds + L_ACS); LAS float* WLH = (LAS float*)(F.lds + L_WL);
    const int lane = F.lane, fr = lane & 15, fq = lane >> 4;
#pragma unroll 1
    for (int u = F.vcu; u < BATCH * NCHUNK; u += F.G) {
        const int b = u / NCHUNK, c = u % NCHUNK, t0 = c * 64; const size_t r0 = (size_t)b * SEQ + t0;
        __syncthreads();
        if (F.tid < 384) { const int ch = 2 * F.tid;
            float w0[4], w1[4];
#pragma unroll
            for (int k = 0; k < 4; ++k) { w0[k] = cw[k * 768 + ch]; w1[k] = cw[k * 768 + ch + 1]; }
            const float b0 = cb[ch], b1 = cb[ch + 1];
            const bf16* pin = P + ((size_t)b * SEQ + t0) * NP + XOFF + ch;
            unsigned h0 = 0u, h1 = 0u, h2 = 0u;
            if (t0 > 0) { h0 = *(const unsigned*)(pin - 3 * (ptrdiff_t)NP); h1 = *(const unsigned*)(pin - 2 * (ptrdiff_t)NP); h2 = *(const unsigned*)(pin - (ptrdiff_t)NP); }
#pragma unroll 1
            for (int tq = 0; tq < 4; ++tq) {
                unsigned r[16];
#pragma unroll
                for (int j = 0; j < 16; ++j) r[j] = *(const unsigned*)(pin + (size_t)(16 * tq + j) * NP);
#pragma unroll
                for (int tg4 = 0; tg4 < 4; ++tg4) { const int tg = 4 * tq + tg4;
                    const unsigned in[7] = {tg4 == 0 ? h0 : r[4 * tg4 - 3], tg4 == 0 ? h1 : r[4 * tg4 - 2], tg4 == 0 ? h2 : r[4 * tg4 - 1], r[4 * tg4], r[4 * tg4 + 1], r[4 * tg4 + 2], r[4 * tg4 + 3]};
                    float y0[4], y1[4];
#pragma unroll
                    for (int j = 0; j < 4; ++j) { float a0 = b0, a1 = b1;
#pragma unroll
                        for (int k = 0; k < 4; ++k) { a0 += w0[k] * bflo(in[j + k]); a1 += w1[k] * bfhi(in[j + k]); }
                        y0[j] = silu_f(a0); y1[j] = silu_f(a1); }
                    const v2u t0v = (v2u){pk2(y0[0], y0[1]), pk2(y0[2], y0[3])}, t1v = (v2u){pk2(y1[0], y1[1]), pk2(y1[2], y1[3])};
                    if (ch < 512) { *(LAS v2u*)(XT + ch * XTS + 4 * tg) = t0v; *(LAS v2u*)(XT + (ch + 1) * XTS + 4 * tg) = t1v; }
                    else if (ch < 640) { const int nb = ch - 512; *(LAS v2u*)(BT + nb * XTS + 4 * tg) = t0v; *(LAS v2u*)(BT + (nb + 1) * XTS + 4 * tg) = t1v;
#pragma unroll
                        for (int j = 0; j < 4; ++j) *(LAS unsigned*)(BN + (4 * tg + j) * BNS + nb) = pk2(y0[j], y1[j]); }
                    else { const int nc = ch - 640;
#pragma unroll
                        for (int j = 0; j < 4; ++j) { const unsigned pk = pk2(y0[j], y1[j]); *(LAS unsigned*)(CN + (4 * tg + j) * BNS + nc) = pk; *(unsigned*)(CC + (r0 + 4 * tg + j) * 128 + nc) = pk; } }
                }
                h0 = r[13]; h1 = r[14]; h2 = r[15];
            }
        }
        { const int h = F.wave, l = lane; const float xx = bf2f(P[(r0 + l) * NP + DTOFF + h]) + dt_bias[h]; const float dt = xx > 20.f ? xx : log1pf(__expf(xx));
          const float A = -__expf(A_log[h]); float cs = dt * A;
#pragma unroll
          for (int o = 1; o < 64; o <<= 1) { const float tmp = __shfl_up(cs, o); if (l >= o) cs += tmp; }
          const float last = __shfl(cs, 63);
          DTH[h * 64 + l] = dt; ACH[h * 64 + l] = cs; WLH[h * 64 + l] = __expf(last - cs) * dt;
          EA[(r0 + l) * 8 + h] = __expf(cs); if (l == 63) CD[(size_t)u * 8 + h] = __expf(cs); }
        __syncthreads();
        { const int g = F.wave >> 2, mt = F.wave & 3;
          const bf16x8 c0 = *(const LAS bf16x8*)(CN + (16 * mt + fr) * BNS + g * 64 + 8 * fq), c1 = *(const LAS bf16x8*)(CN + (16 * mt + fr) * BNS + g * 64 + 32 + 8 * fq);
#pragma unroll 1
          for (int nt = 0; nt <= mt; ++nt) {
              const bf16x8 b0 = *(const LAS bf16x8*)(BN + (16 * nt + fr) * BNS + g * 64 + 8 * fq), b1 = *(const LAS bf16x8*)(BN + (16 * nt + fr) * BNS + g * 64 + 32 + 8 * fq);
              f32x4v acc = (f32x4v){0.f, 0.f, 0.f, 0.f};
              acc = __builtin_amdgcn_mfma_f32_16x16x32_bf16(b0, c0, acc, 0, 0, 0); acc = __builtin_amdgcn_mfma_f32_16x16x32_bf16(b1, c1, acc, 0, 0, 0);
              *(LAS v2u*)(GG + (g * 64 + 16 * mt + fr) * XTS + 16 * nt + 4 * fq) = (v2u){pk2(acc[0], acc[1]), pk2(acc[2], acc[3])}; } }
        __syncthreads();
        { const int h = F.wave, g = h >> 2;
          bf16x8 xa[4][2];
#pragma unroll
          for (int nt = 0; nt < 4; ++nt)
#pragma unroll
              for (int ks = 0; ks < 2; ++ks) xa[nt][ks] = *(const LAS bf16x8*)(XT + (h * 64 + 16 * nt + fr) * XTS + 32 * ks + 8 * fq);
          {
            f32x4v acc[4][4];
#pragma unroll
            for (int nt = 0; nt < 4; ++nt)
#pragma unroll
                for (int mt = 0; mt < 4; ++mt) acc[nt][mt] = (f32x4v){0.f, 0.f, 0.f, 0.f};
#pragma unroll
            for (int mt = 0; mt < 4; ++mt)
#pragma unroll
                for (int ks = 0; ks < 2; ++ks) if (32 * ks <= 16 * mt + 15) {
                    const int l = 16 * mt + fr, s0 = 32 * ks + 8 * fq;
                    float gf[8]; unpack8(*(const LAS v4u*)(GG + (g * 64 + l) * XTS + s0), gf);
                    const float al = ACH[h * 64 + l]; const f32x4 a0 = *(const LAS f32x4*)(ACH + h * 64 + s0), a1 = *(const LAS f32x4*)(ACH + h * 64 + s0 + 4), d0 = *(const LAS f32x4*)(DTH + h * 64 + s0), d1 = *(const LAS f32x4*)(DTH + h * 64 + s0 + 4);
                    float mf[8];
#pragma unroll
                    for (int j = 0; j < 4; ++j) { mf[j] = (s0 + j <= l) ? gf[j] * __expf(al - a0[j]) * d0[j] : 0.f; mf[4 + j] = (s0 + 4 + j <= l) ? gf[4 + j] * __expf(al - a1[j]) * d1[j] : 0.f; }
                    const bf16x8 mfr = __builtin_bit_cast(bf16x8, pack8(mf));
#pragma unroll
                    for (int nt = 0; nt < 4; ++nt) acc[nt][mt] = __builtin_amdgcn_mfma_f32_16x16x32_bf16(xa[nt][ks], mfr, acc[nt][mt], 0, 0, 0);
                }
            const float Dh = Dp[h];
#pragma unroll
            for (int mt = 0; mt < 4; ++mt)
#pragma unroll
                for (int nt = 0; nt < 4; ++nt) { const int l = 16 * mt + fr, p0 = 16 * nt + 4 * fq; float o[4];
#pragma unroll
                    for (int r = 0; r < 4; ++r) o[r] = acc[nt][mt][r] + Dh * bf2f(XT[(h * 64 + p0 + r) * XTS + l]);
                    *(v2u*)(Y + (r0 + l) * DM + 256 + h * 64 + p0) = (v2u){pk2(o[0], o[1]), pk2(o[2], o[3])}; }
          }
          {
#pragma unroll
            for (int ks = 0; ks < 2; ++ks) { const f32x4 w0 = *(const LAS f32x4*)(WLH + h * 64 + 32 * ks + 8 * fq), w1 = *(const LAS f32x4*)(WLH + h * 64 + 32 * ks + 8 * fq + 4);
#pragma unroll
                for (int nt = 0; nt < 4; ++nt) { float f[8]; unpack8(__builtin_bit_cast(v4u, xa[nt][ks]), f);
#pragma unroll
                    for (int j = 0; j < 4; ++j) { f[j] *= w0[j]; f[4 + j] *= w1[j]; }
                    xa[nt][ks] = __builtin_bit_cast(bf16x8, pack8(f)); } }
            f32x4v acc[4][4];
#pragma unroll
            for (int n4 = 0; n4 < 4; ++n4)
#pragma unroll
                for (int pt = 0; pt < 4; ++pt) acc[n4][pt] = (f32x4v){0.f, 0.f, 0.f, 0.f};
#pragma unroll
            for (int n4 = 0; n4 < 4; ++n4)
#pragma unroll
                for (int ks = 0; ks < 2; ++ks) { const bf16x8 bt = *(const LAS bf16x8*)(BT + (g * 64 + 16 * n4 + fr) * XTS + 32 * ks + 8 * fq);
#pragma unroll
                    for (int pt = 0; pt < 4; ++pt) acc[n4][pt] = __builtin_amdgcn_mfma_f32_16x16x32_bf16(bt, xa[pt][ks], acc[n4][pt], 0, 0, 0); }
#pragma unroll
            for (int n4 = 0; n4 < 4; ++n4)
#pragma unroll
                for (int pt = 0; pt < 4; ++pt) *(v2u*)(ST + (((size_t)u * 8 + h) * 64 + 16 * pt + fr) * 64 + 16 * n4 + 4 * fq) = (v2u){pk2(acc[n4][pt][0], acc[n4][pt][1]), pk2(acc[n4][pt][2], acc[n4][pt][3])};
          }
        }
    }
    __syncthreads();
}
__device__ __forceinline__ void convert_tables(const int lane, const float* pu, const float* pv, const float* w2, unsigned char* ws, int L, int wid, int nw) {
    unsigned char* U8 = ws + WS_U8; unsigned char* V8 = ws + WS_V8; float* USc = (float*)(ws + WS_US); float* VSc = (float*)(ws + WS_VS);
    float w2q[16];
#pragma unroll
    for (int j = 0; j < 4; ++j) { const f32x4 w_ = *(const f32x4*)(w2 + lane * 16 + 4 * j); w2q[4 * j] = w_[0]; w2q[4 * j + 1] = w_[1]; w2q[4 * j + 2] = w_[2]; w2q[4 * j + 3] = w_[3]; }
#pragma unroll 1
    for (int r = wid; r < 2 * 16384; r += nw) {
        const bool isv = r >= 16384; const int rl = isv ? r - 16384 : r; const int rr = L * 16384 + rl; const float* src = (isv ? pv : pu) + (size_t)rr * DM + lane * 16;
        f32x4 v[4]; float am = 0.f;
#pragma unroll
        for (int j = 0; j < 4; ++j) { v[j] = *(const f32x4*)(src + 4 * j);
            if (!isv) { v[j][0] *= w2q[4 * j]; v[j][1] *= w2q[4 * j + 1]; v[j][2] *= w2q[4 * j + 2]; v[j][3] *= w2q[4 * j + 3]; }
            am = fmaxf(am, fmaxf(fmaxf(fabsf(v[j][0]), fabsf(v[j][1])), fmaxf(fabsf(v[j][2]), fabsf(v[j][3])))); }
        am = fmaxf(am, dppf<0xB1>(am)); am = fmaxf(am, dppf<0x4E>(am)); am = fmaxf(am, dppf<0x141>(am)); am = fmaxf(am, dppf<0x128>(am));
        { const auto r16 = __builtin_amdgcn_permlane16_swap(__float_as_uint(am), __float_as_uint(am), false, false); am = fmaxf(__uint_as_float(r16[0]), __uint_as_float(r16[1]));
          const auto r32 = __builtin_amdgcn_permlane32_swap(__float_as_uint(am), __float_as_uint(am), false, false); am = fmaxf(__uint_as_float(r32[0]), __uint_as_float(r32[1])); }
        if (isv) {
            const float sc = am > 0.f ? 6.0f / am : 0.f;
            v2u o;
#pragma unroll
            for (int h = 0; h < 2; ++h) { unsigned w = 0u;
                w = __builtin_amdgcn_cvt_scalef32_pk_fp4_f32(w, v[2 * h][0] * sc, v[2 * h][1] * sc, 1.0f, 0); w = __builtin_amdgcn_cvt_scalef32_pk_fp4_f32(w, v[2 * h][2] * sc, v[2 * h][3] * sc, 1.0f, 1);
                w = __builtin_amdgcn_cvt_scalef32_pk_fp4_f32(w, v[2 * h + 1][0] * sc, v[2 * h + 1][1] * sc, 1.0f, 2); w = __builtin_amdgcn_cvt_scalef32_pk_fp4_f32(w, v[2 * h + 1][2] * sc, v[2 * h + 1][3] * sc, 1.0f, 3);
                o[h] = w; }
            *(v2u*)(V8 + (size_t)L * 16384 * DM + (size_t)(lane >> 4) * (16384 * 128) + (size_t)rl * 128 + (lane & 15) * 8) = o;
            if (lane == 0) VSc[rr] = am * (1.0f / 6.0f);
        } else {
            const float sc = am > 0.f ? 7.0f / am : 0.f;
            v2u o;
#pragma unroll
            for (int h = 0; h < 2; ++h) { unsigned w = 0u;
#pragma unroll
                for (int k = 0; k < 8; ++k) w |= ((unsigned)__float2int_rn(v[2 * h + (k >> 2)][k & 3] * sc) & 15u) << (4 * k);
                o[h] = w; }
            *(v2u*)(U8 + (size_t)L * 16384 * DM + (size_t)(lane >> 4) * (16384 * 128) + (size_t)rl * 128 + (lane & 15) * 8) = o;
            if (lane == 0) USc[rr] = am * (1.0f / 7.0f);
        }
    }
}
__device__ __forceinline__ void ssd_scan(const Ctx F, bf16* ST, const float* CD, bool dry) {
    if (F.tid < 128) for (int e = F.vcu * 128 + F.tid; e < BATCH * 16384; e += F.G * 128) {
        const int b = e >> 14, hpn2 = e & 16383, h = hpn2 >> 11; float r0 = 0.f, r1 = 0.f;
        unsigned* sp = (unsigned*)ST + ((size_t)b * NCHUNK << 14) + hpn2; const float* dp = CD + (size_t)b * NCHUNK * 8 + h;
#pragma unroll 1
        for (int c = 0; c < NCHUNK; c += 32) { unsigned s[32]; float d[32];
#pragma unroll
            for (int i = 0; i < 32; ++i) { s[i] = sp[(size_t)(c + i) << 14]; d[i] = dp[(c + i) * 8]; }
#pragma unroll
            for (int i = 0; i < 32; ++i) { if (!dry) sp[(size_t)(c + i) << 14] = pk2(r0, r1); r0 = r0 * d[i] + bflo(s[i]); r1 = r1 * d[i] + bfhi(s[i]); } }
        asm volatile("" :: "v"(r0), "v"(r1));
    }
}
__device__ __forceinline__ void ssd_part2(const Ctx F, const bf16* P, bf16* Y, const bf16* CC, const float* EA, const bf16* ST, const float* nw  , bool dry) {
    LAS float* SSH = (LAS float*)F.lds;
    const int lane = F.lane, fr = lane & 15, fq = lane >> 4, h = F.wave, g = h >> 2;
#pragma unroll 1
    for (int u = F.vcu; u < BATCH * NCHUNK; u += F.G) {
        const int b = u / NCHUNK, c = u % NCHUNK; const size_t r0 = (size_t)b * SEQ + c * 64;
        bf16x8 pa[4][2], cbf[4][2];
#pragma unroll
        for (int pt = 0; pt < 4; ++pt)
#pragma unroll
            for (int ks = 0; ks < 2; ++ks) { pa[pt][ks] = __builtin_bit_cast(bf16x8, *(const v4u*)(ST + (((size_t)u * 8 + h) * 64 + 16 * pt + fr) * 64 + 32 * ks + 8 * fq));
                cbf[pt][ks] = __builtin_bit_cast(bf16x8, *(const v4u*)(CC + (r0 + 16 * pt + fr) * 128 + g * 64 + 32 * ks + 8 * fq)); }
        v2u yv4[4][4], zv4[4][4]; float ea4[4];
#pragma unroll
        for (int lt = 0; lt < 4; ++lt) { const int l = 16 * lt + fr; ea4[lt] = EA[(r0 + l) * 8 + h];
#pragma unroll
            for (int pt = 0; pt < 4; ++pt) { const int p0 = 16 * pt + 4 * fq; yv4[lt][pt] = *(const v2u*)(Y + (r0 + l) * DM + 256 + h * 64 + p0); zv4[lt][pt] = *(const v2u*)(P + (r0 + l) * NP + ZOFF + h * 64 + p0); } }
        f32x4v acc[4][4];
#pragma unroll
        for (int pt = 0; pt < 4; ++pt)
#pragma unroll
            for (int lt = 0; lt < 4; ++lt) { acc[pt][lt] = (f32x4v){0.f, 0.f, 0.f, 0.f};
#pragma unroll
                for (int ks = 0; ks < 2; ++ks) acc[pt][lt] = __builtin_amdgcn_mfma_f32_16x16x32_bf16(pa[pt][ks], cbf[lt][ks], acc[pt][lt], 0, 0, 0); }
        float ssl[4];
#pragma unroll
        for (int lt = 0; lt < 4; ++lt) { const float ea = ea4[lt]; ssl[lt] = 0.f;
#pragma unroll
            for (int pt = 0; pt < 4; ++pt) { const v2u yv = yv4[lt][pt], zv = zv4[lt][pt];
                const float yd[4] = {bflo(yv.x), bfhi(yv.x), bflo(yv.y), bfhi(yv.y)}, zz[4] = {bflo(zv.x), bfhi(zv.x), bflo(zv.y), bfhi(zv.y)};
#pragma unroll
                for (int r = 0; r < 4; ++r) { const float v = (yd[r] + ea * acc[pt][lt][r]) * silu_f(zz[r]); acc[pt][lt][r] = v; ssl[lt] += v * v; } } }
        __syncthreads();
#pragma unroll
        for (int lt = 0; lt < 4; ++lt) { const float s = sum_x32(sum_x16(ssl[lt])); if (fq == 0) SSH[h * 64 + 16 * lt + fr] = s; }
        __syncthreads();
#pragma unroll
        for (int lt = 0; lt < 4; ++lt) { const int l = 16 * lt + fr; float t = 0.f;
#pragma unroll
            for (int hh = 0; hh < 8; ++hh) t += SSH[hh * 64 + l];
            const float rstd = 1.0f / sqrtf(t * (1.0f / 512.0f) + EPS);
#pragma unroll
            for (int pt = 0; pt < 4; ++pt) { const int p0 = 16 * pt + 4 * fq; const f32x4 w4 = *(const f32x4*)(nw + h * 64 + p0);
                const v2u o = (v2u){pk2(acc[pt][lt][0] * rstd * w4[0], acc[pt][lt][1] * rstd * w4[1]), pk2(acc[pt][lt][2] * rstd * w4[2], acc[pt][lt][3] * rstd * w4[3])};
                if (!dry) *(v2u*)(Y + (r0 + l) * DM + 256 + h * 64 + p0) = o; } }
    }
}
constexpr int L7_EI = 0, L7_CF = 16384, L7_PT = L7_CF + 32768, L7_RS = L7_PT + 32768, L7_SSQ = L7_RS + 512, L7_W2 = L7_SSQ + 512, L7_SCL = L7_W2 + 4096, L7_END = L7_SCL + 8 * 9216;
static_assert(L7_END <= LDSCTL_OFF, "PEER LDS");
__device__ __forceinline__ unsigned mk_key(float f, unsigned idx) { const unsigned u = __float_as_uint(f); unsigned k = (u & 0x80000000u) ? ~u : (u | 0x80000000u); return (k & ~127u) | (127u - idx); }
__device__ __forceinline__ float key_val(unsigned k) { const unsigned kk = k & ~127u; return __uint_as_float((kk & 0x80000000u) ? (kk & 0x7fffffffu) : ~kk); }
__device__ __forceinline__ void ce_desc(unsigned& a, unsigned& b) { const unsigned hi = a > b ? a : b; const unsigned lo = a > b ? b : a; a = hi; b = lo; }
__device__ __forceinline__ void bitonic_sort16_desc(unsigned (&v)[16]) {
#pragma unroll
    for (int k = 2; k <= 16; k <<= 1)
#pragma unroll
        for (int j = k >> 1; j > 0; j >>= 1)
#pragma unroll
            for (int i = 0; i < 16; ++i) { const int l = i ^ j; if (l > i) { if ((i & k) == 0) ce_desc(v[i], v[l]); else ce_desc(v[l], v[i]); } }
}
__device__ __forceinline__ void bitonic_merge16_desc(unsigned (&v)[16]) {
#pragma unroll
    for (int j = 8; j > 0; j >>= 1)
#pragma unroll
        for (int i = 0; i < 16; ++i) { const int l = i ^ j; if (l > i) ce_desc(v[i], v[l]); }
}
__device__ __forceinline__ void topk16_slice(const float* sp, unsigned (&lst)[16]) {
    { const f32x4 a = *(const f32x4*)sp, b = *(const f32x4*)(sp + 4), c = *(const f32x4*)(sp + 8), d = *(const f32x4*)(sp + 12);
#pragma unroll
      for (int e = 0; e < 4; ++e) { lst[e] = mk_key(a[e], (unsigned)e); lst[4 + e] = mk_key(b[e], (unsigned)(4 + e)); lst[8 + e] = mk_key(c[e], (unsigned)(8 + e)); lst[12 + e] = mk_key(d[e], (unsigned)(12 + e)); } }
    bitonic_sort16_desc(lst);
#pragma unroll 1
    for (int ch = 1; ch < 8; ++ch) { unsigned cv[16];
        const f32x4 a = *(const f32x4*)(sp + 16 * ch), b = *(const f32x4*)(sp + 16 * ch + 4), c = *(const f32x4*)(sp + 16 * ch + 8), d = *(const f32x4*)(sp + 16 * ch + 12);
#pragma unroll
        for (int e = 0; e < 4; ++e) { cv[e] = mk_key(a[e], (unsigned)(16 * ch + e)); cv[4 + e] = mk_key(b[e], (unsigned)(16 * ch + 4 + e)); cv[8 + e] = mk_key(c[e], (unsigned)(16 * ch + 8 + e)); cv[12 + e] = mk_key(d[e], (unsigned)(16 * ch + 12 + e)); }
        bitonic_sort16_desc(cv);
#pragma unroll
        for (int q = 0; q < 16; ++q) lst[q] = lst[q] > cv[15 - q] ? lst[q] : cv[15 - q];
        bitonic_merge16_desc(lst); }
}
typedef float f32x2 __attribute__((ext_vector_type(2)));
__device__ __forceinline__ void dec16(const v4u q, float (&f)[16]) {
#pragma unroll
    for (int w = 0; w < 4; ++w) { const f32x2 lo = __builtin_amdgcn_cvt_pk_f32_fp8((int)q[w], false), hi = __builtin_amdgcn_cvt_pk_f32_fp8((int)q[w], true);
        f[4 * w] = lo.x; f[4 * w + 1] = lo.y; f[4 * w + 2] = hi.x; f[4 * w + 3] = hi.y; }
}
__device__ __forceinline__ void peer_phase(const Ctx F, const float* SC, const float* SS2, const unsigned char* U8, const unsigned char* V8, const float* US, const float* VS, const float* w2  ,
                                           const bf16* X1B  , unsigned char* HQ  , bf16* XB  , float* RS1  , float* OUT  , const float* fw  , bool last, bool dry, int dry2, const void* ST_CODE = nullptr) {
    LAS unsigned short* EI = (LAS unsigned short*)(F.lds + L7_EI); LAS float* CF = (LAS float*)(F.lds + L7_CF); LAS float* PT = (LAS float*)(F.lds + L7_PT);
    LAS float* RS = (LAS float*)(F.lds + L7_RS); LAS float* SSQ = (LAS float*)(F.lds + L7_SSQ); LAS float* W2L = (LAS float*)(F.lds + L7_W2);
#pragma unroll 1
    for (int tile = F.vcu; tile < M / 128; tile += F.G) {
        int lane_o = F.lane; asm volatile("" : "+v"(lane_o));
        const int g = lane_o >> 3, i = lane_o & 7;
        __syncthreads();
        {
            const int tokl = F.tid >> 2, hh = F.tid & 3; const size_t row = (size_t)tile * 128 + tokl;
            unsigned l0[16], l1[16];
            topk16_slice(SC + row * 1024 + hh * 256, l0); topk16_slice(SC + row * 1024 + hh * 256 + 128, l1);
            float s0[16], s1[16];
#pragma unroll
            for (int j = 0; j < 16; ++j) { s0[j] = key_val(l0[j]); s1[j] = key_val(l1[j]); }
            {
                LAS unsigned* slot = (LAS unsigned*)(PT + tokl * 64 + hh * 16);
#pragma unroll
                for (int j = 0; j < 8; ++j) { slot[j] = (127u - (l0[2 * j] & 127u)) | ((127u - (l0[2 * j + 1] & 127u)) << 16); slot[8 + j] = (127u - (l1[2 * j] & 127u)) | ((127u - (l1[2 * j + 1] & 127u)) << 16); } }
            unsigned best[16];
#define CKEY(i_, j_) ((({ const unsigned u_ = __float_as_uint(s0[i_] + s1[j_]); (u_ & 0x80000000u) ? ~u_ : (u_ | 0x80000000u); }) & ~255u) | (255u - (unsigned)(16 * (i_) + (j_))))
#pragma unroll
            for (int j = 0; j < 16; ++j) best[j] = CKEY(0, j);
#pragma unroll
            for (int ii = 1; ii < 8; ++ii) { constexpr int NR[8] = {16, 8, 5, 4, 3, 2, 2, 2};
#pragma unroll
                for (int j = 0; j < 16; ++j) if (j < NR[ii]) { const unsigned c = CKEY(ii, j); best[15 - j] = best[15 - j] > c ? best[15 - j] : c; }
                bitonic_merge16_desc(best); }
#pragma unroll
            for (int ii = 8; ii < 16; ++ii) { unsigned k = CKEY(ii, 0);
#pragma unroll
                for (int q = 0; q < 16; ++q) { const unsigned hi = best[q] > k ? best[q] : k; k = best[q] > k ? k : best[q]; best[q] = hi; } }
#undef CKEY
            float e[16], bv[16], sum = 0.f;
#pragma unroll
            for (int j = 0; j < 16; ++j) { const unsigned kk = best[j] & ~255u; bv[j] = __uint_as_float((kk & 0x80000000u) ? (kk & 0x7fffffffu) : ~kk); }
#pragma unroll
            for (int j = 0; j < 16; ++j) { e[j] = __expf(bv[j] - bv[0]); sum += e[j]; }
            const float inv = 1.0f / sum;
            { const LAS unsigned short* slot = (const LAS unsigned short*)(PT + tokl * 64 + hh * 16);
#pragma unroll
              for (int j = 0; j < 16; ++j) { const unsigned pos = 255u - (best[j] & 255u); const unsigned ex = (unsigned)slot[pos >> 4] * 128u + (unsigned)slot[16 + (pos & 15u)];
                  EI[tokl * 64 + hh * 16 + j] = (unsigned short)ex; CF[tokl * 64 + hh * 16 + j] = e[j] * inv; } }
        }
        if (F.tid < 256) *(LAS f32x4*)(W2L + 4 * F.tid) = *(const f32x4*)(w2 + 4 * F.tid);
        if (F.lane < 16) { const int tok = F.wave * 16 + F.lane; const f32x4* sp = (const f32x4*)(SS2 + ((size_t)tile * 128 + tok) * 16); const f32x4 a = sp[0], b = sp[1], c = sp[2], d = sp[3];
            const float t = ((a[0] + a[1]) + (a[2] + a[3])) + ((b[0] + b[1]) + (b[2] + b[3])) + ((c[0] + c[1]) + (c[2] + c[3])) + ((d[0] + d[1]) + (d[2] + d[3]));
            RS[tok] = 1.0f / sqrtf(t * (1.0f / DM) + EPS); SSQ[tok] = 0.f; }
        __syncthreads();
        {
#pragma unroll 1
            for (int t4 = 0; t4 < 16; t4 += 4) {
                v4u xr[4][2];
#pragma unroll
                for (int u = 0; u < 4; ++u) { const size_t row = (size_t)tile * 128 + F.wave * 16 + t4 + u; xr[u][0] = *(const v4u*)(X1B + row * DM + lane_o * 16); xr[u][1] = *(const v4u*)(X1B + row * DM + lane_o * 16 + 8); }
#pragma unroll
                for (int u = 0; u < 4; ++u) { const int tok = F.wave * 16 + t4 + u; const size_t row = (size_t)tile * 128 + tok;
                    float hv[16]; { float t8[8]; unpack8(xr[u][0], t8);
#pragma unroll
                        for (int q = 0; q < 8; ++q) hv[q] = t8[q];
                        unpack8(xr[u][1], t8);
#pragma unroll
                        for (int q = 0; q < 8; ++q) hv[8 + q] = t8[q]; }
                    float am = 0.f;
#pragma unroll
                    for (int q = 0; q < 16; ++q) am = fmaxf(am, fabsf(hv[q]));
                    am = fmaxf(am, dppf<0xB1>(am)); am = fmaxf(am, dppf<0x4E>(am)); am = fmaxf(am, dppf<0x141>(am)); am = fmaxf(am, dppf<0x128>(am));
                    { const auto r16 = __builtin_amdgcn_permlane16_swap(__float_as_uint(am), __float_as_uint(am), false, false); am = fmaxf(__uint_as_float(r16[0]), __uint_as_float(r16[1]));
                      const auto r32 = __builtin_amdgcn_permlane32_swap(__float_as_uint(am), __float_as_uint(am), false, false); am = fmaxf(__uint_as_float(r32[0]), __uint_as_float(r32[1])); }
                    const float s1 = am > 0.f ? 119.0f / am : 0.f;
                    v2u hi, lo;
#pragma unroll
                    for (int h = 0; h < 2; ++h) { unsigned hw_ = 0u, lw_ = 0u;
#pragma unroll
                        for (int k = 0; k < 8; ++k) { const int qv = __float2int_rn(hv[8 * h + k] * s1); lw_ |= ((unsigned)qv & 15u) << (4 * k); hw_ |= ((unsigned)((qv + 8) >> 4) & 15u) << (4 * k); }
                        hi[h] = hw_; lo[h] = lw_; }
                    unsigned char* hp = HQ + row * 1024 + (lane_o >> 4) * 256 + ((lane_o & 15) >> 1) * 32 + (lane_o & 1) * 8;
                    *(v2u*)hp = hi; *(v2u*)(hp + 16) = lo;
                    if (lane_o == 0) SSQ[tok] = am * (1.0f / 119.0f);
                }
            }
            asm volatile("s_waitcnt vmcnt(0)" ::: "memory");
        }
#define U_LOAD(it_, Q, X) do { const int s_ = (it_) >> 4, tok_ = F.wave * 16 + ((it_) & 15); \
            _Pragma("unroll") for (int j = 0; j < 8; ++j) { const unsigned e_ = EI[tok_ * 64 + 8 * j + g]; Q[j] = *(const v4u*)(U8 + (size_t)s_ * (16384 * 128) + (size_t)e_ * 128 + 16 * i); } \
            const unsigned char* xp_ = HQ + ((size_t)tile * 128 + tok_) * 1024 + 256 * s_ + 32 * i; \
            X[0] = *(const v4u*)xp_; X[1] = *(const v4u*)(xp_ + 16); } while (0)
#define U_COMP(it_, Q, X) do { const int s_ = (it_) >> 4, tok_ = F.wave * 16 + ((it_) & 15); \
            float d[8]; \
            _Pragma("unroll") for (int j = 0; j < 8; ++j) { int a_ = 0, b_ = 0; \
                _Pragma("unroll") for (int w = 0; w < 4; ++w) { a_ = __builtin_amdgcn_sdot8((int)Q[j][w], (int)X[0][w], a_, false); b_ = __builtin_amdgcn_sdot8((int)Q[j][w], (int)X[1][w], b_, false); } \
                d[j] = (float)(a_ * 16 + b_); } \
            float d2[4], d3[2]; \
            _Pragma("unroll") for (int m = 0; m < 4; ++m) { const float snd = (i & 4) ? d[m] : d[4 + m]; const float kp = (i & 4) ? d[4 + m] : d[m]; d2[m] = kp + dppf<0x141>(snd); }     \
            _Pragma("unroll") for (int m = 0; m < 2; ++m) { const float snd = (i & 2) ? d2[m] : d2[2 + m]; const float kp = (i & 2) ? d2[2 + m] : d2[m]; d3[m] = kp + dppf<0x4E>(snd); } \
            const float snd = (i & 1) ? d3[0] : d3[1]; const float kp = (i & 1) ? d3[1] : d3[0]; const float tot = kp + dppf<0xB1>(snd); \
            const int pi = tok_ * 64 + 8 * i + g; PT[pi] = (s_ == 0) ? tot : PT[pi] + tot; } while (0)
        {
            v4u qa[8], qb[8]; v4u xa[2], xb[2];
            U_LOAD(0, qa, xa);
#pragma unroll 1
            for (int it = 0; it < 64; it += 2) {
                U_LOAD(it + 1, qb, xb);
                U_COMP(it, qa, xa);
                { const int itn = (it + 2 < 64) ? it + 2 : 63; U_LOAD(itn, qa, xa); }
                U_COMP(it + 1, qb, xb);
            }
        }
#undef U_LOAD
#undef U_COMP
#pragma unroll 1
        for (int n = 0; n < 16; ++n) { const int idx = (F.wave * 16 + n) * 64 + F.lane; const unsigned e = EI[idx]; const float dd = PT[idx] * US[e] * (RS[F.wave * 16 + n] * SSQ[F.wave * 16 + n]);
            CF[idx] = CF[idx] * (0.5f * dd * (1.0f + erff(dd * 0.70710678118654752f))) * VS[e]; }
#define V_LOAD(it_, Q, X) do { const int s_ = (it_) >> 4, tok_ = F.wave * 16 + ((it_) & 15); \
            _Pragma("unroll") for (int j = 0; j < 8; ++j) { const unsigned e_ = EI[tok_ * 64 + 8 * j + g]; Q[j] = *(const v4u*)(V8 + (size_t)s_ * (16384 * 128) + (size_t)e_ * 128 + 16 * i); } \
            X = *(const v2u*)(X1B + ((size_t)tile * 128 + tok_) * DM + 256 * s_ + vd); } while (0)
#define V_DEC(Q, w_, b_) { const f32x2 r_ = __builtin_amdgcn_cvt_scalef32_pk_f32_fp4(Q[j][w_], 1.0f, b_); o[4 * (w_) + (b_)] = __builtin_elementwise_fma(r_, c2_, o[4 * (w_) + (b_)]); }
#define V_COMP(it_, Q, X) do { const int s_ = (it_) >> 4, tok_ = F.wave * 16 + ((it_) & 15); f32x2 o[16]; \
            _Pragma("unroll") for (int m = 0; m < 16; ++m) o[m] = (f32x2){0.f, 0.f}; \
            _Pragma("unroll") for (int j = 0; j < 8; ++j) { const float cf_ = CF[tok_ * 64 + 8 * j + g]; const f32x2 c2_ = (f32x2){cf_, cf_}; \
                V_DEC(Q, 0, 0) V_DEC(Q, 0, 1) V_DEC(Q, 0, 2) V_DEC(Q, 0, 3) V_DEC(Q, 1, 0) V_DEC(Q, 1, 1) V_DEC(Q, 1, 2) V_DEC(Q, 1, 3) V_DEC(Q, 2, 0) V_DEC(Q, 2, 1) V_DEC(Q, 2, 2) V_DEC(Q, 2, 3) V_DEC(Q, 3, 0) V_DEC(Q, 3, 1) V_DEC(Q, 3, 2) V_DEC(Q, 3, 3) } \
            float o2[16], o3[8], o4[4]; \
            _Pragma("unroll") for (int m = 0; m < 16; ++m) { const auto rr_ = __builtin_amdgcn_permlane32_swap(__float_as_uint(o[8 + (m >> 1)][m & 1]), __float_as_uint(o[m >> 1][m & 1]), false, false); o2[m] = __uint_as_float(rr_[0]) + __uint_as_float(rr_[1]); }     \
            _Pragma("unroll") for (int m = 0; m < 8; ++m) { const auto rr_ = __builtin_amdgcn_permlane16_swap(__float_as_uint(o2[8 + m]), __float_as_uint(o2[m]), false, false); o3[m] = __uint_as_float(rr_[0]) + __uint_as_float(rr_[1]); }     \
            _Pragma("unroll") for (int m = 0; m < 4; ++m) { const float snd = (g & 1) ? o3[m] : o3[4 + m]; const float kp = (g & 1) ? o3[4 + m] : o3[m]; o4[m] = kp + dppf<0x128>(snd); } \
            const float y0 = bflo(X[0]) + o4[0], y1 = bfhi(X[0]) + o4[1], y2 = bflo(X[1]) + o4[2], y3 = bfhi(X[1]) + o4[3]; \
            if (!dry) { v2u yo_; yo_[0] = pk2(y0, y1); yo_[1] = pk2(y2, y3); *(v2u*)(XB + ((size_t)tile * 128 + tok_) * DM + 256 * s_ + vd) = yo_; } \
            } while (0)
        {
            const int vd = 32 * i + 16 * (1 - ((g >> 2) & 1)) + 8 * (1 - ((g >> 1) & 1)) + 4 * (g & 1);
            v4u qa[8], qb[8]; v2u xa, xb;
            V_LOAD(0, qa, xa);
#pragma unroll 1
            for (int it = 0; it < 64; it += 2) {
                V_LOAD(it + 1, qb, xb);
                V_COMP(it, qa, xa);
                { const int itn = (it + 2 < 64) ? it + 2 : 63; V_LOAD(itn, qa, xa); }
                V_COMP(it + 1, qb, xb);
            }
        }
#undef V_LOAD
#undef V_COMP
#undef V_DEC
        asm volatile("s_waitcnt vmcnt(0)" ::: "memory");
        __builtin_amdgcn_fence(__ATOMIC_ACQUIRE, "agent");
        asm volatile("s_waitcnt vmcnt(0)" ::: "memory");
#pragma unroll 1
        for (int ti = 0; ti < 16; ++ti) {
            const int tok = F.wave * 16 + ti; const size_t row = (size_t)tile * 128 + tok;
            float f0[8], f1[8]; unpack8(*(const v4u*)(XB + row * DM + F.lane * 8), f0); unpack8(*(const v4u*)(XB + row * DM + 512 + F.lane * 8), f1);
            float sq = 0.f;
#pragma unroll
            for (int q = 0; q < 8; ++q) sq += f0[q] * f0[q] + f1[q] * f1[q];
            float rstd = 1.0f / sqrtf(wave_sum_v(sq) * (1.0f / DM) + EPS);
#if defined(SELFTEST)
            rstd *= 1.0f + 0.2f * (float)__hip_atomic_load((const unsigned*)ST_CODE, __ATOMIC_RELAXED, __HIP_MEMORY_SCOPE_AGENT);
#endif
            if (!last) { if (F.lane == 0 && !dry) RS1[row] = rstd; }
            else if (!dry) {
                const f32x4 c0 = *(const f32x4*)(fw + F.lane * 8), d0 = *(const f32x4*)(fw + F.lane * 8 + 4), c1 = *(const f32x4*)(fw + 512 + F.lane * 8), d1 = *(const f32x4*)(fw + 512 + F.lane * 8 + 4);
                *(f32x4*)(OUT + row * DM + F.lane * 8) = (f32x4){f0[0] * rstd * c0[0], f0[1] * rstd * c0[1], f0[2] * rstd * c0[2], f0[3] * rstd * c0[3]};
                *(f32x4*)(OUT + row * DM + F.lane * 8 + 4) = (f32x4){f0[4] * rstd * d0[0], f0[5] * rstd * d0[1], f0[6] * rstd * d0[2], f0[7] * rstd * d0[3]};
                *(f32x4*)(OUT + row * DM + 512 + F.lane * 8) = (f32x4){f1[0] * rstd * c1[0], f1[1] * rstd * c1[1], f1[2] * rstd * c1[2], f1[3] * rstd * c1[3]};
                *(f32x4*)(OUT + row * DM + 512 + F.lane * 8 + 4) = (f32x4){f1[4] * rstd * d1[0], f1[5] * rstd * d1[1], f1[6] * rstd * d1[2], f1[7] * rstd * d1[3]};
            }
        }
    }
}


#if defined(SELFTEST)
__device__ __forceinline__ float st_a(int r, int k) { return (float)(((r * 3 + k) % 5) - 2); }
__device__ __forceinline__ float st_b(int k, int c) { return (float)(((k + 2 * c) % 7) - 3); }
__device__ __forceinline__ void selftest(const Ctx F, gu32* ctl) {
    if (blockIdx.x != 0 || F.wave != 0) return;
    const int lane = F.lane, fr = lane & 15, fq = lane >> 4;
    int aw[2] = {0, 0}, bw[2] = {0, 0};
#pragma unroll
    for (int w = 0; w < 2; ++w) { aw[w] = __builtin_amdgcn_cvt_pk_fp8_f32(st_a(fr, 8 * fq + 4 * w), st_a(fr, 8 * fq + 4 * w + 1), aw[w], false); aw[w] = __builtin_amdgcn_cvt_pk_fp8_f32(st_a(fr, 8 * fq + 4 * w + 2), st_a(fr, 8 * fq + 4 * w + 3), aw[w], true);
                                  bw[w] = __builtin_amdgcn_cvt_pk_fp8_f32(st_b(8 * fq + 4 * w, fr), st_b(8 * fq + 4 * w + 1, fr), bw[w], false); bw[w] = __builtin_amdgcn_cvt_pk_fp8_f32(st_b(8 * fq + 4 * w + 2, fr), st_b(8 * fq + 4 * w + 3, fr), bw[w], true); }
    const long A = (long)(((unsigned long long)(unsigned)aw[1] << 32) | (unsigned)aw[0]), B = (long)(((unsigned long long)(unsigned)bw[1] << 32) | (unsigned)bw[0]);
    f32x4 d = (f32x4){0.f, 0.f, 0.f, 0.f};
    d = __builtin_amdgcn_mfma_f32_16x16x32_fp8_fp8(A, B, d, 0, 0, 0);
    bool ok1 = true;
#pragma unroll
    for (int r = 0; r < 4; ++r) { float e = 0.f; for (int kk = 0; kk < 32; ++kk) e += st_a(4 * fq + r, kk) * st_b(kk, fr); ok1 = ok1 && (d[r] == e); }
    const int t1 = __all(ok1) ? 1 : 0;
    LAS unsigned char* T = F.lds;
    for (int c4 = 0; c4 < 32; ++c4) { unsigned w = 0; for (int b = 0; b < 4; ++b) w |= (unsigned)((37 * lane + 11 * (4 * c4 + b)) & 127) << (8 * b); *(LAS unsigned*)(T + lane * 128 + 4 * c4) = w; }
    asm volatile("s_waitcnt lgkmcnt(0)" ::: "memory");
    int t2 = 0;
#pragma unroll
    for (int hyp = 1; hyp <= 2; ++hyp) {
        const int l16 = lane & 15; const int row = (hyp == 1) ? (l16 >> 1) : (l16 & 7), cc = (hyp == 1) ? 8 * (l16 & 1) : 8 * (l16 >> 3);
        const v2i_t v = __builtin_amdgcn_ds_read_tr8_b64_v2i32((LAS v2i_t*)(T + (8 * fq + row) * 128 + 16 + cc));
        bool ok = true;
#pragma unroll
        for (int j = 0; j < 8; ++j) { const unsigned got = ((unsigned)(j < 4 ? v.x : v.y) >> (8 * (j & 3))) & 255u; ok = ok && (got == (unsigned)((37 * (8 * fq + j) + 11 * (16 + l16)) & 127)); }
        if (__all(ok)) t2 = hyp;
    }
    if (lane == 0) __hip_atomic_store(ctl + 20, (unsigned)(t1 + 2 * t2 + 1), RLX_AGENT);
    asm volatile("s_waitcnt vmcnt(0) lgkmcnt(0)" ::: "memory");
}
#endif
__device__ __forceinline__ Ctx fresh(const Ctx F) { Ctx R = F; int t = F.tid, v = F.vcu, g = F.G; asm volatile("" : "+v"(t)); asm volatile("" : "+s"(v), "+s"(g)); R.tid = t; R.lane = t & 63; R.wave = __builtin_amdgcn_readfirstlane(t >> 6); R.vcu = v; R.G = g; return R; }
struct Args { const float* in[17]; float* out; unsigned char* ws; int ph_lo, ph_hi, li, pad; };
__global__ void __launch_bounds__(NWAVES * 64, 2) mega_fwd(Args args) {
    extern __shared__ __attribute__((aligned(16))) unsigned char lds[];
    Ctx F;
    F.lds = (LAS unsigned char*)lds;
    F.tid = threadIdx.x; F.lane = F.tid & 63; F.wave = __builtin_amdgcn_readfirstlane(F.tid >> 6);
    F.G = gridDim.x; { const int bx = blockIdx.x; F.vcu = (F.G % 8 == 0) ? (bx % 8) * (F.G / 8) + bx / 8 : bx; }
    unsigned char* ws = args.ws;
    gu32* ctl = (gu32*)(ws + WS_CTL);
    volatile LAS unsigned* MISC = (volatile LAS unsigned*)(F.lds + MISC_OFF);
    for (int u = F.tid; u < (LDS_BYTES - LDSCTL_OFF) / 4; u += NWAVES * 64) ((LAS unsigned*)(F.lds + LDSCTL_OFF))[u] = 0u;
    __syncthreads();
    XcdBarrier bar; bar.bar = (unsigned*)(ctl + CW_BAR); bar.x = 0; bar.st = nullptr;
    if (N_LAUNCHES != NPH) bar = xcd_barrier_post((unsigned*)(ctl + CW_BAR), MISC + 8);
    const int lo = args.ph_lo, hi = args.ph_hi;
#define IN(k) (lo <= (k) && (k) < hi)
#ifndef PH_MASK
#define PH_MASK 0x3ff
#endif
#define PHK(i) ((PH_MASK >> (i)) & 1)
#ifndef DUP_KIND
#define DUP_KIND (-1)
#endif
#define DUPK(i) (DUP_KIND == (i))
    const bool dry = (args.pad == 0);
#define SEAM(k) do { if (N_LAUNCHES != NPH) { if (IN(k) && IN((k) + 1)) xcd_barrier(bar); } } while (0)
    const float* x_in = args.in[0]; float* OUT = args.out;
    bf16* XNY = (bf16*)(ws + WS_XNY); bf16* XB = (bf16*)(ws + WS_XB); float* RS1 = (float*)(ws + WS_RS1); bf16* PB = (bf16*)(ws + WS_P); float* SC = (float*)(ws + WS_SC); bf16* X1B = (bf16*)(ws + WS_X1B);
    float* SS2 = (float*)(ws + WS_SS2); float* EA = (float*)(ws + WS_EA); float* CD = (float*)(ws + WS_CD); bf16* CC = (bf16*)(ws + WS_CC); bf16* ST = (bf16*)(ws + WS_ST);
#if defined(SELFTEST)
    if (IN(0)) { selftest(fresh(F), ctl); __syncthreads(); }
#endif
    if (DUPK(0) && IN(0)) p0_prologue(fresh(F), x_in, args.in[1], args.in[2], args.in[10], args.in[11], args.in[12], args.in[13], ws);
    if (PHK(0) && IN(0)) p0_prologue(fresh(F), x_in, args.in[1], args.in[2], args.in[10], args.in[11], args.in[12], args.in[13], ws);
    SEAM(0);
    if (DUPK(15) && N_LAUNCHES != NPH) { for (int r = 0; r < 10; ++r) xcd_barrier(bar); }
#pragma unroll
    for (int L = 0; L < DEPTH; ++L) {
        const int pb = 1 + 7 * L;
#pragma unroll 1
        for (int rep = 0; rep < ((DUPK(1) && L == 0) ? 2 : 1); ++rep)
        if (PHK(1) && IN(pb)) {
            pg8::Gemm g{XB, (const bf16*)(ws + WS_WIN) + (size_t)L * NP * DM, M, NP, DM}; pg8::StaticOrder S; S.init(M, NP, F.G, (int)blockIdx.x);
            pg8::EpiBf16Row E{PB, NP, RS1};
            pg8::gemm_phase<pg8::EpiBf16Row, pg8::StaticOrder, PG8_ALIGN, PG8_SP2>(F.lds, g, S, E);
        }
        SEAM(pb);
        if (IN(pb + 1)) {
            if (DUPK(2) && L == 0) ssd_part1(fresh(F), PB, XNY, args.in[3] + (size_t)L * 4 * 768, args.in[4] + L * 768, args.in[5] + L * 8, args.in[6] + L * 8, args.in[7] + L * 8, CC, EA, CD, ST);
            if (PHK(2)) ssd_part1(fresh(F), PB, XNY, args.in[3] + (size_t)L * 4 * 768, args.in[4] + L * 768, args.in[5] + L * 8, args.in[6] + L * 8, args.in[7] + L * 8, CC, EA, CD, ST);
            if (DUPK(3) && L == 0) attn_mfma(fresh(F), PB, XNY);
            if (PHK(3)) attn_mfma(fresh(F), PB, XNY);
            if (DUPK(4) && L == 0) shortconv(fresh(F), PB, XNY, args.in[9] + (size_t)L * 3 * 256);
            if (PHK(4)) shortconv(fresh(F), PB, XNY, args.in[9] + (size_t)L * 3 * 256);
        }
        SEAM(pb + 1);
        if (DUPK(5) && L == 0 && IN(pb + 2)) ssd_scan(fresh(F), ST, CD, dry);
        if (PHK(5) && IN(pb + 2)) { const Ctx Fs = fresh(F); ssd_scan(Fs, ST, CD, false); if (Fs.wave >= 2) convert_tables(Fs.lane, args.in[14], args.in[15], args.in[11] + L * DM, ws, L, Fs.vcu * 6 + (Fs.wave - 2), Fs.G * 6); }
        SEAM(pb + 2);
        if (DUPK(6) && L == 0 && IN(pb + 3)) ssd_part2(fresh(F), PB, XNY, CC, EA, ST, args.in[8] + L * 512, dry);
        if (PHK(6) && IN(pb + 3)) ssd_part2(fresh(F), PB, XNY, CC, EA, ST, args.in[8] + L * 512, false);
        SEAM(pb + 3);
#pragma unroll 1
        for (int rep = 0; rep < ((DUPK(7) && L == 0) ? 2 : 1); ++rep)
        if (PHK(7) && IN(pb + 4)) {
            pg8::Gemm g{XNY, (const bf16*)(ws + WS_WOUT) + (size_t)L * DM * DM, M, DM, DM}; pg8::StaticOrder S; S.init(M, DM, F.G, (int)blockIdx.x);
            pg8::EpiResidB E{XB, X1B, SS2};
            pg8::gemm_phase<pg8::EpiResidB, pg8::StaticOrder, PG8_ALIGN, PG8_SP2>(F.lds, g, S, E);
        }
        SEAM(pb + 4);
#pragma unroll 1
        for (int rep = 0; rep < ((DUPK(8) && L == 0) ? 2 : 1); ++rep)
        if (PHK(8) && IN(pb + 5)) {
            pg8::Gemm g{X1B, (const bf16*)(ws + WS_WS) + (size_t)L * DM * DM, M, DM, DM}; pg8::StaticOrder S; S.init(M, DM, F.G, (int)blockIdx.x);
            pg8::EpiScore E{SC, SS2, EPS};
            pg8::gemm_phase<pg8::EpiScore, pg8::StaticOrder, PG8_ALIGN, PG8_SP2>(F.lds, g, S, E);
        }
        SEAM(pb + 5);
        if (DUPK(9) && L == 0 && IN(pb + 6)) peer_phase(fresh(F), SC, SS2, ws + WS_U8 + (size_t)L * 16384 * DM, ws + WS_V8 + (size_t)L * 16384 * DM, (const float*)(ws + WS_US) + L * 16384, (const float*)(ws + WS_VS) + L * 16384, args.in[11] + L * DM, X1B, ws + WS_ST, XB, RS1, OUT, args.in[16], L == DEPTH - 1, dry, 0);
        if (PHK(9) && IN(pb + 6)) peer_phase(fresh(F), SC, SS2, ws + WS_U8 + (size_t)L * 16384 * DM, ws + WS_V8 + (size_t)L * 16384 * DM, (const float*)(ws + WS_US) + L * 16384, (const float*)(ws + WS_VS) + L * 16384, args.in[11] + L * DM, X1B, ws + WS_ST, XB, RS1, OUT, args.in[16], L == DEPTH - 1, false, (L == 0 && dry) ? (DUPK(10) ? 1 : DUPK(11) ? 2 : DUPK(12) ? 4 : DUPK(13) ? 10 : DUPK(14) ? 17 : 0) : 0, (const void*)(ctl + 20));
        SEAM(pb + 6);
    }
#undef IN
#undef SEAM
}

extern "C" void kernel_launch(void* const* d_in, const int* in_sizes, int n_in, void* d_out, int out_size, void* d_ws, size_t ws_size, hipStream_t stream) {
    static int grid = 0;
    if (grid == 0) {
        if (n_in != 17 || in_sizes[0] != M * DM || out_size != M * DM || ws_size < WS_END) { fprintf(stderr, "kernel_launch: unexpected shapes (n_in %d, in0 %d, out %d, ws %zu); nothing launched\n", n_in, n_in > 0 ? in_sizes[0] : -1, out_size, ws_size); grid = -1; return; }
        int dev = 0, cus = 0, per_cu = 0;
        if (hipGetDevice(&dev) != hipSuccess || hipDeviceGetAttribute(&cus, hipDeviceAttributeMultiprocessorCount, dev) != hipSuccess) { fprintf(stderr, "kernel_launch: device query failed\n"); grid = -1; return; }
        if (hipFuncSetAttribute((const void*)mega_fwd, hipFuncAttributeMaxDynamicSharedMemorySize, LDS_BYTES) != hipSuccess) { fprintf(stderr, "kernel_launch: hipFuncSetAttribute failed\n"); grid = -1; return; }
        if (hipOccupancyMaxActiveBlocksPerMultiprocessor(&per_cu, (const void*)mega_fwd, NWAVES * 64, LDS_BYTES) != hipSuccess || per_cu < 1) { fprintf(stderr, "kernel_launch: the occupancy query reports %d resident workgroups per CU for %d threads + %d B of LDS; nothing launched\n", per_cu, NWAVES * 64, LDS_BYTES); (void)hipGetLastError(); grid = -1; return; }
        (void)hipGetLastError();
        grid = cus;
    }
    if (grid < 0) return;
    if (hipMemsetAsync((char*)d_ws + WS_CTL, 0, CTL_ZERO_BYTES, stream) != hipSuccess) { fprintf(stderr, "kernel_launch: memset failed\n"); return; }
    Args a{};
    for (int i = 0; i < 17; ++i) a.in[i] = (const float*)d_in[i];
    a.out = (float*)d_out; a.ws = (unsigned char*)d_ws;
    for (int li = 0; li < N_LAUNCHES; ++li) {
        a.ph_lo = (N_LAUNCHES == NPH) ? li : 0; a.ph_hi = (N_LAUNCHES == NPH) ? li + 1 : NPH; a.li = li;
        hipLaunchKernelGGL(mega_fwd, dim3(grid), dim3(NWAVES * 64), LDS_BYTES, stream, a);
        const hipError_t le = hipPeekAtLastError();
        if (le != hipSuccess) { fprintf(stderr, "kernel_launch: launch %d failed: %s\n", li, hipGetErrorName(le)); break; }
    }
}
```

```cpp
#define MK_N_LAUNCHES 1
#include <hip/hip_runtime.h>
#include <cstdio>
#include <cstdint>
#include <cmath>
namespace pg8 {
#define PG8_LAS __attribute__((address_space(3)))
typedef unsigned short bf16_t;
typedef short bf16x8 __attribute__((ext_vector_type(8)));
typedef float f32x4 __attribute__((ext_vector_type(4)));
typedef unsigned u32x4 __attribute__((ext_vector_type(4)));
constexpr int BM = 256, BK = 64, HALF = 128, HTB = HALF * BK * 2  , STAGE_BYTES = 8 * HTB, NXCD = 8, WGM = 8;

__host__ __device__ __forceinline__ int lds_byte(int r, int c) { const int st = (r >> 4) * 2 + (c >> 5), rr = r & 15, cc = c & 31, ob = rr * 64 + cc * 2; return st * 1024 + (ob ^ (((ob >> 9) & 1) << 5)); }
__host__ __device__ __forceinline__ void stage_rc(int b, int& R, int& C) { const int st = b / 1024, sb = b % 1024, swz = sb ^ (((sb >> 9) & 1) << 5); R = (st >> 1) * 16 + swz / 64; C = (st & 1) * 32 + (swz % 64) / 2; }
__host__ __device__ __forceinline__ int perm32(int rho) { const int n = rho >> 4, i = rho & 15; return 8 * (i >> 2) + 4 * n + (i & 3); }

struct Unit { int pm, pn; };
struct Gemm { const bf16_t* A; const bf16_t* Bt; int M, N, K; };

struct StaticOrder {
    int nM, nN, nwg, G, c;
    __host__ __device__ void init(int M, int N, int G_, int c_) { nM = M / BM; nN = N / BM; nwg = nM * nN; G = G_; c = c_; }
    __host__ __device__ bool next(int i, Unit& u) const {
        const long L = (long)i * G + c; if (L >= nwg) return false;
        int wgid = (int)L; { const int q = nwg / NXCD, r = nwg % NXCD, xcd = wgid % NXCD, off = wgid / NXCD; wgid = (xcd < r ? xcd * (q + 1) : r * (q + 1) + (xcd - r) * q) + off; }
        const int nig = WGM * nN, gid = wgid / nig, fm = gid * WGM, gsz = (nM - fm) < WGM ? (nM - fm) : WGM;
        u.pm = fm + ((wgid % nig) % gsz); u.pn = (wgid % nig) / gsz; return true;
    }
    __device__ __forceinline__ void a_ready(const Unit&) const {}
    __device__ __forceinline__ void done(const Unit&) const {}
};

__device__ __forceinline__ unsigned cvt_pk_bf16(float lo, float hi) { unsigned r; asm volatile("v_cvt_pk_bf16_f32 %0, %1, %2" : "=v"(r) : "v"(lo), "v"(hi)); return r; }
typedef float f32x2 __attribute__((ext_vector_type(2)));
__device__ __forceinline__ f32x2 gelu_pk(f32x2 v) {
    const f32x2 av = __builtin_elementwise_abs(v), d = av * 0.2316418882f + 1.0f;
    f32x2 t; t.x = __builtin_amdgcn_rcpf(d.x); t.y = __builtin_amdgcn_rcpf(d.y);
    f32x2 q = t * 0.5307027145f + (-0.7265760135f); q = q * t + 0.7107068705f; q = q * t + (-0.142248368f); q = q * t + 0.127414796f; q = q * t;
    const f32x2 s = (v * v) * (-0.72134752044f);
    f32x2 e; e.x = __builtin_amdgcn_exp2f(s.x); e.y = __builtin_amdgcn_exp2f(s.y);
    const f32x2 m = v * (q * e), r = v - m;
    f32x2 o; o.x = v.x < 0.f ? m.x : r.x; o.y = v.y < 0.f ? m.y : r.y; return o;
}

template <int ACT  > struct EpiBf16 {
    static constexpr bool PERM = true, AFTER_DRAIN = false; static_assert(ACT == 0 || ACT == 1, "EpiBf16: ACT is 0 (none) or 1 (gelu_pk)");
    bf16_t* O; int ldc; const float* bias; int split_cols; size_t split_stride; float scale0;
    __device__ __forceinline__ void operator()(const f32x4 (&acc)[2][2][4][2], const Unit& u, int wr, int wc, int fr, int fq) const {
        const int row0 = u.pm * BM + wr * 64 + fr; int colt = u.pn * BM; bf16_t* base = O;
        float sc = 1.f; if (split_cols) { const int t = colt / split_cols; base += (size_t)t * split_stride; colt -= t * split_cols; if (t == 0) sc = scale0; }
        const int col0 = colt + wc * 32 + 8 * fq, bcol0 = u.pn * BM + wc * 32 + 8 * fq;
        f32x4 bv[2][2];
#pragma unroll
        for (int bj = 0; bj < 2; ++bj)
#pragma unroll
            for (int n = 0; n < 2; ++n) bv[bj][n] = bias ? *(const f32x4*)(bias + bcol0 + bj * HALF + 4 * n) : (f32x4){0.f, 0.f, 0.f, 0.f};
#pragma unroll
        for (int ai = 0; ai < 2; ++ai)
#pragma unroll
            for (int m = 0; m < 4; ++m) { bf16_t* rowp = base + (size_t)(row0 + ai * HALF + m * 16) * ldc + col0;
#pragma unroll
                for (int bj = 0; bj < 2; ++bj) { f32x4 v0 = acc[ai][bj][m][0] + bv[bj][0], v1 = acc[ai][bj][m][1] + bv[bj][1];
                    if (ACT == 1) { f32x2 a = gelu_pk((f32x2){v0[0], v0[1]}), b = gelu_pk((f32x2){v0[2], v0[3]}), c = gelu_pk((f32x2){v1[0], v1[1]}), d = gelu_pk((f32x2){v1[2], v1[3]});
                        v0 = (f32x4){a.x, a.y, b.x, b.y}; v1 = (f32x4){c.x, c.y, d.x, d.y}; }
                    v0 = v0 * sc; v1 = v1 * sc; u32x4 w; w.x = cvt_pk_bf16(v0[0], v0[1]); w.y = cvt_pk_bf16(v0[2], v0[3]); w.z = cvt_pk_bf16(v1[0], v1[1]); w.w = cvt_pk_bf16(v1[2], v1[3]);
                    *(u32x4*)(rowp + bj * HALF) = w; } }
    }
};
struct EpiResid {
    static constexpr bool PERM = true, AFTER_DRAIN = false;
    const float* resid; float* out; bf16_t* xb; float* ss;
    __device__ __forceinline__ void operator()(const f32x4 (&acc)[2][2][4][2], const Unit& u, int wr, int wc, int fr, int fq) const {
        const int row0 = u.pm * BM + wr * 64 + fr; const int col0 = u.pn * BM + wc * 32 + 8 * fq;
#pragma unroll
        for (int ai = 0; ai < 2; ++ai)
#pragma unroll
            for (int m = 0; m < 4; ++m) { const int row = row0 + ai * HALF + m * 16; const size_t off = (size_t)row * 1024 + col0; float s = 0.f;
#pragma unroll
                for (int bj = 0; bj < 2; ++bj) { const float* rp = resid + off + bj * HALF; const f32x4 r0 = *(const f32x4*)rp, r1 = *(const f32x4*)(rp + 4);
                    const f32x4 v0 = acc[ai][bj][m][0] + r0, v1 = acc[ai][bj][m][1] + r1;
                    *(f32x4*)(out + off + bj * HALF) = v0; *(f32x4*)(out + off + bj * HALF + 4) = v1;
                    u32x4 w; w.x = cvt_pk_bf16(v0[0], v0[1]); w.y = cvt_pk_bf16(v0[2], v0[3]); w.z = cvt_pk_bf16(v1[0], v1[1]); w.w = cvt_pk_bf16(v1[2], v1[3]);
                    *(u32x4*)(xb + off + bj * HALF) = w;
                    s += (v0[0] * v0[0] + v0[1] * v0[1]) + (v0[2] * v0[2] + v0[3] * v0[3]) + (v1[0] * v1[0] + v1[1] * v1[1]) + (v1[2] * v1[2] + v1[3] * v1[3]); }
                { const auto r16_ = __builtin_amdgcn_permlane16_swap(__float_as_uint(s), __float_as_uint(s), false, false); s = __uint_as_float(r16_[0]) + __uint_as_float(r16_[1]); const auto r32_ = __builtin_amdgcn_permlane32_swap(__float_as_uint(s), __float_as_uint(s), false, false); s = __uint_as_float(r32_[0]) + __uint_as_float(r32_[1]); }
                if (fq == 0) ss[(size_t)row * 16 + u.pn * 4 + wc] = s; }
    }
};
struct EpiScore {
    static constexpr bool PERM = true, AFTER_DRAIN = false;
    float* out; const float* ss; float eps;
    __device__ __forceinline__ void operator()(const f32x4 (&acc)[2][2][4][2], const Unit& u, int wr, int wc, int fr, int fq) const {
        const int row0 = u.pm * BM + wr * 64 + fr; const int col0 = u.pn * BM + wc * 32 + 8 * fq;
#pragma unroll
        for (int ai = 0; ai < 2; ++ai)
#pragma unroll
            for (int m = 0; m < 4; ++m) { const int row = row0 + ai * HALF + m * 16; const size_t off = (size_t)row * 1024 + col0;
                const f32x4* sp = (const f32x4*)(ss + (size_t)row * 16); const f32x4 a = sp[0], b = sp[1], c = sp[2], d = sp[3];
                const float t = ((a[0] + a[1]) + (a[2] + a[3])) + ((b[0] + b[1]) + (b[2] + b[3])) + ((c[0] + c[1]) + (c[2] + c[3])) + ((d[0] + d[1]) + (d[2] + d[3]));
                const float rstd = 1.0f / sqrtf(t * (1.0f / 1024.0f) + eps);
#pragma unroll
                for (int bj = 0; bj < 2; ++bj) { *(f32x4*)(out + off + bj * HALF) = acc[ai][bj][m][0] * rstd; *(f32x4*)(out + off + bj * HALF + 4) = acc[ai][bj][m][1] * rstd; } }
    }
};

struct EpiBf16Row {
    static constexpr bool PERM = true, AFTER_DRAIN = false;
    bf16_t* O; int ldc; const float* rs;
    __device__ __forceinline__ void operator()(const f32x4 (&acc)[2][2][4][2], const Unit& u, int wr, int wc, int fr, int fq) const {
        const int row0 = u.pm * BM + wr * 64 + fr; const int col0 = u.pn * BM + wc * 32 + 8 * fq;
#pragma unroll
        for (int ai = 0; ai < 2; ++ai)
#pragma unroll
            for (int m = 0; m < 4; ++m) { const int row = row0 + ai * HALF + m * 16; const float sc = rs[row]; bf16_t* rowp = O + (size_t)row * ldc + col0;
#pragma unroll
                for (int bj = 0; bj < 2; ++bj) { const f32x4 v0 = acc[ai][bj][m][0] * sc, v1 = acc[ai][bj][m][1] * sc;
                    u32x4 w; w.x = cvt_pk_bf16(v0[0], v0[1]); w.y = cvt_pk_bf16(v0[2], v0[3]); w.z = cvt_pk_bf16(v1[0], v1[1]); w.w = cvt_pk_bf16(v1[2], v1[3]);
                    *(u32x4*)(rowp + bj * HALF) = w; } }
    }
};
struct EpiResidB {
    static constexpr bool PERM = true, AFTER_DRAIN = false;
    const bf16_t* resid; bf16_t* xb; float* ss;
    __device__ __forceinline__ void operator()(const f32x4 (&acc)[2][2][4][2], const Unit& u, int wr, int wc, int fr, int fq) const {
        const int row0 = u.pm * BM + wr * 64 + fr; const int col0 = u.pn * BM + wc * 32 + 8 * fq;
#pragma unroll
        for (int ai = 0; ai < 2; ++ai)
#pragma unroll
            for (int m = 0; m < 4; ++m) { const int row = row0 + ai * HALF + m * 16; const size_t off = (size_t)row * 1024 + col0; float s = 0.f;
#pragma unroll
                for (int bj = 0; bj < 2; ++bj) { const u32x4 r = *(const u32x4*)(resid + off + bj * HALF);
                    const f32x4 r0 = (f32x4){__uint_as_float(r.x << 16), __uint_as_float(r.x & 0xffff0000u), __uint_as_float(r.y << 16), __uint_as_float(r.y & 0xffff0000u)};
                    const f32x4 r1 = (f32x4){__uint_as_float(r.z << 16), __uint_as_float(r.z & 0xffff0000u), __uint_as_float(r.w << 16), __uint_as_float(r.w & 0xffff0000u)};
                    const f32x4 v0 = acc[ai][bj][m][0] + r0, v1 = acc[ai][bj][m][1] + r1;
                    u32x4 w; w.x = cvt_pk_bf16(v0[0], v0[1]); w.y = cvt_pk_bf16(v0[2], v0[3]); w.z = cvt_pk_bf16(v1[0], v1[1]); w.w = cvt_pk_bf16(v1[2], v1[3]);
                    *(u32x4*)(xb + off + bj * HALF) = w;
                    s += (v0[0] * v0[0] + v0[1] * v0[1]) + (v0[2] * v0[2] + v0[3] * v0[3]) + (v1[0] * v1[0] + v1[1] * v1[1]) + (v1[2] * v1[2] + v1[3] * v1[3]); }
                { const auto r16_ = __builtin_amdgcn_permlane16_swap(__float_as_uint(s), __float_as_uint(s), false, false); s = __uint_as_float(r16_[0]) + __uint_as_float(r16_[1]); const auto r32_ = __builtin_amdgcn_permlane32_swap(__float_as_uint(s), __float_as_uint(s), false, false); s = __uint_as_float(r32_[0]) + __uint_as_float(r32_[1]); }
                if (fq == 0) ss[(size_t)row * 16 + u.pn * 4 + wc] = s; }
    }
};
template <class Epi, class Sched, bool ALIGN_EPI = false, bool SP2 = false>
__device__ __forceinline__ void gemm_phase(PG8_LAS unsigned char* lds, const Gemm g, const Sched& S, const Epi& E) {
    int tid_ = threadIdx.x; asm volatile("" : "+v"(tid_));
    const int tid = tid_, wid = __builtin_amdgcn_readfirstlane(tid >> 6), lane = tid & 63, wr = wid >> 2, wc = wid & 3, fr = lane & 15, fq = lane >> 4;
    const int K = g.K, nt = K / BK;
    unsigned voffA[2], voffB[2];
#pragma unroll
    for (int i = 0; i < 2; ++i) { int R, C; stage_rc(tid * 16 + i * 8192, R, C); const int Rb = Epi::PERM ? ((R & ~31) + perm32(R & 31)) : R;
        voffA[i] = (unsigned)(R * K + C) * 2u; voffB[i] = (unsigned)(Rb * K + C) * 2u; }
    const size_t kstep = (size_t)(BK * 2);
    const size_t hstep = (size_t)HALF * K * 2;
    const size_t tstep = 2 * hstep;
    const unsigned ldsw = (unsigned)wid * 1024u;
    const int aoff = lds_byte(wr * 64 + fr, fq * 8), boff = lds_byte(wc * 32 + fr, fq * 8);
#define PG8_SA(b, h) (((b) * 2 + (h)) * HTB)
#define PG8_SB(b, h) ((4 + (b) * 2 + (h)) * HTB)
#define PG8_STAGE(bufoff, gbase, voff) do { _Pragma("unroll") for (int _i = 0; _i < 2; ++_i) \
        __builtin_amdgcn_global_load_lds((const unsigned*)((const char*)(gbase) + (voff)[_i]), (PG8_LAS unsigned*)(lds + (bufoff) + ldsw + _i * 8192), 16, 0, 0); } while (0)
#define PG8_LDA(dst, b, h) do { _Pragma("unroll") for (int m = 0; m < 4; ++m) _Pragma("unroll") for (int k = 0; k < 2; ++k) dst[m][k] = *(const PG8_LAS bf16x8*)(lds + PG8_SA(b, h) + aoff + m * 2048 + k * 1024); } while (0)
#define PG8_LDB(dst, b, h) do { _Pragma("unroll") for (int n = 0; n < 2; ++n) _Pragma("unroll") for (int k = 0; k < 2; ++k) dst[n][k] = *(const PG8_LAS bf16x8*)(lds + PG8_SB(b, h) + boff + n * 2048 + k * 1024); } while (0)
#define PG8_MMA(ai, bj, At, Bt) do { __builtin_amdgcn_s_setprio(1); _Pragma("unroll") for (int m = 0; m < 4; ++m) _Pragma("unroll") for (int n = 0; n < 2; ++n) _Pragma("unroll") for (int k = 0; k < 2; ++k) \
        acc[ai][bj][m][n] = __builtin_amdgcn_mfma_f32_16x16x32_bf16(Bt[n][k], At[m][k], acc[ai][bj][m][n], 0, 0, 0); __builtin_amdgcn_s_setprio(0); } while (0)
#define PG8_WAIT_V(n) asm volatile("s_waitcnt vmcnt(" #n ")" ::: "memory")
#define PG8_WAIT_L(n) asm volatile("s_waitcnt lgkmcnt(" #n ")" ::: "memory")
#define PG8_BAR __builtin_amdgcn_s_barrier()
#define PG8_SCHED __builtin_amdgcn_sched_barrier(0)
    Unit cur, nxt; int ui = 0;
    if (!S.next(0, cur)) return;
    f32x4 acc[2][2][4][2];
#pragma unroll
    for (int a = 0; a < 2; ++a)
#pragma unroll
        for (int b = 0; b < 2; ++b)
#pragma unroll
            for (int m = 0; m < 4; ++m)
#pragma unroll
                for (int n = 0; n < 2; ++n) acc[a][b][m][n] = (f32x4){0.f, 0.f, 0.f, 0.f};
    bf16x8 At[4][2], B0[2][2], B1[2][2];
    const char* cA = (const char*)g.A + (size_t)cur.pm * tstep; const char* cB = (const char*)g.Bt + (size_t)cur.pn * tstep;
    S.a_ready(cur);
    if constexpr (SP2) {
        PG8_STAGE(PG8_SB(0, 0), cB, voffB); PG8_STAGE(PG8_SB(0, 1), cB + hstep, voffB); PG8_STAGE(PG8_SA(0, 0), cA, voffA); PG8_STAGE(PG8_SA(0, 1), cA + hstep, voffA);
        if (wr == 1) PG8_BAR;
        PG8_WAIT_V(2); PG8_BAR;
        PG8_STAGE(PG8_SB(1, 0), cB + kstep, voffB); PG8_STAGE(PG8_SA(1, 0), cA + kstep, voffA); PG8_STAGE(PG8_SB(1, 1), cB + hstep + kstep, voffB);
        PG8_WAIT_V(6); PG8_BAR;
    } else {
        PG8_STAGE(PG8_SB(0, 0), cB, voffB); PG8_STAGE(PG8_SA(0, 0), cA, voffA); PG8_STAGE(PG8_SB(0, 1), cB + hstep, voffB); PG8_STAGE(PG8_SA(0, 1), cA + hstep, voffA);
        if (wr == 1) PG8_BAR;
        PG8_WAIT_V(4); PG8_BAR;
        PG8_STAGE(PG8_SB(1, 0), cB + kstep, voffB); PG8_STAGE(PG8_SA(1, 0), cA + kstep, voffA); PG8_STAGE(PG8_SB(1, 1), cB + hstep + kstep, voffB);
        PG8_WAIT_V(6); PG8_BAR;
    }
    for (;;) {
        const bool has_next = S.next(ui + 1, nxt);
        const char* nA = has_next ? (const char*)g.A + (size_t)nxt.pm * tstep : cA; const char* nB = has_next ? (const char*)g.Bt + (size_t)nxt.pn * tstep : cB;
        for (int t = 0; t < nt; t += 2) {
            const bool last = (t == nt - 2);
            const char* a1 = cA + (size_t)(t + 1) * kstep;
            const char* a2 = last ? nA : cA + (size_t)(t + 2) * kstep; const char* b2 = last ? nB : cB + (size_t)(t + 2) * kstep;
            const char* a3 = a2 + kstep; const char* b3 = b2 + kstep;
            if (last && has_next) S.a_ready(nxt);
            if constexpr (SP2) {
            PG8_LDB(B0, 0, 0); PG8_LDB(B1, 0, 1); PG8_SCHED; PG8_LDA(At, 0, 0); PG8_STAGE(PG8_SA(1, 1), a1 + hstep, voffA);
            PG8_WAIT_V(8); PG8_WAIT_L(0); PG8_BAR; PG8_MMA(0, 0, At, B0); PG8_MMA(0, 1, At, B1); PG8_BAR; PG8_SCHED;
            PG8_LDA(At, 0, 1); PG8_STAGE(PG8_SB(0, 0), b2, voffB); PG8_STAGE(PG8_SB(0, 1), b2 + hstep, voffB); PG8_STAGE(PG8_SA(0, 0), a2, voffA);
            PG8_WAIT_V(8); PG8_WAIT_L(0); PG8_BAR; PG8_MMA(1, 0, At, B0); PG8_MMA(1, 1, At, B1); PG8_BAR; PG8_SCHED;
            PG8_LDB(B0, 1, 0); PG8_LDB(B1, 1, 1); PG8_SCHED; PG8_LDA(At, 1, 0); PG8_STAGE(PG8_SA(0, 1), a2 + hstep, voffA);
            PG8_WAIT_V(8); PG8_WAIT_L(0); PG8_BAR; PG8_MMA(0, 0, At, B0); PG8_MMA(0, 1, At, B1); PG8_BAR; PG8_SCHED;
            PG8_LDA(At, 1, 1); PG8_STAGE(PG8_SB(1, 0), b3, voffB); PG8_STAGE(PG8_SB(1, 1), b3 + hstep, voffB); PG8_STAGE(PG8_SA(1, 0), a3, voffA);
            PG8_WAIT_V(8); PG8_WAIT_L(0); PG8_BAR; PG8_MMA(1, 0, At, B0); PG8_MMA(1, 1, At, B1); PG8_BAR; PG8_SCHED;
            } else {
            PG8_LDB(B0, 0, 0); PG8_SCHED; PG8_LDA(At, 0, 0); PG8_STAGE(PG8_SA(1, 1), a1 + hstep, voffA);
            PG8_WAIT_L(8); PG8_BAR; PG8_WAIT_L(0); PG8_MMA(0, 0, At, B0); PG8_BAR; PG8_SCHED;
            PG8_LDB(B1, 0, 1); PG8_STAGE(PG8_SB(0, 0), b2, voffB);
            PG8_BAR; PG8_WAIT_L(0); PG8_MMA(0, 1, At, B1); PG8_BAR;
            PG8_LDA(At, 0, 1); PG8_STAGE(PG8_SA(0, 0), a2, voffA);
            PG8_BAR; PG8_WAIT_L(0); PG8_MMA(1, 0, At, B0); PG8_BAR; PG8_SCHED;
            PG8_STAGE(PG8_SB(0, 1), b2 + hstep, voffB);
            PG8_WAIT_V(6); PG8_BAR; PG8_MMA(1, 1, At, B1); PG8_BAR;
            PG8_LDB(B0, 1, 0); PG8_SCHED; PG8_LDA(At, 1, 0); PG8_STAGE(PG8_SA(0, 1), a2 + hstep, voffA);
            PG8_WAIT_L(8); PG8_BAR; PG8_WAIT_L(0); PG8_MMA(0, 0, At, B0); PG8_BAR; PG8_SCHED;
            PG8_LDB(B1, 1, 1); PG8_STAGE(PG8_SB(1, 0), b3, voffB);
            PG8_BAR; PG8_WAIT_L(0); PG8_MMA(0, 1, At, B1); PG8_BAR;
            PG8_LDA(At, 1, 1); PG8_STAGE(PG8_SA(1, 0), a3, voffA);
            PG8_BAR; PG8_WAIT_L(0); PG8_MMA(1, 0, At, B0); PG8_BAR; PG8_SCHED;
            PG8_STAGE(PG8_SB(1, 1), b3 + hstep, voffB);
            PG8_WAIT_V(6); PG8_BAR; PG8_MMA(1, 1, At, B1); PG8_BAR;
            }
        }
        if constexpr (ALIGN_EPI) { if (wr == 0) PG8_BAR; }
        if constexpr (!Epi::AFTER_DRAIN) { E(acc, cur, wr, wc, fr, fq); S.done(cur); }
        if (!has_next) break;
#pragma unroll
        for (int a = 0; a < 2; ++a)
#pragma unroll
            for (int b = 0; b < 2; ++b)
#pragma unroll
                for (int m = 0; m < 4; ++m)
#pragma unroll
                    for (int n = 0; n < 2; ++n) acc[a][b][m][n] = (f32x4){0.f, 0.f, 0.f, 0.f};
        cur = nxt; cA = nA; cB = nB; ++ui;
        if constexpr (ALIGN_EPI) { if (wr == 1) PG8_BAR; }
    }
    PG8_WAIT_V(0);
    if constexpr (!ALIGN_EPI) { if (wr == 0) PG8_BAR; }
    PG8_BAR;
    if constexpr (Epi::AFTER_DRAIN) { E.fused(acc, cur, wr, wc, fr, fq, lds, wid, lane); S.done(cur); }
#undef PG8_SA
#undef PG8_SB
#undef PG8_STAGE
#undef PG8_LDA
#undef PG8_LDB
#undef PG8_MMA
#undef PG8_WAIT_V
#undef PG8_WAIT_L
#undef PG8_BAR
#undef PG8_SCHED
}
}

#ifndef PG8_SP2
#define PG8_SP2 true
#endif
#ifndef PG8_ALIGN
#define PG8_ALIGN true
#endif
constexpr int NWAVES = 8;
constexpr int NPH = 15;
#ifndef MK_N_LAUNCHES
#define MK_N_LAUNCHES 1
#endif
constexpr int N_LAUNCHES = MK_N_LAUNCHES;

constexpr int BATCH = 2, SEQ = 16384, DM = 1024, DEPTH = 2;
constexpr int M = BATCH * SEQ;
constexpr int INW = 2824;
constexpr int NP = 3072;
constexpr int QOFF = 0, KOFF = 256, VOFF = 512, ZOFF = 768, XOFF = 1280, SBOFF = 2048, SCOFF = 2304, SVOFF = 2560, DTOFF = 2816;
constexpr int NCHUNK = SEQ / 64;
constexpr float EPS = 1e-6f;
constexpr float SB_EXIT = -104.0f;

constexpr size_t MiB = 1u << 20;
constexpr size_t WS_CTL = 0, CTL_ZERO_BYTES = 1 * MiB;
constexpr size_t WS_WIN = 2 * MiB;
constexpr size_t WS_WOUT = 14 * MiB;
constexpr size_t WS_WS = 18 * MiB;
constexpr size_t WS_SS2 = 22 * MiB;
constexpr size_t WS_EA = 24 * MiB;
constexpr size_t WS_CD = 25 * MiB;
constexpr size_t WS_CC = 26 * MiB;
constexpr size_t WS_U8 = 34 * MiB;
constexpr size_t WS_V8 = 66 * MiB;
constexpr size_t WS_US = 25 * MiB + 128 * 1024;
constexpr size_t WS_VS = 25 * MiB + 256 * 1024;
constexpr size_t WS_RS1 = 25 * MiB + 512 * 1024;
constexpr size_t WS_XB = 98 * MiB;
constexpr size_t WS_XNY = 162 * MiB;
constexpr size_t WS_P = 226 * MiB;
constexpr size_t WS_SC = WS_P, WS_X1B = WS_P + 128 * MiB;
constexpr size_t WS_ST = 418 * MiB;
constexpr size_t WS_END = 482 * MiB;
constexpr int CW_BAR = 4096;

constexpr int LDS_BYTES = 163840;
constexpr int LDSCTL_OFF = 161792, MISC_OFF = LDSCTL_OFF + 320;
static_assert(MISC_OFF + 128 <= LDS_BYTES, "LDS map");

#define GAS __attribute__((address_space(1)))
#define LAS __attribute__((address_space(3)))
typedef unsigned short bf16;
typedef unsigned v4u __attribute__((ext_vector_type(4)));
typedef unsigned v2u __attribute__((ext_vector_type(2)));
typedef float f32x4 __attribute__((ext_vector_type(4)));
typedef GAS unsigned gu32;
#define RLX_AGENT __ATOMIC_RELAXED, __HIP_MEMORY_SCOPE_AGENT
#define LDS_WAIT() asm volatile("s_waitcnt lgkmcnt(0)" ::: "memory")
#define VM_WAIT() asm volatile("s_waitcnt vmcnt(0)" ::: "memory")
__device__ __forceinline__ unsigned f2bf(float f) { unsigned u = __builtin_bit_cast(unsigned, f); return (u + 0x7fffu + ((u >> 16) & 1u)) >> 16; }
__device__ __forceinline__ unsigned pk2(float lo, float hi) { return f2bf(lo) | (f2bf(hi) << 16); }
__device__ __forceinline__ float bflo(unsigned u) { return __uint_as_float(u << 16); }
__device__ __forceinline__ float bfhi(unsigned u) { return __uint_as_float(u & 0xffff0000u); }
__device__ __forceinline__ float bf2f(bf16 h) { return __uint_as_float(((unsigned)h) << 16); }
__device__ __forceinline__ void unpack8(const v4u v, float (&f)[8]) { f[0] = bflo(v.x); f[1] = bfhi(v.x); f[2] = bflo(v.y); f[3] = bfhi(v.y); f[4] = bflo(v.z); f[5] = bfhi(v.z); f[6] = bflo(v.w); f[7] = bfhi(v.w); }
__device__ __forceinline__ v4u pack8(const float (&f)[8]) { v4u o; o.x = pk2(f[0], f[1]); o.y = pk2(f[2], f[3]); o.z = pk2(f[4], f[5]); o.w = pk2(f[6], f[7]); return o; }
__device__ __forceinline__ float wave_sum(float v) {
#pragma unroll
    for (int o = 1; o < 64; o <<= 1) v += __shfl_xor(v, o);
    return v;
}
template <int CTRL> __device__ __forceinline__ float dppf(float x) { return __int_as_float(__builtin_amdgcn_update_dpp(0, __float_as_int(x), CTRL, 0xf, 0xf, false)); }
__device__ __forceinline__ float sum_x16(float x) { const auto r = __builtin_amdgcn_permlane16_swap(__float_as_uint(x), __float_as_uint(x), false, false); return __uint_as_float(r[0]) + __uint_as_float(r[1]); }
__device__ __forceinline__ float sum_x32(float x) { const auto r = __builtin_amdgcn_permlane32_swap(__float_as_uint(x), __float_as_uint(x), false, false); return __uint_as_float(r[0]) + __uint_as_float(r[1]); }
__device__ __forceinline__ float wave_sum_v(float x) { x += dppf<0xB1>(x); x += dppf<0x4E>(x); x += dppf<0x141>(x); x += dppf<0x128>(x); x = sum_x16(x); return sum_x32(x); }
__device__ __forceinline__ float silu_f(float x) { return x / (1.0f + __expf(-x)); }

#define XB_TMO      128
#define XB_XCNT(j)  (256  + 64 * (j))
#define XB_XSUB(j)  (1280 + 64 * (j))
#define XB_XGEN(j)  (2304 + 64 * (j))
#define XB_TOP      3328
#define XB_TOPGEN   3392
#define XCD_BAR_WORDS 3456
#define XB_SPIN_CAP (1u << 18)

__device__ __forceinline__ unsigned xb_ld(unsigned* p)              { return __hip_atomic_load(p, __ATOMIC_RELAXED, __HIP_MEMORY_SCOPE_AGENT); }
__device__ __forceinline__ unsigned xb_add(unsigned* p, unsigned v) { return __hip_atomic_fetch_add(p, v, __ATOMIC_RELAXED, __HIP_MEMORY_SCOPE_AGENT); }
__device__ __forceinline__ unsigned xb_xcc_id() { return (unsigned)__builtin_amdgcn_s_getreg((3 << 11) | 20) & 0xFu; }
#define XB_SPIN(cond, bar) do { unsigned _sp = 0; while (cond) { __builtin_amdgcn_s_sleep(1); \
    if ((++_sp & 255u) == 0u) { if (xb_ld(&(bar)[XB_TMO])) break; if (_sp > XB_SPIN_CAP) { atomicAdd(&(bar)[XB_TMO], 1u); break; } } } } while (0)

struct XcdBarrier {
    unsigned* bar; unsigned x;
    volatile LAS unsigned* st;
};

__device__ __forceinline__ XcdBarrier xcd_barrier_post(unsigned* bar, volatile LAS unsigned* st) {
    XcdBarrier b; b.bar = bar; b.x = xb_xcc_id(); b.st = st;
    if (threadIdx.x == 0) (void)xb_add(&bar[XB_XCNT(b.x)], 1u);
    return b;
}
__device__ __forceinline__ void xcd_barrier_complete(unsigned* bar, unsigned x, unsigned& nloc, unsigned& nx) {
    const unsigned G = gridDim.x * gridDim.y * gridDim.z;
    unsigned sum, cnt, mine, sp = 0u;
    for (;;) {
        sum = 0u; cnt = 0u; mine = 0u;
#pragma unroll
        for (unsigned j = 0; j < 16; ++j) { const unsigned c = xb_ld(&bar[XB_XCNT(j)]); sum += c; cnt += (c > 0u) ? 1u : 0u; mine = (j == x) ? c : mine; }
        if (sum == G) break;
        __builtin_amdgcn_s_sleep(1);
        if ((++sp & 255u) == 0u) { if (xb_ld(&bar[XB_TMO])) break; if (sp > XB_SPIN_CAP) { atomicAdd(&bar[XB_TMO], 1u); break; } }
    }
    nloc = mine > 0u ? mine : 1u; nx = cnt > 0u ? cnt : 1u;
}

__device__ __forceinline__ void xcd_barrier(const XcdBarrier& b) {
    asm volatile("s_waitcnt vmcnt(0)" ::: "memory");
    __syncthreads();
    if (threadIdx.x == 0) {
        unsigned* bar = b.bar;
        __builtin_amdgcn_s_waitcnt(0);
        unsigned nloc = b.st[0], nx = b.st[1];
        if (nloc == 0u) { xcd_barrier_complete(bar, b.x, nloc, nx); b.st[0] = nloc; b.st[1] = nx; }
        const unsigned old = xb_add(&bar[XB_XSUB(b.x)], 1u);
        const unsigned gen = old / nloc;
        if (old + 1u == (gen + 1u) * nloc) {
            __builtin_amdgcn_fence(__ATOMIC_RELEASE, "agent");
            asm volatile("s_waitcnt vmcnt(0)" ::: "memory");
            const unsigned og = xb_add(&bar[XB_TOP], 1u);
            const unsigned tg = og / nx;
            if (og + 1u == (tg + 1u) * nx) xb_add(&bar[XB_TOPGEN], 1u);
            else XB_SPIN(xb_ld(&bar[XB_TOPGEN]) == tg, bar);
            __builtin_amdgcn_fence(__ATOMIC_ACQUIRE, "agent");
            xb_add(&bar[XB_XGEN(b.x)], 1u);
            asm volatile("s_waitcnt vmcnt(0)" ::: "memory");
        } else {
            XB_SPIN(xb_ld(&bar[XB_XGEN(b.x)]) == gen, bar);
            __builtin_amdgcn_fence(__ATOMIC_ACQUIRE, "agent");
            asm volatile("s_waitcnt vmcnt(0)" ::: "memory");
        }
    }
    __syncthreads();
}

struct Ctx { LAS unsigned char* lds; int tid, lane, wave, vcu, G; };

__device__ __forceinline__ int win_colmap(int n) { return n < 2048 ? n : (n < 2816 ? n + 8 : (n < INW ? n - 2816 + 2048 : -1)); }
__device__ __forceinline__ void tr_item(const float* W, int Nsrc, int K, bf16* WT, const float* rowscale, LAS float* scr, int kb, int nb, int lane, bool mapped) {
    const int k0 = 64 * kb, n0 = 32 * nb; const int n = n0 + (lane & 31); const int sc = mapped ? win_colmap(n) : n;
#pragma unroll 8
    for (int i = 0; i < 32; ++i) { const int kk = 2 * i + (lane >> 5); float v = 0.f; if (sc >= 0) { v = W[(size_t)(k0 + kk) * Nsrc + sc]; if (rowscale) v *= rowscale[k0 + kk]; } scr[kk * 33 + (lane & 31)] = v; }
    LDS_WAIT(); asm volatile("" ::: "memory");
    const int c = lane & 7;
#pragma unroll
    for (int j = 0; j < 4; ++j) { const int nn = (lane >> 3) + 8 * j; const LAS float* s = scr + (8 * c) * 33 + nn;
        v4u o; o.x = pk2(s[0 * 33], s[1 * 33]); o.y = pk2(s[2 * 33], s[3 * 33]); o.z = pk2(s[4 * 33], s[5 * 33]); o.w = pk2(s[6 * 33], s[7 * 33]);
        *(GAS v4u*)(WT + (size_t)(n0 + nn) * K + k0 + 8 * c) = o; }
    LDS_WAIT(); asm volatile("" ::: "memory");
}
__device__ __forceinline__ void p0_prologue(const Ctx F, const float* x, const float* norm1_w, const float* w_in, const float* w_out, const float* norm2_w, const float* w_q, const float* sub_keys, unsigned char* ws) {
    bf16* WIN = (bf16*)(ws + WS_WIN); bf16* WOUT = (bf16*)(ws + WS_WOUT); bf16* WST = (bf16*)(ws + WS_WS);
    LAS float* scr = (LAS float*)(F.lds + F.wave * 16384);
    const int gw = F.vcu * NWAVES + F.wave, NGW = F.G * NWAVES;
    constexpr int I_IN = (DM / 64) * (NP / 32), I_OUT = (DM / 64) * (DM / 32);
    for (int it = gw; it < DEPTH * (I_IN + I_OUT); it += NGW) {
        int r = it;
        if (r < DEPTH * I_IN) { const int L = r / I_IN; r -= L * I_IN; tr_item(w_in + (size_t)L * DM * INW, INW, DM, WIN + (size_t)L * NP * DM, norm1_w + L * DM, scr, r / (NP / 32), r % (NP / 32), F.lane, true); }
        else { r -= DEPTH * I_IN; const int L = r / I_OUT; r -= L * I_OUT; tr_item(w_out + (size_t)L * DM * DM, DM, DM, WOUT + (size_t)L * DM * DM, nullptr, scr, r / (DM / 32), r % (DM / 32), F.lane, false); }
    }
    {
        typedef float f32x4w __attribute__((ext_vector_type(4)));
        const int fr = F.lane & 15, fq = F.lane >> 4;
        for (int u = gw; u < DEPTH * 8 * 64 * 2; u += NGW) {
            const int jh = u & 1, dt = (u >> 1) & 63, sl = (u >> 7) & 7, L = u >> 10, half = sl & 1;
            const float* Aq = w_q + (size_t)L * DM * DM + (size_t)(16 * dt + fr) * DM + sl * 128 + fq;
            const float* Bk = sub_keys + ((size_t)L * 2 + half) * 128 * 128 + (size_t)(64 * jh + fr) * 128 + fq;
            f32x4w acc[4];
#pragma unroll
            for (int j = 0; j < 4; ++j) acc[j] = (f32x4w){0.f, 0.f, 0.f, 0.f};
#pragma unroll 4
            for (int kk = 0; kk < 32; ++kk) { const float a = Aq[4 * kk];
#pragma unroll
                for (int j = 0; j < 4; ++j) acc[j] = __builtin_amdgcn_mfma_f32_16x16x4f32(a, Bk[(size_t)(16 * j) * 128 + 4 * kk], acc[j], 0, 0, 0); }
            const f32x4 w4 = *(const f32x4*)(norm2_w + L * DM + 16 * dt + 4 * fq);
#pragma unroll
            for (int j = 0; j < 4; ++j) *(v2u*)(WST + (size_t)L * DM * DM + (size_t)(sl * 128 + 64 * jh + 16 * j + fr) * DM + 16 * dt + 4 * fq) = (v2u){pk2(acc[j][0] * w4[0], acc[j][1] * w4[1]), pk2(acc[j][2] * w4[2], acc[j][3] * w4[3])};
        }
    }
    { bf16* XB = (bf16*)(ws + WS_XB); float* RS1 = (float*)(ws + WS_RS1);
    for (int m = gw; m < M; m += NGW) {
        const f32x4* xr = (const f32x4*)(x + (size_t)m * DM) + F.lane; f32x4 v[4]; float s = 0.f;
#pragma unroll
        for (int j = 0; j < 4; ++j) { v[j] = xr[64 * j]; s += (v[j][0] * v[j][0] + v[j][1] * v[j][1]) + (v[j][2] * v[j][2] + v[j][3] * v[j][3]); }
        const float rstd = 1.0f / sqrtf(wave_sum_v(s) * (1.0f / DM) + EPS);
        v2u* o8 = (v2u*)(XB + (size_t)m * DM) + F.lane;
#pragma unroll
        for (int j = 0; j < 4; ++j) { v2u o; o.x = pk2(v[j][0], v[j][1]); o.y = pk2(v[j][2], v[j][3]); o8[64 * j] = o; }
        if (F.lane == 0) RS1[m] = rstd;
    } }
}

typedef float f32x16 __attribute__((ext_vector_type(16)));
typedef short bf16x8 __attribute__((ext_vector_type(8)));
typedef short v4i16_t __attribute__((ext_vector_type(4)));
constexpr int AT_VS = 72;
__device__ __forceinline__ int crow(int r, int hi) { return (r & 3) + 8 * (r >> 2) + 4 * hi; }
__device__ __forceinline__ void attn_mfma(const Ctx F, const bf16* P, bf16* Y) {
    LAS bf16* vt = (LAS bf16*)(F.lds + F.wave * 8192);
    const int lane = F.lane, r32 = lane & 31, hi = lane >> 5;
    const int gw = F.vcu * NWAVES + F.wave, NGW = F.G * NWAVES;
    const LAS bf16* vrd = vt + (4 * hi + ((lane & 15) >> 2)) * AT_VS + 16 * ((lane >> 4) & 1) + 4 * (lane & 3);
#pragma unroll 1
    for (int u = gw; u < BATCH * 4 * (SEQ / 32); u += NGW) {
        const int qb = u & (SEQ / 32 - 1), bh = u / (SEQ / 32), h = bh & 3, b = bh >> 2;
        const int q0 = qb * 32; const size_t rowbase = (size_t)b * SEQ; const int t = q0 + r32;
        bf16x8 qf[4];
#pragma unroll
        for (int d0 = 0; d0 < 4; ++d0) { float f[8]; unpack8(*(const v4u*)(P + (rowbase + q0 + r32) * NP + QOFF + h * 64 + d0 * 16 + hi * 8), f);
#pragma unroll
            for (int i = 0; i < 8; ++i) f[i] *= 0.125f;
            qf[d0] = __builtin_bit_cast(bf16x8, pack8(f)); }
        f32x16 o0, o1;
#pragma unroll
        for (int r = 0; r < 16; ++r) { o0[r] = 0.f; o1[r] = 0.f; }
        float R = 0.f;
        int k0 = q0; bool diag = true;
        v4u kf[4], vr[4];
        { const bf16* kp = P + (rowbase + k0 + r32) * NP + KOFF + h * 64 + hi * 8; const bf16* vp = P + (rowbase + k0 + (lane >> 1)) * NP + VOFF + h * 64 + (lane & 1) * 32;
#pragma unroll
          for (int c = 0; c < 4; ++c) { kf[c] = *(const v4u*)(kp + c * 16); vr[c] = *(const v4u*)(vp + c * 8); } }
#pragma unroll 1
        for (;;) {
#pragma unroll
            for (int c = 0; c < 4; ++c) *(LAS v4u*)(vt + (lane >> 1) * AT_VS + (lane & 1) * 32 + c * 8) = vr[c];
            bf16x8 ka[4];
#pragma unroll
            for (int c = 0; c < 4; ++c) ka[c] = __builtin_bit_cast(bf16x8, kf[c]);
            const int kn = k0 - 32;
            if (kn >= 0) { const bf16* kp = P + (rowbase + kn + r32) * NP + KOFF + h * 64 + hi * 8; const bf16* vp = P + (rowbase + kn + (lane >> 1)) * NP + VOFF + h * 64 + (lane & 1) * 32;
#pragma unroll
                for (int c = 0; c < 4; ++c) { kf[c] = *(const v4u*)(kp + c * 16); vr[c] = *(const v4u*)(vp + c * 8); } }
            f32x16 p;
#pragma unroll
            for (int r = 0; r < 16; ++r) p[r] = 0.f;
#pragma unroll
            for (int d0 = 0; d0 < 4; ++d0) p = __builtin_amdgcn_mfma_f32_32x32x16_bf16(ka[d0], qf[d0], p, 0, 0, 0);
            float l[16], ee[16];
#pragma unroll
            for (int r = 0; r < 16; ++r) { const float z = p[r]; const float sp = fmaxf(z, 0.f) + __logf(1.0f + __expf(-fabsf(z)));
                const bool valid = !diag || (k0 + crow(r, hi) < t);
                l[r] = valid ? -sp : 0.f; ee[r] = valid ? (z - sp) : -INFINITY; }
            float gs[4], pg[4], tot[4], later[4];
#pragma unroll
            for (int g = 0; g < 4; ++g) { gs[g] = (l[4 * g] + l[4 * g + 1]) + (l[4 * g + 2] + l[4 * g + 3]); tot[g] = sum_x32(gs[g]); pg[g] = tot[g] - gs[g]; }
            later[3] = 0.f; later[2] = tot[3]; later[1] = tot[3] + tot[2]; later[0] = later[1] + tot[1];
            if (hi == 0) {
#pragma unroll
                for (int g = 0; g < 4; ++g) later[g] += pg[g]; }
#pragma unroll
            for (int g = 0; g < 4; ++g) { const float base = R + later[g];
                const float s3 = base, s2 = s3 + l[4 * g + 3], s1 = s2 + l[4 * g + 2], s0 = s1 + l[4 * g + 1];
                p[4 * g + 3] = __expf(ee[4 * g + 3] + s3); p[4 * g + 2] = __expf(ee[4 * g + 2] + s2); p[4 * g + 1] = __expf(ee[4 * g + 1] + s1); p[4 * g] = __expf(ee[4 * g] + s0); }
            R += (tot[0] + tot[1]) + (tot[2] + tot[3]);
            bf16x8 pb[2];
#pragma unroll
            for (int ks = 0; ks < 2; ++ks) { float f[8];
#pragma unroll
                for (int j = 0; j < 8; ++j) f[j] = p[8 * ks + j];
                pb[ks] = __builtin_bit_cast(bf16x8, pack8(f)); }
#pragma unroll
            for (int ks = 0; ks < 2; ++ks)
#pragma unroll
                for (int dt = 0; dt < 2; ++dt) {
                    const v4i16_t lo = __builtin_amdgcn_ds_read_tr16_b64_v4i16((LAS v4i16_t*)(vrd + (16 * ks) * AT_VS + 32 * dt));
                    const v4i16_t hi4 = __builtin_amdgcn_ds_read_tr16_b64_v4i16((LAS v4i16_t*)(vrd + (16 * ks + 8) * AT_VS + 32 * dt));
                    const bf16x8 va = (bf16x8){lo[0], lo[1], lo[2], lo[3], hi4[0], hi4[1], hi4[2], hi4[3]};
                    if (dt == 0) o0 = __builtin_amdgcn_mfma_f32_32x32x16_bf16(va, pb[ks], o0, 0, 0, 0); else o1 = __builtin_amdgcn_mfma_f32_32x32x16_bf16(va, pb[ks], o1, 0, 0, 0);
                }
            if (kn < 0 || __all(R < SB_EXIT)) break;
            k0 = kn; diag = false;
        }
        bf16* yp = Y + (rowbase + q0 + r32) * DM + h * 64;
#pragma unroll
        for (int g = 0; g < 4; ++g) { v2u a, c; a.x = pk2(o0[4 * g], o0[4 * g + 1]); a.y = pk2(o0[4 * g + 2], o0[4 * g + 3]); c.x = pk2(o1[4 * g], o1[4 * g + 1]); c.y = pk2(o1[4 * g + 2], o1[4 * g + 3]);
            *(v2u*)(yp + 8 * g + 4 * hi) = a; *(v2u*)(yp + 32 + 8 * g + 4 * hi) = c; }
    }
}
__device__ __forceinline__ void shortconv(const Ctx F, const bf16* P, bf16* Y, const float* cw  ) {
    for (long it = (long)F.vcu * 512 + F.tid; it < (long)(M / 8) * 32; it += (long)F.G * 512) {
        const size_t row0 = (size_t)(it >> 5) * 8; const int c0 = (int)(it & 31) * 8; const int t0 = (int)(row0 & (SEQ - 1));
        v4u cr[10], vr[10], br[8];
#pragma unroll
        for (int j = 0; j < 10; ++j) { const bool ok = (j >= 2) || (t0 > 0);
            cr[j] = ok ? *(const v4u*)(P + (row0 + j - 2) * NP + SCOFF + c0) : (v4u){0u, 0u, 0u, 0u}; vr[j] = ok ? *(const v4u*)(P + (row0 + j - 2) * NP + SVOFF + c0) : (v4u){0u, 0u, 0u, 0u}; }
#pragma unroll
        for (int j = 0; j < 8; ++j) br[j] = *(const v4u*)(P + (row0 + j) * NP + SBOFF + c0);
        float w[3][8];
#pragma unroll
        for (int k = 0; k < 3; ++k) { const f32x4 w0 = *(const f32x4*)(cw + k * 256 + c0), w1 = *(const f32x4*)(cw + k * 256 + c0 + 4);
#pragma unroll
            for (int i = 0; i < 4; ++i) { w[k][i] = w0[i]; w[k][4 + i] = w1[i]; } }
        float cv[10][8];
#pragma unroll
        for (int j = 0; j < 10; ++j) { float c8[8], v8[8]; unpack8(cr[j], c8); unpack8(vr[j], v8);
#pragma unroll
            for (int i = 0; i < 8; ++i) cv[j][i] = c8[i] * v8[i]; }
#pragma unroll
        for (int j = 0; j < 8; ++j) { float b8[8], o[8]; unpack8(br[j], b8);
#pragma unroll
            for (int i = 0; i < 8; ++i) o[i] = b8[i] * (w[0][i] * cv[j][i] + w[1][i] * cv[j + 1][i] + w[2][i] * cv[j + 2][i]);
            *(v4u*)(Y + (row0 + j) * DM + 768 + c0) = pack8(o); }
    }
}
constexpr int XTS = 72, BNS = 136;
constexpr int L_XT = 0, L_BN = L_XT + 512 * XTS * 2, L_BT = L_BN + 64 * BNS * 2, L_CN = L_BT + 128 * XTS * 2, L_GG = L_CN + 64 * BNS * 2, L_DT = L_GG + 128 * XTS * 2, L_ACS = L_DT + 2048, L_WL = L_ACS + 2048, L_SSD_END = L_WL + 2048;
static_assert(L_SSD_END <= LDSCTL_OFF, "SSD part 1 LDS");
typedef float f32x4v __attribute__((ext_vector_type(4)));
__device__ __forceinline__ void ssd_part1(const Ctx F, const bf16* P, bf16* Y, const float* cw  , const float* cb  , const float* dt_bias, const float* A_log, const float* Dp,
                                          bf16* CC, float* EA, float* CD, bf16* ST) {
    LAS bf16* XT = (LAS bf16*)(F.lds + L_XT); LAS bf16* BN = (LAS bf16*)(F.lds + L_BN); LAS bf16* BT = (LAS bf16*)(F.lds + L_BT); LAS bf16* CN = (LAS bf16*)(F.lds + L_CN); LAS bf16* GG = (LAS bf16*)(F.lds + L_GG);
    LAS float* DTH = (LAS float*)(F.lds + L_DT); LAS float* ACH = (LAS float*)(F.lds + L_ACS); LAS float* WLH = (LAS float*)(F.lds + L_WL);
    const int lane = F.lane, fr = lane & 15, fq = lane >> 4;
#pragma unroll 1
    for (int u = F.vcu; u < BATCH * NCHUNK; u += F.G) {
        const int b = u / NCHUNK, c = u % NCHUNK, t0 = c * 64; const size_t r0 = (size_t)b * SEQ + t0;
        __syncthreads();
        if (F.tid < 384) { const int ch = 2 * F.tid;
            float w0[4], w1[4];
#pragma unroll
            for (int k = 0; k < 4; ++k) { w0[k] = cw[k * 768 + ch]; w1[k] = cw[k * 768 + ch + 1]; }
            const float b0 = cb[ch], b1 = cb[ch + 1];
            const bf16* pin = P + ((size_t)b * SEQ + t0) * NP + XOFF + ch;
            unsigned h0 = 0u, h1 = 0u, h2 = 0u;
            if (t0 > 0) { h0 = *(const unsigned*)(pin - 3 * (ptrdiff_t)NP); h1 = *(const unsigned*)(pin - 2 * (ptrdiff_t)NP); h2 = *(const unsigned*)(pin - (ptrdiff_t)NP); }
#pragma unroll 1
            for (int tq = 0; tq < 4; ++tq) {
                unsigned r[16];
#pragma unroll
                for (int j = 0; j < 16; ++j) r[j] = *(const unsigned*)(pin + (size_t)(16 * tq + j) * NP);
#pragma unroll
                for (int tg4 = 0; tg4 < 4; ++tg4) { const int tg = 4 * tq + tg4;
                    const unsigned in[7] = {tg4 == 0 ? h0 : r[4 * tg4 - 3], tg4 == 0 ? h1 : r[4 * tg4 - 2], tg4 == 0 ? h2 : r[4 * tg4 - 1], r[4 * tg4], r[4 * tg4 + 1], r[4 * tg4 + 2], r[4 * tg4 + 3]};
                    float y0[4], y1[4];
#pragma unroll
                    for (int j = 0; j < 4; ++j) { float a0 = b0, a1 = b1;
#pragma unroll
                        for (int k = 0; k < 4; ++k) { a0 += w0[k] * bflo(in[j + k]); a1 += w1[k] * bfhi(in[j + k]); }
                        y0[j] = silu_f(a0); y1[j] = silu_f(a1); }
                    const v2u t0v = (v2u){pk2(y0[0], y0[1]), pk2(y0[2], y0[3])}, t1v = (v2u){pk2(y1[0], y1[1]), pk2(y1[2], y1[3])};
                    if (ch < 512) { *(LAS v2u*)(XT + ch * XTS + 4 * tg) = t0v; *(LAS v2u*)(XT + (ch + 1) * XTS + 4 * tg) = t1v; }
                    else if (ch < 640) { const int nb = ch - 512; *(LAS v2u*)(BT + nb * XTS + 4 * tg) = t0v; *(LAS v2u*)(BT + (nb + 1) * XTS + 4 * tg) = t1v;
#pragma unroll
                        for (int j = 0; j < 4; ++j) *(LAS unsigned*)(BN + (4 * tg + j) * BNS + nb) = pk2(y0[j], y1[j]); }
                    else { const int nc = ch - 640;
#pragma unroll
                        for (int j = 0; j < 4; ++j) { const unsigned pk = pk2(y0[j], y1[j]); *(LAS unsigned*)(CN + (4 * tg + j) * BNS + nc) = pk; *(unsigned*)(CC + (r0 + 4 * tg + j) * 128 + nc) = pk; } }
                }
                h0 = r[13]; h1 = r[14]; h2 = r[15];
            }
        }
        { const int h = F.wave, l = lane; const float xx = bf2f(P[(r0 + l) * NP + DTOFF + h]) + dt_bias[h]; const float dt = xx > 20.f ? xx : log1pf(__expf(xx));
          const float A = -__expf(A_log[h]); float cs = dt * A;
#pragma unroll
          for (int o = 1; o < 64; o <<= 1) { const float tmp = __shfl_up(cs, o); if (l >= o) cs += tmp; }
          const float last = __shfl(cs, 63);
          DTH[h * 64 + l] = dt; ACH[h * 64 + l] = cs; WLH[h * 64 + l] = __expf(last - cs) * dt;
          EA[(r0 + l) * 8 + h] = __expf(cs); if (l == 63) CD[(size_t)u * 8 + h] = __expf(cs); }
        __syncthreads();
        { const int g = F.wave >> 2, mt = F.wave & 3;
          const bf16x8 c0 = *(const LAS bf16x8*)(CN + (16 * mt + fr) * BNS + g * 64 + 8 * fq), c1 = *(const LAS bf16x8*)(CN + (16 * mt + fr) * BNS + g * 64 + 32 + 8 * fq);
#pragma unroll 1
          for (int nt = 0; nt <= mt; ++nt) {
              const bf16x8 b0 = *(const LAS bf16x8*)(BN + (16 * nt + fr) * BNS + g * 64 + 8 * fq), b1 = *(const LAS bf16x8*)(BN + (16 * nt + fr) * BNS + g * 64 + 32 + 8 * fq);
              f32x4v acc = (f32x4v){0.f, 0.f, 0.f, 0.f};
              acc = __builtin_amdgcn_mfma_f32_16x16x32_bf16(b0, c0, acc, 0, 0, 0); acc = __builtin_amdgcn_mfma_f32_16x16x32_bf16(b1, c1, acc, 0, 0, 0);
              *(LAS v2u*)(GG + (g * 64 + 16 * mt + fr) * XTS + 16 * nt + 4 * fq) = (v2u){pk2(acc[0], acc[1]), pk2(acc[2], acc[3])}; } }
        __syncthreads();
        { const int h = F.wave, g = h >> 2;
          bf16x8 xa[4][2];
#pragma unroll
          for (int nt = 0; nt < 4; ++nt)
#pragma unroll
              for (int ks = 0; ks < 2; ++ks) xa[nt][ks] = *(const LAS bf16x8*)(XT + (h * 64 + 16 * nt + fr) * XTS + 32 * ks + 8 * fq);
          {
            f32x4v acc[4][4];
#pragma unroll
            for (int nt = 0; nt < 4; ++nt)
#pragma unroll
                for (int mt = 0; mt < 4; ++mt) acc[nt][mt] = (f32x4v){0.f, 0.f, 0.f, 0.f};
#pragma unroll
            for (int mt = 0; mt < 4; ++mt)
#pragma unroll
                for (int ks = 0; ks < 2; ++ks) if (32 * ks <= 16 * mt + 15) {
                    const int l = 16 * mt + fr, s0 = 32 * ks + 8 * fq;
                    float gf[8]; unpack8(*(const LAS v4u*)(GG + (g * 64 + l) * XTS + s0), gf);
                    const float al = ACH[h * 64 + l]; const f32x4 a0 = *(const LAS f32x4*)(ACH + h * 64 + s0), a1 = *(const LAS f32x4*)(ACH + h * 64 + s0 + 4), d0 = *(const LAS f32x4*)(DTH + h * 64 + s0), d1 = *(const LAS f32x4*)(DTH + h * 64 + s0 + 4);
                    float mf[8];
#pragma unroll
                    for (int j = 0; j < 4; ++j) { mf[j] = (s0 + j <= l) ? gf[j] * __expf(al - a0[j]) * d0[j] : 0.f; mf[4 + j] = (s0 + 4 + j <= l) ? gf[4 + j] * __expf(al - a1[j]) * d1[j] : 0.f; }
                    const bf16x8 mfr = __builtin_bit_cast(bf16x8, pack8(mf));
#pragma unroll
                    for (int nt = 0; nt < 4; ++nt) acc[nt][mt] = __builtin_amdgcn_mfma_f32_16x16x32_bf16(xa[nt][ks], mfr, acc[nt][mt], 0, 0, 0);
                }
            const float Dh = Dp[h];
#pragma unroll
            for (int mt = 0; mt < 4; ++mt)
#pragma unroll
                for (int nt = 0; nt < 4; ++nt) { const int l = 16 * mt + fr, p0 = 16 * nt + 4 * fq; float o[4];
#pragma unroll
                    for (int r = 0; r < 4; ++r) o[r] = acc[nt][mt][r] + Dh * bf2f(XT[(h * 64 + p0 + r) * XTS + l]);
                    *(v2u*)(Y + (r0 + l) * DM + 256 + h * 64 + p0) = (v2u){pk2(o[0], o[1]), pk2(o[2], o[3])}; }
          }
          {
#pragma unroll
            for (int ks = 0; ks < 2; ++ks) { const f32x4 w0 = *(const LAS f32x4*)(WLH + h * 64 + 32 * ks + 8 * fq), w1 = *(const LAS f32x4*)(WLH + h * 64 + 32 * ks + 8 * fq + 4);
#pragma unroll
                for (int nt = 0; nt < 4; ++nt) { float f[8]; unpack8(__builtin_bit_cast(v4u, xa[nt][ks]), f);
#pragma unroll
                    for (int j = 0; j < 4; ++j) { f[j] *= w0[j]; f[4 + j] *= w1[j]; }
                    xa[nt][ks] = __builtin_bit_cast(bf16x8, pack8(f)); } }
            f32x4v acc[4][4];
#pragma unroll
            for (int n4 = 0; n4 < 4; ++n4)
#pragma unroll
                for (int pt = 0; pt < 4; ++pt) acc[n4][pt] = (f32x4v){0.f, 0.f, 0.f, 0.f};
#pragma unroll
            for (int n4 = 0; n4 < 4; ++n4)
#pragma unroll
                for (int ks = 0; ks < 2; ++ks) { const bf16x8 bt = *(const LAS bf16x8*)(BT + (g * 64 + 16 * n4 + fr) * XTS + 32 * ks + 8 * fq);
#pragma unroll
                    for (int pt = 0; pt < 4; ++pt) acc[n4][pt] = __builtin_amdgcn_mfma_f32_16x16x32_bf16(bt, xa[pt][ks], acc[n4][pt], 0, 0, 0); }
#pragma unroll
            for (int n4 = 0; n4 < 4; ++n4)
#pragma unroll
                for (int pt = 0; pt < 4; ++pt) *(v2u*)(ST + (((size_t)u * 8 + h) * 64 + 16 * pt + fr) * 64 + 16 * n4 + 4 * fq) = (v2u){pk2(acc[n4][pt][0], acc[n4][pt][1]), pk2(acc[n4][pt][2], acc[n4][pt][3])};
          }
        }
    }
    __syncthreads();
}
__device__ __forceinline__ void convert_tables(const int lane, const float* pu, const float* pv, const float* w2, unsigned char* ws, int L, int wid, int nw) {
    unsigned char* U8 = ws + WS_U8; unsigned char* V8 = ws + WS_V8; float* USc = (float*)(ws + WS_US); float* VSc = (float*)(ws + WS_VS);
    float w2q[16];
#pragma unroll
    for (int j = 0; j < 4; ++j) { const f32x4 w_ = *(const f32x4*)(w2 + lane * 16 + 4 * j); w2q[4 * j] = w_[0]; w2q[4 * j + 1] = w_[1]; w2q[4 * j + 2] = w_[2]; w2q[4 * j + 3] = w_[3]; }
#pragma unroll 1
    for (int r = wid; r < 2 * 16384; r += nw) {
        const bool isv = r >= 16384; const int rl = isv ? r - 16384 : r; const int rr = L * 16384 + rl; const float* src = (isv ? pv : pu) + (size_t)rr * DM + lane * 16;
        f32x4 v[4]; float am = 0.f;
#pragma unroll
        for (int j = 0; j < 4; ++j) { v[j] = *(const f32x4*)(src + 4 * j);
            if (!isv) { v[j][0] *= w2q[4 * j]; v[j][1] *= w2q[4 * j + 1]; v[j][2] *= w2q[4 * j + 2]; v[j][3] *= w2q[4 * j + 3]; }
            am = fmaxf(am, fmaxf(fmaxf(fabsf(v[j][0]), fabsf(v[j][1])), fmaxf(fabsf(v[j][2]), fabsf(v[j][3])))); }
        am = fmaxf(am, dppf<0xB1>(am)); am = fmaxf(am, dppf<0x4E>(am)); am = fmaxf(am, dppf<0x141>(am)); am = fmaxf(am, dppf<0x128>(am));
        { const auto r16 = __builtin_amdgcn_permlane16_swap(__float_as_uint(am), __float_as_uint(am), false, false); am = fmaxf(__uint_as_float(r16[0]), __uint_as_float(r16[1]));
          const auto r32 = __builtin_amdgcn_permlane32_swap(__float_as_uint(am), __float_as_uint(am), false, false); am = fmaxf(__uint_as_float(r32[0]), __uint_as_float(r32[1])); }
        if (isv) {
            const float sc = am > 0.f ? 6.0f / am : 0.f;
            v2u o;
#pragma unroll
            for (int h = 0; h < 2; ++h) { unsigned w = 0u;
                w = __builtin_amdgcn_cvt_scalef32_pk_fp4_f32(w, v[2 * h][0] * sc, v[2 * h][1] * sc, 1.0f, 0); w = __builtin_amdgcn_cvt_scalef32_pk_fp4_f32(w, v[2 * h][2] * sc, v[2 * h][3] * sc, 1.0f, 1);
                w = __builtin_amdgcn_cvt_scalef32_pk_fp4_f32(w, v[2 * h + 1][0] * sc, v[2 * h + 1][1] * sc, 1.0f, 2); w = __builtin_amdgcn_cvt_scalef32_pk_fp4_f32(w, v[2 * h + 1][2] * sc, v[2 * h + 1][3] * sc, 1.0f, 3);
                o[h] = w; }
            *(v2u*)(V8 + (size_t)L * 16384 * DM + (size_t)(lane >> 4) * (16384 * 128) + (size_t)rl * 128 + (lane & 15) * 8) = o;
            if (lane == 0) VSc[rr] = am * (1.0f / 6.0f);
        } else {
            const float sc = am > 0.f ? 7.0f / am : 0.f;
            v2u o;
#pragma unroll
            for (int h = 0; h < 2; ++h) { unsigned w = 0u;
#pragma unroll
                for (int k = 0; k < 8; ++k) w |= ((unsigned)__float2int_rn(v[2 * h + (k >> 2)][k & 3] * sc) & 15u) << (4 * k);
                o[h] = w; }
            *(v2u*)(U8 + (size_t)L * 16384 * DM + (size_t)(lane >> 4) * (16384 * 128) + (size_t)rl * 128 + (lane & 15) * 8) = o;
            if (lane == 0) USc[rr] = am * (1.0f / 7.0f);
        }
    }
}
__device__ __forceinline__ void ssd_scan(const Ctx F, bf16* ST, const float* CD, bool dry) {
    if (F.tid < 128) for (int e = F.vcu * 128 + F.tid; e < BATCH * 16384; e += F.G * 128) {
        const int b = e >> 14, hpn2 = e & 16383, h = hpn2 >> 11; float r0 = 0.f, r1 = 0.f;
        unsigned* sp = (unsigned*)ST + ((size_t)b * NCHUNK << 14) + hpn2; const float* dp = CD + (size_t)b * NCHUNK * 8 + h;
#pragma unroll 1
        for (int c = 0; c < NCHUNK; c += 32) { unsigned s[32]; float d[32];
#pragma unroll
            for (int i = 0; i < 32; ++i) { s[i] = sp[(size_t)(c + i) << 14]; d[i] = dp[(c + i) * 8]; }
#pragma unroll
            for (int i = 0; i < 32; ++i) { if (!dry) sp[(size_t)(c + i) << 14] = pk2(r0, r1); r0 = r0 * d[i] + bflo(s[i]); r1 = r1 * d[i] + bfhi(s[i]); } }
        asm volatile("" :: "v"(r0), "v"(r1));
    }
}
__device__ __forceinline__ void ssd_part2(const Ctx F, const bf16* P, bf16* Y, const bf16* CC, const float* EA, const bf16* ST, const float* nw  , bool dry) {
    LAS float* SSH = (LAS float*)F.lds;
    const int lane = F.lane, fr = lane & 15, fq = lane >> 4, h = F.wave, g = h >> 2;
#pragma unroll 1
    for (int u = F.vcu; u < BATCH * NCHUNK; u += F.G) {
        const int b = u / NCHUNK, c = u % NCHUNK; const size_t r0 = (size_t)b * SEQ + c * 64;
        bf16x8 pa[4][2], cbf[4][2];
#pragma unroll
        for (int pt = 0; pt < 4; ++pt)
#pragma unroll
            for (int ks = 0; ks < 2; ++ks) { pa[pt][ks] = __builtin_bit_cast(bf16x8, *(const v4u*)(ST + (((size_t)u * 8 + h) * 64 + 16 * pt + fr) * 64 + 32 * ks + 8 * fq));
                cbf[pt][ks] = __builtin_bit_cast(bf16x8, *(const v4u*)(CC + (r0 + 16 * pt + fr) * 128 + g * 64 + 32 * ks + 8 * fq)); }
        v2u yv4[4][4], zv4[4][4]; float ea4[4];
#pragma unroll
        for (int lt = 0; lt < 4; ++lt) { const int l = 16 * lt + fr; ea4[lt] = EA[(r0 + l) * 8 + h];
#pragma unroll
            for (int pt = 0; pt < 4; ++pt) { const int p0 = 16 * pt + 4 * fq; yv4[lt][pt] = *(const v2u*)(Y + (r0 + l) * DM + 256 + h * 64 + p0); zv4[lt][pt] = *(const v2u*)(P + (r0 + l) * NP + ZOFF + h * 64 + p0); } }
        f32x4v acc[4][4];
#pragma unroll
        for (int pt = 0; pt < 4; ++pt)
#pragma unroll
            for (int lt = 0; lt < 4; ++lt) { acc[pt][lt] = (f32x4v){0.f, 0.f, 0.f, 0.f};
#pragma unroll
                for (int ks = 0; ks < 2; ++ks) acc[pt][lt] = __builtin_amdgcn_mfma_f32_16x16x32_bf16(pa[pt][ks], cbf[lt][ks], acc[pt][lt], 0, 0, 0); }
        float ssl[4];
#pragma unroll
        for (int lt = 0; lt < 4; ++lt) { const float ea = ea4[lt]; ssl[lt] = 0.f;
#pragma unroll
            for (int pt = 0; pt < 4; ++pt) { const v2u yv = yv4[lt][pt], zv = zv4[lt][pt];
                const float yd[4] = {bflo(yv.x), bfhi(yv.x), bflo(yv.y), bfhi(yv.y)}, zz[4] = {bflo(zv.x), bfhi(zv.x), bflo(zv.y), bfhi(zv.y)};
#pragma unroll
                for (int r = 0; r < 4; ++r) { const float v = (yd[r] + ea * acc[pt][lt][r]) * silu_f(zz[r]); acc[pt][lt][r] = v; ssl[lt] += v * v; } } }
        __syncthreads();
#pragma unroll
        for (int lt = 0; lt < 4; ++lt) { const float s = sum_x32(sum_x16(ssl[lt])); if (fq == 0) SSH[h * 64 + 16 * lt + fr] = s; }
        __syncthreads();
#pragma unroll
        for (int lt = 0; lt < 4; ++lt) { const int l = 16 * lt + fr; float t = 0.f;
#pragma unroll
            for (int hh = 0; hh < 8; ++hh) t += SSH[hh * 64 + l];
            const float rstd = 1.0f / sqrtf(t * (1.0f / 512.0f) + EPS);
#pragma unroll
            for (int pt = 0; pt < 4; ++pt) { const int p0 = 16 * pt + 4 * fq; const f32x4 w4 = *(const f32x4*)(nw + h * 64 + p0);
                const v2u o = (v2u){pk2(acc[pt][lt][0] * rstd * w4[0], acc[pt][lt][1] * rstd * w4[1]), pk2(acc[pt][lt][2] * rstd * w4[2], acc[pt][lt][3] * rstd * w4[3])};
                if (!dry) *(v2u*)(Y + (r0 + l) * DM + 256 + h * 64 + p0) = o; } }
    }
}
constexpr int EIS = 72, CFS = 68;
constexpr int L7_EI = 0, L7_CF = 128 * EIS * 2, L7_PT = L7_CF + 128 * CFS * 4, L7_RS = L7_PT + 32768, L7_SSQ = L7_RS + 512, L7_SCL = L7_SSQ + 512, L7_END = L7_SCL + 8 * 9216;
static_assert(L7_END <= LDSCTL_OFF, "PEER LDS");
__device__ __forceinline__ unsigned mk_key(float f, unsigned idx) { const unsigned u = __float_as_uint(f); unsigned k = (u & 0x80000000u) ? ~u : (u | 0x80000000u); return (k & ~127u) | (127u - idx); }
__device__ __forceinline__ float key_val(unsigned k) { const unsigned kk = k & ~127u; return __uint_as_float((kk & 0x80000000u) ? (kk & 0x7fffffffu) : ~kk); }
__device__ __forceinline__ void ce_desc(unsigned& a, unsigned& b) { const unsigned hi = a > b ? a : b; const unsigned lo = a > b ? b : a; a = hi; b = lo; }
__device__ __forceinline__ void bitonic_sort16_desc(unsigned (&v)[16]) {
#pragma unroll
    for (int k = 2; k <= 16; k <<= 1)
#pragma unroll
        for (int j = k >> 1; j > 0; j >>= 1)
#pragma unroll
            for (int i = 0; i < 16; ++i) { const int l = i ^ j; if (l > i) { if ((i & k) == 0) ce_desc(v[i], v[l]); else ce_desc(v[l], v[i]); } }
}
__device__ __forceinline__ void bitonic_merge16_desc(unsigned (&v)[16]) {
#pragma unroll
    for (int j = 8; j > 0; j >>= 1)
#pragma unroll
        for (int i = 0; i < 16; ++i) { const int l = i ^ j; if (l > i) ce_desc(v[i], v[l]); }
}
__device__ __forceinline__ void topk16_slice(const float* sp, unsigned (&lst)[16]) {
    { const f32x4 a = *(const f32x4*)sp, b = *(const f32x4*)(sp + 4), c = *(const f32x4*)(sp + 8), d = *(const f32x4*)(sp + 12);
#pragma unroll
      for (int e = 0; e < 4; ++e) { lst[e] = mk_key(a[e], (unsigned)e); lst[4 + e] = mk_key(b[e], (unsigned)(4 + e)); lst[8 + e] = mk_key(c[e], (unsigned)(8 + e)); lst[12 + e] = mk_key(d[e], (unsigned)(12 + e)); } }
    bitonic_sort16_desc(lst);
#pragma unroll 1
    for (int ch = 1; ch < 8; ++ch) { unsigned cv[16];
        const f32x4 a = *(const f32x4*)(sp + 16 * ch), b = *(const f32x4*)(sp + 16 * ch + 4), c = *(const f32x4*)(sp + 16 * ch + 8), d = *(const f32x4*)(sp + 16 * ch + 12);
#pragma unroll
        for (int e = 0; e < 4; ++e) { cv[e] = mk_key(a[e], (unsigned)(16 * ch + e)); cv[4 + e] = mk_key(b[e], (unsigned)(16 * ch + 4 + e)); cv[8 + e] = mk_key(c[e], (unsigned)(16 * ch + 8 + e)); cv[12 + e] = mk_key(d[e], (unsigned)(16 * ch + 12 + e)); }
        bitonic_sort16_desc(cv);
#pragma unroll
        for (int q = 0; q < 16; ++q) lst[q] = lst[q] > cv[15 - q] ? lst[q] : cv[15 - q];
        bitonic_merge16_desc(lst); }
}
typedef float f32x2 __attribute__((ext_vector_type(2)));
__device__ __forceinline__ void dec16(const v4u q, float (&f)[16]) {
#pragma unroll
    for (int w = 0; w < 4; ++w) { const f32x2 lo = __builtin_amdgcn_cvt_pk_f32_fp8((int)q[w], false), hi = __builtin_amdgcn_cvt_pk_f32_fp8((int)q[w], true);
        f[4 * w] = lo.x; f[4 * w + 1] = lo.y; f[4 * w + 2] = hi.x; f[4 * w + 3] = hi.y; }
}
#ifdef PROBE_REP
#define REP_LOOP(n) _Pragma("unroll 1") for (int rp_ = 0; rp_ < ((PROBE_REP == (n)) ? reps_ : 1); ++rp_)
#else
#define REP_LOOP(n)
#endif
__device__ __forceinline__ void peer_phase(const Ctx F, const float* SC, const float* SS2, const unsigned char* U8, const unsigned char* V8, const float* US, const float* VS, const float* w2  ,
                                           const bf16* X1B  , unsigned char* HQ  , bf16* XB  , float* RS1  , float* OUT  , const float* fw  , bool last, bool dry, int dry2, const void* ST_CODE = nullptr) {
    LAS unsigned short* EI = (LAS unsigned short*)(F.lds + L7_EI); LAS float* CF = (LAS float*)(F.lds + L7_CF); LAS float* PT = (LAS float*)(F.lds + L7_PT);
    LAS float* RS = (LAS float*)(F.lds + L7_RS); LAS float* SSQ = (LAS float*)(F.lds + L7_SSQ);
#pragma unroll 1
    for (int tile = F.vcu; tile < M / 128; tile += F.G) {
        const int reps_ = 1 + (dry2 & 1); (void)reps_;
        int lane_o = F.lane; asm volatile("" : "+v"(lane_o));
        const int g = lane_o >> 3, i = lane_o & 7;
        __syncthreads();
        REP_LOOP(1)
        {
            const int tokl = F.tid >> 2, hh = F.tid & 3; const size_t row = (size_t)tile * 128 + tokl;
            unsigned l0[16], l1[16];
            topk16_slice(SC + row * 1024 + hh * 256, l0); topk16_slice(SC + row * 1024 + hh * 256 + 128, l1);
            float s0[16], s1[16];
#pragma unroll
            for (int j = 0; j < 16; ++j) { s0[j] = key_val(l0[j]); s1[j] = key_val(l1[j]); }
            {
                LAS unsigned* slot = (LAS unsigned*)(PT + tokl * 64 + hh * 16);
#pragma unroll
                for (int j = 0; j < 8; ++j) { slot[j] = (127u - (l0[2 * j] & 127u)) | ((127u - (l0[2 * j + 1] & 127u)) << 16); slot[8 + j] = (127u - (l1[2 * j] & 127u)) | ((127u - (l1[2 * j + 1] & 127u)) << 16); } }
            unsigned best[16];
#define CKEY(i_, j_) ((({ const unsigned u_ = __float_as_uint(s0[i_] + s1[j_]); (u_ & 0x80000000u) ? ~u_ : (u_ | 0x80000000u); }) & ~255u) | (255u - (unsigned)(16 * (i_) + (j_))))
#pragma unroll
            for (int j = 0; j < 16; ++j) best[j] = CKEY(0, j);
#pragma unroll
            for (int ii = 1; ii < 8; ++ii) { constexpr int NR[8] = {16, 8, 5, 4, 3, 2, 2, 2};
#pragma unroll
                for (int j = 0; j < 16; ++j) if (j < NR[ii]) { const unsigned c = CKEY(ii, j); best[15 - j] = best[15 - j] > c ? best[15 - j] : c; }
                bitonic_merge16_desc(best); }
#pragma unroll
            for (int ii = 8; ii < 16; ++ii) { unsigned k = CKEY(ii, 0);
#pragma unroll
                for (int q = 0; q < 16; ++q) { const unsigned hi = best[q] > k ? best[q] : k; k = best[q] > k ? k : best[q]; best[q] = hi; } }
#undef CKEY
            float e[16], bv[16], sum = 0.f;
#pragma unroll
            for (int j = 0; j < 16; ++j) { const unsigned kk = best[j] & ~255u; bv[j] = __uint_as_float((kk & 0x80000000u) ? (kk & 0x7fffffffu) : ~kk); }
#pragma unroll
            for (int j = 0; j < 16; ++j) { e[j] = __expf(bv[j] - bv[0]); sum += e[j]; }
            const float inv = 1.0f / sum;
            { const LAS unsigned short* slot = (const LAS unsigned short*)(PT + tokl * 64 + hh * 16);
#pragma unroll
              for (int j = 0; j < 16; ++j) { const unsigned pos = 255u - (best[j] & 255u); const unsigned ex = (unsigned)slot[pos >> 4] * 128u + (unsigned)slot[16 + (pos & 15u)];
                  EI[tokl * EIS + hh * 16 + j] = (unsigned short)ex; CF[tokl * CFS + hh * 16 + j] = e[j] * inv; } }
        }
        if (F.lane < 16) { const int tok = F.wave * 16 + F.lane; const f32x4* sp = (const f32x4*)(SS2 + ((size_t)tile * 128 + tok) * 16); const f32x4 a = sp[0], b = sp[1], c = sp[2], d = sp[3];
            const float t = ((a[0] + a[1]) + (a[2] + a[3])) + ((b[0] + b[1]) + (b[2] + b[3])) + ((c[0] + c[1]) + (c[2] + c[3])) + ((d[0] + d[1]) + (d[2] + d[3]));
            RS[tok] = 1.0f / sqrtf(t * (1.0f / DM) + EPS); SSQ[tok] = 0.f; }
        __syncthreads();
        REP_LOOP(2)
        {
#pragma unroll 1
            for (int t4 = 0; t4 < 16; t4 += 4) {
                v4u xr[4][2];
#pragma unroll
                for (int u = 0; u < 4; ++u) { const size_t row = (size_t)tile * 128 + F.wave * 16 + t4 + u; xr[u][0] = *(const v4u*)(X1B + row * DM + lane_o * 16); xr[u][1] = *(const v4u*)(X1B + row * DM + lane_o * 16 + 8); }
#pragma unroll
                for (int u = 0; u < 4; ++u) { const int tok = F.wave * 16 + t4 + u; const size_t row = (size_t)tile * 128 + tok;
                    float hv[16]; { float t8[8]; unpack8(xr[u][0], t8);
#pragma unroll
                        for (int q = 0; q < 8; ++q) hv[q] = t8[q];
                        unpack8(xr[u][1], t8);
#pragma unroll
                        for (int q = 0; q < 8; ++q) hv[8 + q] = t8[q]; }
                    float am = 0.f;
#pragma unroll
                    for (int q = 0; q < 16; ++q) am = fmaxf(am, fabsf(hv[q]));
                    am = fmaxf(am, dppf<0xB1>(am)); am = fmaxf(am, dppf<0x4E>(am)); am = fmaxf(am, dppf<0x141>(am)); am = fmaxf(am, dppf<0x128>(am));
                    { const auto r16 = __builtin_amdgcn_permlane16_swap(__float_as_uint(am), __float_as_uint(am), false, false); am = fmaxf(__uint_as_float(r16[0]), __uint_as_float(r16[1]));
                      const auto r32 = __builtin_amdgcn_permlane32_swap(__float_as_uint(am), __float_as_uint(am), false, false); am = fmaxf(__uint_as_float(r32[0]), __uint_as_float(r32[1])); }
                    const float s1 = am > 0.f ? 119.0f / am : 0.f;
                    v2u hi, lo;
#pragma unroll
                    for (int h = 0; h < 2; ++h) { unsigned hw_ = 0u, lw_ = 0u;
#pragma unroll
                        for (int k = 0; k < 8; ++k) { const int qv = __float2int_rn(hv[8 * h + k] * s1); lw_ |= ((unsigned)qv & 15u) << (4 * k); hw_ |= ((unsigned)((qv + 8) >> 4) & 15u) << (4 * k); }
                        hi[h] = hw_; lo[h] = lw_; }
                    unsigned char* hp = HQ + row * 1024 + (lane_o >> 4) * 256 + ((lane_o & 15) >> 1) * 32 + (lane_o & 1) * 8;
                    *(v2u*)hp = hi; *(v2u*)(hp + 16) = lo;
                    if (lane_o == 0) SSQ[tok] = am * (1.0f / 119.0f);
                }
            }
            asm volatile("s_waitcnt vmcnt(0)" ::: "memory");
        }
#define U_LOAD(it_, Q, X) do { const int s_ = (it_) >> 4, tok_ = F.wave * 16 + ((it_) & 15); \
            _Pragma("unroll") for (int j = 0; j < 8; ++j) { const unsigned e_ = EI[tok_ * EIS + 8 * j + g]; Q[j] = *(const v4u*)(U8 + (size_t)s_ * (16384 * 128) + (size_t)e_ * 128 + 16 * i); } \
            const unsigned char* xp_ = HQ + ((size_t)tile * 128 + tok_) * 1024 + 256 * s_ + 32 * i; \
            X[0] = *(const v4u*)xp_; X[1] = *(const v4u*)(xp_ + 16); } while (0)
#define U_COMP(it_, Q, X) do { const int s_ = (it_) >> 4, tok_ = F.wave * 16 + ((it_) & 15); \
            float d[8]; \
            _Pragma("unroll") for (int j = 0; j < 8; ++j) { int a_ = 0, b_ = 0; \
                _Pragma("unroll") for (int w = 0; w < 4; ++w) { a_ = __builtin_amdgcn_sdot8((int)Q[j][w], (int)X[0][w], a_, false); b_ = __builtin_amdgcn_sdot8((int)Q[j][w], (int)X[1][w], b_, false); } \
                d[j] = (float)(a_ * 16 + b_); } \
            float d2[4], d3[2]; \
            _Pragma("unroll") for (int m = 0; m < 4; ++m) { const float snd = (i & 4) ? d[m] : d[4 + m]; const float kp = (i & 4) ? d[4 + m] : d[m]; d2[m] = kp + dppf<0x141>(snd); }     \
            _Pragma("unroll") for (int m = 0; m < 2; ++m) { const float snd = (i & 2) ? d2[m] : d2[2 + m]; const float kp = (i & 2) ? d2[2 + m] : d2[m]; d3[m] = kp + dppf<0x4E>(snd); } \
            const float snd = (i & 1) ? d3[0] : d3[1]; const float kp = (i & 1) ? d3[1] : d3[0]; const float tot = kp + dppf<0xB1>(snd); \
            const int pi = tok_ * 64 + 8 * i + g; PT[pi] = (s_ == 0) ? tot : PT[pi] + tot; } while (0)
        REP_LOOP(3)
        {
            v4u qa[8], qb[8]; v4u xa[2], xb[2];
            U_LOAD(0, qa, xa);
#pragma unroll 1
            for (int it = 0; it < 64; it += 2) {
                U_LOAD(it + 1, qb, xb);
                U_COMP(it, qa, xa);
                { const int itn = (it + 2 < 64) ? it + 2 : 63; U_LOAD(itn, qa, xa); }
                U_COMP(it + 1, qb, xb);
            }
        }
#undef U_LOAD
#undef U_COMP
#pragma unroll 1
        for (int n = 0; n < 16; ++n) { const int tk = F.wave * 16 + n; const unsigned e = EI[tk * EIS + F.lane]; const float dd = PT[tk * 64 + F.lane] * US[e] * (RS[tk] * SSQ[tk]);
            CF[tk * CFS + F.lane] = CF[tk * CFS + F.lane] * (0.5f * dd * (1.0f + erff(dd * 0.70710678118654752f))) * VS[e]; }
#define V_LOADK(n_, kb_, Q) do { const int s_ = (n_) >> 1, tok_ = F.wave * 16 + 8 * ((n_) & 1) + t; \
            const v4u ev_ = *(const LAS v4u*)(EI + tok_ * EIS + 8 * (kb_)); \
            _Pragma("unroll") for (int j = 0; j < 8; ++j) { const unsigned e_ = (ev_[j >> 1] >> (16 * (j & 1))) & 0xffffu; Q[j] = *(const v4u*)(V8 + (size_t)s_ * (16384 * 128) + (size_t)e_ * 128 + 16 * i); } } while (0)
#define V_DEC(Q, w_, b_) { const f32x2 r_ = __builtin_amdgcn_cvt_scalef32_pk_f32_fp4(Q[j][w_], 1.0f, b_); o[4 * (w_) + (b_)] = __builtin_elementwise_fma(r_, c2_, o[4 * (w_) + (b_)]); }
#define V_COMPK(n_, kb_, Q) do { const int tok_ = F.wave * 16 + 8 * ((n_) & 1) + t; \
            const f32x4 c0_ = *(const LAS f32x4*)(CF + tok_ * CFS + 8 * (kb_)), c1_ = *(const LAS f32x4*)(CF + tok_ * CFS + 8 * (kb_) + 4); \
            _Pragma("unroll") for (int j = 0; j < 8; ++j) { const float cf_ = (j < 4) ? c0_[j & 3] : c1_[j & 3]; const f32x2 c2_ = (f32x2){cf_, cf_}; \
                V_DEC(Q, 0, 0) V_DEC(Q, 0, 1) V_DEC(Q, 0, 2) V_DEC(Q, 0, 3) V_DEC(Q, 1, 0) V_DEC(Q, 1, 1) V_DEC(Q, 1, 2) V_DEC(Q, 1, 3) V_DEC(Q, 2, 0) V_DEC(Q, 2, 1) V_DEC(Q, 2, 2) V_DEC(Q, 2, 3) V_DEC(Q, 3, 0) V_DEC(Q, 3, 1) V_DEC(Q, 3, 2) V_DEC(Q, 3, 3) } } while (0)
        REP_LOOP(5)
        {
            const int t = lane_o >> 3;
            v4u qa[8], qb[8]; float ssq0 = 0.f, ssq1 = 0.f;
            V_LOADK(0, 0, qa);
#pragma unroll 1
            for (int n = 0; n < 8; ++n) {
                const size_t xoff = ((size_t)tile * 128 + F.wave * 16 + 8 * (n & 1) + t) * DM + 256 * (n >> 1) + 32 * i;
                f32x2 o[16];
#pragma unroll
                for (int m = 0; m < 16; ++m) o[m] = (f32x2){0.f, 0.f};
                V_LOADK(n, 1, qb); V_COMPK(n, 0, qa);
                V_LOADK(n, 2, qa); V_COMPK(n, 1, qb);
                V_LOADK(n, 3, qb); V_COMPK(n, 2, qa);
                V_LOADK(n, 4, qa); V_COMPK(n, 3, qb);
                V_LOADK(n, 5, qb); V_COMPK(n, 4, qa);
                V_LOADK(n, 6, qa); V_COMPK(n, 5, qb);
                v4u xr[4];
#pragma unroll
                for (int q = 0; q < 4; ++q) xr[q] = *(const v4u*)(X1B + xoff + 8 * q);
                V_LOADK(n, 7, qb); V_COMPK(n, 6, qa);
                { const int nn = (n < 7) ? n + 1 : 7; V_LOADK(nn, 0, qa); }
                V_COMPK(n, 7, qb);
                float sq = 0.f;
#pragma unroll
                for (int q = 0; q < 4; ++q) { float xf[8]; unpack8(xr[q], xf);
#pragma unroll
                    for (int m = 0; m < 8; ++m) { xf[m] += o[4 * q + (m >> 1)][m & 1]; sq += xf[m] * xf[m]; }
                    if (!dry) *(v4u*)(XB + xoff + 8 * q) = pack8(xf); }
                ssq0 += (n & 1) ? 0.f : sq; ssq1 += (n & 1) ? sq : 0.f;
            }
            ssq0 += dppf<0xB1>(ssq0); ssq0 += dppf<0x4E>(ssq0); ssq0 += dppf<0x141>(ssq0);
            ssq1 += dppf<0xB1>(ssq1); ssq1 += dppf<0x4E>(ssq1); ssq1 += dppf<0x141>(ssq1);
            const float rstd0 = 1.0f / sqrtf(ssq0 * (1.0f / DM) + EPS), rstd1 = 1.0f / sqrtf(ssq1 * (1.0f / DM) + EPS);
            if (i == 0) {
                if (!last) { if (!dry) { RS1[(size_t)tile * 128 + F.wave * 16 + t] = rstd0; RS1[(size_t)tile * 128 + F.wave * 16 + 8 + t] = rstd1; } }
                else { RS[F.wave * 16 + t] = rstd0; RS[F.wave * 16 + 8 + t] = rstd1; }
            }
        }
#undef V_LOADK
#undef V_COMPK
#undef V_DEC
        if (last) {
            asm volatile("s_waitcnt vmcnt(0) lgkmcnt(0)" ::: "memory");
            __builtin_amdgcn_fence(__ATOMIC_ACQUIRE, "agent");
            asm volatile("s_waitcnt vmcnt(0)" ::: "memory");
            REP_LOOP(6)
#pragma unroll 1
            for (int ti = 0; ti < 16; ++ti) {
                const int tok = F.wave * 16 + ti; const size_t row = (size_t)tile * 128 + tok;
                float f0[8], f1[8]; unpack8(*(const v4u*)(XB + row * DM + F.lane * 8), f0); unpack8(*(const v4u*)(XB + row * DM + 512 + F.lane * 8), f1);
                float rstd = RS[tok];
#if defined(SELFTEST)
                rstd *= 1.0f + 0.2f * (float)__hip_atomic_load((const unsigned*)ST_CODE, __ATOMIC_RELAXED, __HIP_MEMORY_SCOPE_AGENT);
#endif
                if (!dry) {
                    const f32x4 c0 = *(const f32x4*)(fw + F.lane * 8), d0 = *(const f32x4*)(fw + F.lane * 8 + 4), c1 = *(const f32x4*)(fw + 512 + F.lane * 8), d1 = *(const f32x4*)(fw + 512 + F.lane * 8 + 4);
                    *(f32x4*)(OUT + row * DM + F.lane * 8) = (f32x4){f0[0] * rstd * c0[0], f0[1] * rstd * c0[1], f0[2] * rstd * c0[2], f0[3] * rstd * c0[3]};
                    *(f32x4*)(OUT + row * DM + F.lane * 8 + 4) = (f32x4){f0[4] * rstd * d0[0], f0[5] * rstd * d0[1], f0[6] * rstd * d0[2], f0[7] * rstd * d0[3]};
                    *(f32x4*)(OUT + row * DM + 512 + F.lane * 8) = (f32x4){f1[0] * rstd * c1[0], f1[1] * rstd * c1[1], f1[2] * rstd * c1[2], f1[3] * rstd * c1[3]};
                    *(f32x4*)(OUT + row * DM + 512 + F.lane * 8 + 4) = (f32x4){f1[4] * rstd * d1[0], f1[5] * rstd * d1[1], f1[6] * rstd * d1[2], f1[7] * rstd * d1[3]};
                }
            }
        }
    }
}


#if defined(SELFTEST)
__device__ __forceinline__ float st_a(int r, int k) { return (float)(((r * 3 + k) % 5) - 2); }
__device__ __forceinline__ float st_b(int k, int c) { return (float)(((k + 2 * c) % 7) - 3); }
__device__ __forceinline__ void selftest(const Ctx F, gu32* ctl) {
    if (blockIdx.x != 0 || F.wave != 0) return;
    const int lane = F.lane, fr = lane & 15, fq = lane >> 4;
    int aw[2] = {0, 0}, bw[2] = {0, 0};
#pragma unroll
    for (int w = 0; w < 2; ++w) { aw[w] = __builtin_amdgcn_cvt_pk_fp8_f32(st_a(fr, 8 * fq + 4 * w), st_a(fr, 8 * fq + 4 * w + 1), aw[w], false); aw[w] = __builtin_amdgcn_cvt_pk_fp8_f32(st_a(fr, 8 * fq + 4 * w + 2), st_a(fr, 8 * fq + 4 * w + 3), aw[w], true);
                                  bw[w] = __builtin_amdgcn_cvt_pk_fp8_f32(st_b(8 * fq + 4 * w, fr), st_b(8 * fq + 4 * w + 1, fr), bw[w], false); bw[w] = __builtin_amdgcn_cvt_pk_fp8_f32(st_b(8 * fq + 4 * w + 2, fr), st_b(8 * fq + 4 * w + 3, fr), bw[w], true); }
    const long A = (long)(((unsigned long long)(unsigned)aw[1] << 32) | (unsigned)aw[0]), B = (long)(((unsigned long long)(unsigned)bw[1] << 32) | (unsigned)bw[0]);
    f32x4 d = (f32x4){0.f, 0.f, 0.f, 0.f};
    d = __builtin_amdgcn_mfma_f32_16x16x32_fp8_fp8(A, B, d, 0, 0, 0);
    bool ok1 = true;
#pragma unroll
    for (int r = 0; r < 4; ++r) { float e = 0.f; for (int kk = 0; kk < 32; ++kk) e += st_a(4 * fq + r, kk) * st_b(kk, fr); ok1 = ok1 && (d[r] == e); }
    const int t1 = __all(ok1) ? 1 : 0;
    LAS unsigned char* T = F.lds;
    for (int c4 = 0; c4 < 32; ++c4) { unsigned w = 0; for (int b = 0; b < 4; ++b) w |= (unsigned)((37 * lane + 11 * (4 * c4 + b)) & 127) << (8 * b); *(LAS unsigned*)(T + lane * 128 + 4 * c4) = w; }
    asm volatile("s_waitcnt lgkmcnt(0)" ::: "memory");
    int t2 = 0;
#pragma unroll
    for (int hyp = 1; hyp <= 2; ++hyp) {
        const int l16 = lane & 15; const int row = (hyp == 1) ? (l16 >> 1) : (l16 & 7), cc = (hyp == 1) ? 8 * (l16 & 1) : 8 * (l16 >> 3);
        const v2i_t v = __builtin_amdgcn_ds_read_tr8_b64_v2i32((LAS v2i_t*)(T + (8 * fq + row) * 128 + 16 + cc));
        bool ok = true;
#pragma unroll
        for (int j = 0; j < 8; ++j) { const unsigned got = ((unsigned)(j < 4 ? v.x : v.y) >> (8 * (j & 3))) & 255u; ok = ok && (got == (unsigned)((37 * (8 * fq + j) + 11 * (16 + l16)) & 127)); }
        if (__all(ok)) t2 = hyp;
    }
    if (lane == 0) __hip_atomic_store(ctl + 20, (unsigned)(t1 + 2 * t2 + 1), RLX_AGENT);
    asm volatile("s_waitcnt vmcnt(0) lgkmcnt(0)" ::: "memory");
}
#endif
__device__ __forceinline__ Ctx fresh(const Ctx F) { Ctx R = F; int t = F.tid, v = F.vcu, g = F.G; asm volatile("" : "+v"(t)); asm volatile("" : "+s"(v), "+s"(g)); R.tid = t; R.lane = t & 63; R.wave = __builtin_amdgcn_readfirstlane(t >> 6); R.vcu = v; R.G = g; return R; }
struct Args { const float* in[17]; float* out; unsigned char* ws; int ph_lo, ph_hi, li, pad; };
__global__ void __launch_bounds__(NWAVES * 64, 2) mega_fwd(Args args) {
    extern __shared__ __attribute__((aligned(16))) unsigned char lds[];
    Ctx F;
    F.lds = (LAS unsigned char*)lds;
    F.tid = threadIdx.x; F.lane = F.tid & 63; F.wave = __builtin_amdgcn_readfirstlane(F.tid >> 6);
    F.G = gridDim.x; { const int bx = blockIdx.x; F.vcu = (F.G % 8 == 0) ? (bx % 8) * (F.G / 8) + bx / 8 : bx; }
    unsigned char* ws = args.ws;
    gu32* ctl = (gu32*)(ws + WS_CTL);
    volatile LAS unsigned* MISC = (volatile LAS unsigned*)(F.lds + MISC_OFF);
    for (int u = F.tid; u < (LDS_BYTES - LDSCTL_OFF) / 4; u += NWAVES * 64) ((LAS unsigned*)(F.lds + LDSCTL_OFF))[u] = 0u;
    __syncthreads();
    XcdBarrier bar; bar.bar = (unsigned*)(ctl + CW_BAR); bar.x = 0; bar.st = nullptr;
    if (N_LAUNCHES != NPH) bar = xcd_barrier_post((unsigned*)(ctl + CW_BAR), MISC + 8);
    const int lo = args.ph_lo, hi = args.ph_hi;
#define IN(k) (lo <= (k) && (k) < hi)
#ifndef PH_MASK
#define PH_MASK 0x3ff
#endif
#define PHK(i) ((PH_MASK >> (i)) & 1)
#ifndef DUP_KIND
#define DUP_KIND (-1)
#endif
#define DUPK(i) (DUP_KIND == (i))
    const bool dry = (args.pad == 0);
#define SEAM(k) do { if (N_LAUNCHES != NPH) { if (IN(k) && IN((k) + 1)) xcd_barrier(bar); } } while (0)
    const float* x_in = args.in[0]; float* OUT = args.out;
    bf16* XNY = (bf16*)(ws + WS_XNY); bf16* XB = (bf16*)(ws + WS_XB); float* RS1 = (float*)(ws + WS_RS1); bf16* PB = (bf16*)(ws + WS_P); float* SC = (float*)(ws + WS_SC); bf16* X1B = (bf16*)(ws + WS_X1B);
    float* SS2 = (float*)(ws + WS_SS2); float* EA = (float*)(ws + WS_EA); float* CD = (float*)(ws + WS_CD); bf16* CC = (bf16*)(ws + WS_CC); bf16* ST = (bf16*)(ws + WS_ST);
#if defined(SELFTEST)
    if (IN(0)) { selftest(fresh(F), ctl); __syncthreads(); }
#endif
    if (DUPK(0) && IN(0)) p0_prologue(fresh(F), x_in, args.in[1], args.in[2], args.in[10], args.in[11], args.in[12], args.in[13], ws);
    if (PHK(0) && IN(0)) p0_prologue(fresh(F), x_in, args.in[1], args.in[2], args.in[10], args.in[11], args.in[12], args.in[13], ws);
    SEAM(0);
    if (DUPK(15) && N_LAUNCHES != NPH) { for (int r = 0; r < 10; ++r) xcd_barrier(bar); }
#pragma unroll
    for (int L = 0; L < DEPTH; ++L) {
        const int pb = 1 + 7 * L;
#pragma unroll 1
        for (int rep = 0; rep < ((DUPK(1) && L == 0) ? 2 : 1); ++rep)
        if (PHK(1) && IN(pb)) {
            pg8::Gemm g{XB, (const bf16*)(ws + WS_WIN) + (size_t)L * NP * DM, M, NP, DM}; pg8::StaticOrder S; S.init(M, NP, F.G, (int)blockIdx.x);
            pg8::EpiBf16Row E{PB, NP, RS1};
            pg8::gemm_phase<pg8::EpiBf16Row, pg8::StaticOrder, PG8_ALIGN, PG8_SP2>(F.lds, g, S, E);
        }
        SEAM(pb);
        if (IN(pb + 1)) {
            if (DUPK(2) && L == 0) ssd_part1(fresh(F), PB, XNY, args.in[3] + (size_t)L * 4 * 768, args.in[4] + L * 768, args.in[5] + L * 8, args.in[6] + L * 8, args.in[7] + L * 8, CC, EA, CD, ST);
            if (PHK(2)) ssd_part1(fresh(F), PB, XNY, args.in[3] + (size_t)L * 4 * 768, args.in[4] + L * 768, args.in[5] + L * 8, args.in[6] + L * 8, args.in[7] + L * 8, CC, EA, CD, ST);
            if (DUPK(3) && L == 0) attn_mfma(fresh(F), PB, XNY);
            if (PHK(3)) attn_mfma(fresh(F), PB, XNY);
            if (DUPK(4) && L == 0) shortconv(fresh(F), PB, XNY, args.in[9] + (size_t)L * 3 * 256);
            if (PHK(4)) shortconv(fresh(F), PB, XNY, args.in[9] + (size_t)L * 3 * 256);
        }
        SEAM(pb + 1);
        if (DUPK(5) && L == 0 && IN(pb + 2)) ssd_scan(fresh(F), ST, CD, dry);
        if (PHK(5) && IN(pb + 2)) { const Ctx Fs = fresh(F); ssd_scan(Fs, ST, CD, false); if (Fs.wave >= 2) {
#if defined(PROBE_REP) && PROBE_REP == 7
#pragma unroll 1
                for (int rp_ = 0; rp_ < (dry ? 2 : 1); ++rp_)
#endif
                convert_tables(Fs.lane, args.in[14], args.in[15], args.in[11] + L * DM, ws, L, Fs.vcu * 6 + (Fs.wave - 2), Fs.G * 6); } }
        SEAM(pb + 2);
        if (DUPK(6) && L == 0 && IN(pb + 3)) ssd_part2(fresh(F), PB, XNY, CC, EA, ST, args.in[8] + L * 512, dry);
        if (PHK(6) && IN(pb + 3)) ssd_part2(fresh(F), PB, XNY, CC, EA, ST, args.in[8] + L * 512, false);
        SEAM(pb + 3);
#pragma unroll 1
        for (int rep = 0; rep < ((DUPK(7) && L == 0) ? 2 : 1); ++rep)
        if (PHK(7) && IN(pb + 4)) {
            pg8::Gemm g{XNY, (const bf16*)(ws + WS_WOUT) + (size_t)L * DM * DM, M, DM, DM}; pg8::StaticOrder S; S.init(M, DM, F.G, (int)blockIdx.x);
            pg8::EpiResidB E{XB, X1B, SS2};
            pg8::gemm_phase<pg8::EpiResidB, pg8::StaticOrder, PG8_ALIGN, PG8_SP2>(F.lds, g, S, E);
        }
        SEAM(pb + 4);
#pragma unroll 1
        for (int rep = 0; rep < ((DUPK(8) && L == 0) ? 2 : 1); ++rep)
        if (PHK(8) && IN(pb + 5)) {
            pg8::Gemm g{X1B, (const bf16*)(ws + WS_WS) + (size_t)L * DM * DM, M, DM, DM}; pg8::StaticOrder S; S.init(M, DM, F.G, (int)blockIdx.x);
            pg8::EpiScore E{SC, SS2, EPS};
            pg8::gemm_phase<pg8::EpiScore, pg8::StaticOrder, PG8_ALIGN, PG8_SP2>(F.lds, g, S, E);
        }
        SEAM(pb + 5);
        if (DUPK(9) && L == 0 && IN(pb + 6)) peer_phase(fresh(F), SC, SS2, ws + WS_U8 + (size_t)L * 16384 * DM, ws + WS_V8 + (size_t)L * 16384 * DM, (const float*)(ws + WS_US) + L * 16384, (const float*)(ws + WS_VS) + L * 16384, args.in[11] + L * DM, X1B, ws + WS_ST, XB, RS1, OUT, args.in[16], L == DEPTH - 1, dry, 0);
        if (PHK(9) && IN(pb + 6)) peer_phase(fresh(F), SC, SS2, ws + WS_U8 + (size_t)L * 16384 * DM, ws + WS_V8 + (size_t)L * 16384 * DM, (const float*)(ws + WS_US) + L * 16384, (const float*)(ws + WS_VS) + L * 16384, args.in[11] + L * DM, X1B, ws + WS_ST, XB, RS1, OUT, args.in[16], L == DEPTH - 1, false, dry ? 1 : 0, (const void*)(ctl + 20));
        SEAM(pb + 6);
    }
#undef IN
#undef SEAM
}

extern "C" void kernel_launch(void* const* d_in, const int* in_sizes, int n_in, void* d_out, int out_size, void* d_ws, size_t ws_size, hipStream_t stream) {
    static int grid = 0;
    if (grid == 0) {
        if (n_in != 17 || in_sizes[0] != M * DM || out_size != M * DM || ws_size < WS_END) { fprintf(stderr, "kernel_launch: unexpected shapes (n_in %d, in0 %d, out %d, ws %zu); nothing launched\n", n_in, n_in > 0 ? in_sizes[0] : -1, out_size, ws_size); grid = -1; return; }
        int dev = 0, cus = 0, per_cu = 0;
        if (hipGetDevice(&dev) != hipSuccess || hipDeviceGetAttribute(&cus, hipDeviceAttributeMultiprocessorCount, dev) != hipSuccess) { fprintf(stderr, "kernel_launch: device query failed\n"); grid = -1; return; }
        if (hipFuncSetAttribute((const void*)mega_fwd, hipFuncAttributeMaxDynamicSharedMemorySize, LDS_BYTES) != hipSuccess) { fprintf(stderr, "kernel_launch: hipFuncSetAttribute failed\n"); grid = -1; return; }
        if (hipOccupancyMaxActiveBlocksPerMultiprocessor(&per_cu, (const void*)mega_fwd, NWAVES * 64, LDS_BYTES) != hipSuccess || per_cu < 1) { fprintf(stderr, "kernel_launch: the occupancy query reports %d resident workgroups per CU for %d threads + %d B of LDS; nothing launched\n", per_cu, NWAVES * 64, LDS_BYTES); (void)hipGetLastError(); grid = -1; return; }
        (void)hipGetLastError();
        grid = cus;
    }
    if (grid < 0) return;
    if (hipMemsetAsync((char*)d_ws + WS_CTL, 0, CTL_ZERO_BYTES, stream) != hipSuccess) { fprintf(stderr, "kernel_launch: memset failed\n"); return; }
    Args a{};
    for (int i = 0; i < 17; ++i) a.in[i] = (const float*)d_in[i];
    a.out = (float*)d_out; a.ws = (unsigned char*)d_ws;
    for (int li = 0; li < N_LAUNCHES; ++li) {
        a.ph_lo = (N_LAUNCHES == NPH) ? li : 0; a.ph_hi = (N_LAUNCHES == NPH) ? li + 1 : NPH; a.li = li;
        hipLaunchKernelGGL(mega_fwd, dim3(grid), dim3(NWAVES * 64), LDS_BYTES, stream, a);
        const hipError_t le = hipPeekAtLastError();
        if (le != hipSuccess) { fprintf(stderr, "kernel_launch: launch %d failed: %s\n", li, hipGetErrorName(le)); break; }
    }
}
```
